# Optimizing an MI355X kernel written in HIP

```python
import math
import jax, jax.numpy as jnp
from jax import lax
import numpy as np

D_MODEL = 1024
BATCH = 8
SEQ = 2048
DEPTH = 4

N_MIXERS = 2
N_HEADS = 16
HEAD_DIM = 64
NSA_KV_GROUPS = 4
NSA_Q_PER_GROUP = N_HEADS // NSA_KV_GROUPS
CMP_BLOCK = 32
CMP_STRIDE = 16
CMP_HIDDEN = 256
SEL_BLOCK = 64
SEL_TOPK = 16
SEL_Q_CHUNK = 64
WINDOW = 512
Q_BLOCK = 128
NUM_BUCKETS = 32
MAX_DISTANCE = 128
D_FF = 2816
RMS_EPS = 1e-6
NEG_INF = -1e30
FORCED_SCORE = 1e9
Q_DIM = N_HEADS * HEAD_DIM
KV_DIM = NSA_KV_GROUPS * HEAD_DIM
NSA_IN_DIM = Q_DIM + 6 * KV_DIM + 3 * N_HEADS
FOX_IN_DIM = 3 * Q_DIM + N_HEADS
N_NSA_LAYERS = (DEPTH + 1) // 2
N_FOX_LAYERS = DEPTH // 2

kernel_name = "nsa_fox_macaron_sandwich_hybrid"


def rms_norm(x, g):
    xf = x.astype(jnp.float32)
    y = xf * lax.rsqrt(jnp.mean(xf * xf, axis=-1, keepdims=True) + RMS_EPS)
    return (y * g.astype(jnp.float32)).astype(x.dtype)


def swiglu(x, w_gate, w_up, w_down):
    return (jax.nn.silu(x @ w_gate) * (x @ w_up)) @ w_down


def t5_bucket(rel):
    n = jnp.maximum(rel, 0)
    max_exact = NUM_BUCKETS // 2
    nf = jnp.maximum(n, 1).astype(jnp.float32)
    large = max_exact + (jnp.log(nf / max_exact) / math.log(MAX_DISTANCE / max_exact)
                         * (NUM_BUCKETS - max_exact)).astype(jnp.int32)
    large = jnp.minimum(large, NUM_BUCKETS - 1)
    return jnp.where(n < max_exact, n, large)


def masked_softmax(logits, mask):
    logits = jnp.where(mask, logits.astype(jnp.float32), NEG_INF)
    p = jax.nn.softmax(logits, axis=-1)
    return jnp.where(mask, p, 0.0)


def nsa_mixer(h, w_in, cmp_pe, cmp_w1, cmp_b1, cmp_w2, w_out, rel_bias):
    B, S, _ = h.shape
    G, R, dh = NSA_KV_GROUPS, NSA_Q_PER_GROUP, HEAD_DIM
    scale = dh ** -0.5
    splits = np.cumsum([Q_DIM] + [KV_DIM] * 6).tolist()
    q, kc, vc, ks, vs, kw, vw, gates = jnp.split(h @ w_in, splits, axis=-1)
    q = q.reshape(B, S, G, R, dh).transpose(0, 2, 3, 1, 4)
    to_kv = lambda a: a.reshape(B, S, G, dh).transpose(0, 2, 1, 3)
    kc, vc, ks, vs, kw, vw = map(to_kv, (kc, vc, ks, vs, kw, vw))
    t_np = np.arange(S)

    nc = (S - CMP_BLOCK) // CMP_STRIDE + 1
    blk_idx = np.arange(nc)[:, None] * CMP_STRIDE + np.arange(CMP_BLOCK)[None, :]

    def compress(a, pe, w1, b1, w2):
        blocks = a[:, :, blk_idx] + pe
        flat = blocks.reshape(B, G, nc, CMP_BLOCK * dh)
        return jax.nn.gelu(flat @ w1 + b1) @ w2

    k_cmp = compress(kc, cmp_pe[0], cmp_w1[0], cmp_b1[0], cmp_w2[0])
    v_cmp = compress(vc, cmp_pe[1], cmp_w1[1], cmp_b1[1], cmp_w2[1])
    blk_end = np.arange(nc) * CMP_STRIDE + CMP_BLOCK - 1
    rel_c = t_np[:, None] - blk_end[None, :]
    mask_c = rel_c >= 0
    bias_c = jnp.transpose(rel_bias[t5_bucket(jnp.asarray(rel_c))], (2, 0, 1)).reshape(G, R, S, nc)
    logits_c = jnp.einsum('bgrsd,bgcd->bgrsc', q, k_cmp) * scale + bias_c
    p_c = masked_softmax(logits_c, mask_c)
    o_cmp = jnp.einsum('bgrsc,bgcd->bgrsd', p_c.astype(v_cmp.dtype), v_cmp)

    n_sel = S // SEL_BLOCK
    c_start = np.arange(nc)[:, None] * CMP_STRIDE
    j_np = np.arange(n_sel)[None, :]
    overlap = ((c_start < (j_np + 1) * SEL_BLOCK) & (c_start + CMP_BLOCK > j_np * SEL_BLOCK)).astype(np.float32)
    imp = jnp.einsum('bgrsc,cj->bgsj', p_c, jnp.asarray(overlap))
    cur = (t_np // SEL_BLOCK)[:, None]
    forced = (j_np == 0) | (j_np == cur) | (j_np == cur - 1)
    valid_blk = j_np <= cur
    imp = jnp.where(forced, FORCED_SCORE, jnp.where(valid_blk, imp, NEG_INF))
    k_eff = min(SEL_TOPK, n_sel)
    _, sel_idx = lax.top_k(imp, k_eff)

    k_blocks = ks.reshape(B, G, n_sel, SEL_BLOCK, dh)
    v_blocks = vs.reshape(B, G, n_sel, SEL_BLOCK, dh)
    tbl = jnp.transpose(rel_bias.reshape(NUM_BUCKETS, G, R), (1, 0, 2))
    b_ix = jnp.arange(B)[:, None, None, None]
    g_ix = jnp.arange(G)[None, :, None, None]
    C = SEL_Q_CHUNK
    n_ch = S // C

    def sel_chunk(args):
        q_c, idx_c, t_c = args
        kg = k_blocks[b_ix, g_ix, idx_c]
        vg = v_blocks[b_ix, g_ix, idx_c]
        pos = idx_c[..., None] * SEL_BLOCK + jnp.arange(SEL_BLOCK)
        rel = t_c[None, None, :, None, None] - pos
        bias = jnp.moveaxis(tbl[g_ix[..., None], t5_bucket(rel)], -1, 2)
        logits = jnp.einsum('bgrcd,bgckld->bgrckl', q_c, kg) * scale + bias
        mask = (rel >= 0)[:, :, None].reshape(B, G, 1, C, -1)
        p = masked_softmax(logits.reshape(B, G, R, C, -1), mask).reshape(logits.shape)
        return jnp.einsum('bgrckl,bgckld->bgrcd', p.astype(vg.dtype), vg)

    q_x = jnp.moveaxis(q.reshape(B, G, R, n_ch, C, dh), 3, 0)
    idx_x = jnp.moveaxis(sel_idx.reshape(B, G, n_ch, C, k_eff), 2, 0)
    t_x = jnp.arange(S).reshape(n_ch, C)
    o_sel = lax.map(sel_chunk, (q_x, idx_x, t_x))
    o_sel = jnp.moveaxis(o_sel, 0, 3).reshape(B, G, R, S, dh)

    n_qb = S // Q_BLOCK
    band = WINDOW + Q_BLOCK
    kw_p = jnp.pad(kw, ((0, 0), (0, 0), (WINDOW, 0), (0, 0)))
    vw_p = jnp.pad(vw, ((0, 0), (0, 0), (WINDOW, 0), (0, 0)))
    rel_w = np.arange(Q_BLOCK)[:, None] + WINDOW - np.arange(band)[None, :]
    band_mask = (rel_w >= 0) & (rel_w < WINDOW)
    bias_w = jnp.transpose(rel_bias[t5_bucket(jnp.asarray(rel_w))], (2, 0, 1)).reshape(G, R, Q_BLOCK, band)

    def win_block(args):
        q_b, start = args
        k_b = lax.dynamic_slice_in_dim(kw_p, start, band, axis=2)
        v_b = lax.dynamic_slice_in_dim(vw_p, start, band, axis=2)
        key_pos = start - WINDOW + jnp.arange(band)
        mask = band_mask & (key_pos >= 0)[None, :]
        logits = jnp.einsum('bgrqd,bgkd->bgrqk', q_b, k_b) * scale + bias_w
        p = masked_softmax(logits, mask)
        return jnp.einsum('bgrqk,bgkd->bgrqd', p.astype(v_b.dtype), v_b)

    qw_x = jnp.moveaxis(q.reshape(B, G, R, n_qb, Q_BLOCK, dh), 3, 0)
    o_win = lax.map(win_block, (qw_x, jnp.arange(n_qb) * Q_BLOCK))
    o_win = jnp.moveaxis(o_win, 0, 3).reshape(B, G, R, S, dh)

    g = jax.nn.sigmoid(gates.reshape(B, S, 3, G, R)).transpose(2, 0, 3, 4, 1)[..., None]
    o = g[0] * o_cmp + g[1] * o_sel + g[2] * o_win
    o = o.transpose(0, 3, 1, 2, 4).reshape(B, S, Q_DIM)
    return o @ w_out


def fox_mixer(h, w_in, b_f, w_out):
    B, S, _ = h.shape
    H, dh = N_HEADS, HEAD_DIM
    scale = dh ** -0.5
    q, k, v, f_logit = jnp.split(h @ w_in, [Q_DIM, 2 * Q_DIM, 3 * Q_DIM], axis=-1)
    heads = lambda a: a.reshape(B, S, H, dh).transpose(0, 2, 1, 3)
    q, k, v = heads(q), heads(k), heads(v)
    log_f = jax.nn.log_sigmoid((f_logit + b_f).astype(jnp.float32))
    cum = jnp.cumsum(log_f, axis=1).transpose(0, 2, 1)
    n_qb = S // Q_BLOCK
    key_pos = jnp.arange(S)

    def blk(args):
        q_b, cum_b, start = args
        decay = cum_b[..., None] - cum[:, :, None, :]
        logits = jnp.einsum('bhqd,bhkd->bhqk', q_b, k).astype(jnp.float32) * scale + decay
        qpos = start + jnp.arange(Q_BLOCK)
        mask = key_pos[None, :] <= qpos[:, None]
        p = masked_softmax(logits, mask)
        return jnp.einsum('bhqk,bhkd->bhqd', p.astype(v.dtype), v)

    q_x = jnp.moveaxis(q.reshape(B, H, n_qb, Q_BLOCK, dh), 2, 0)
    c_x = jnp.moveaxis(cum.reshape(B, H, n_qb, Q_BLOCK), 2, 0)
    o = lax.map(blk, (q_x, c_x, jnp.arange(n_qb) * Q_BLOCK))
    o = o.transpose(1, 0, 3, 2, 4).reshape(B, S, Q_DIM)
    return o @ w_out


def setup_inputs(seed: int = 0) -> dict:
    key = jax.random.key(seed)
    ks = jax.random.split(key, 16)
    nrm = lambda k, shape, fan_in: jax.random.normal(k, shape, jnp.float32) * (fan_in ** -0.5)
    dh = HEAD_DIM
    return {
        "x": jax.random.normal(ks[0], (BATCH, SEQ, D_MODEL), jnp.float32),
        "norm_g": 1.0 + 0.05 * jax.random.normal(ks[1], (DEPTH, 6, D_MODEL), jnp.float32),
        "ffn_w_gate": nrm(ks[2], (DEPTH, 2, D_MODEL, D_FF), D_MODEL),
        "ffn_w_up": nrm(ks[3], (DEPTH, 2, D_MODEL, D_FF), D_MODEL),
        "ffn_w_down": nrm(ks[4], (DEPTH, 2, D_FF, D_MODEL), D_FF),
        "rel_bias": 0.5 * jax.random.normal(ks[5], (NUM_BUCKETS, N_HEADS), jnp.float32),
        "nsa_w_in": nrm(ks[6], (N_NSA_LAYERS, D_MODEL, NSA_IN_DIM), D_MODEL),
        "nsa_cmp_pe": 0.1 * jax.random.normal(ks[7], (N_NSA_LAYERS, 2, CMP_BLOCK, dh), jnp.float32),
        "nsa_cmp_w1": nrm(ks[8], (N_NSA_LAYERS, 2, CMP_BLOCK * dh, CMP_HIDDEN), CMP_BLOCK * dh),
        "nsa_cmp_b1": 0.01 * jax.random.normal(ks[9], (N_NSA_LAYERS, 2, CMP_HIDDEN), jnp.float32),
        "nsa_cmp_w2": nrm(ks[10], (N_NSA_LAYERS, 2, CMP_HIDDEN, dh), CMP_HIDDEN),
        "nsa_w_out": nrm(ks[11], (N_NSA_LAYERS, Q_DIM, D_MODEL), Q_DIM),
        "fox_w_in": nrm(ks[12], (N_FOX_LAYERS, D_MODEL, FOX_IN_DIM), D_MODEL),
        "fox_b_f": 2.0 + 0.1 * jax.random.normal(ks[13], (N_FOX_LAYERS, N_HEADS), jnp.float32),
        "fox_w_out": nrm(ks[14], (N_FOX_LAYERS, Q_DIM, D_MODEL), Q_DIM),
    }


def reference(x, norm_g, ffn_w_gate, ffn_w_up, ffn_w_down, rel_bias, nsa_w_in, nsa_cmp_pe,
              nsa_cmp_w1, nsa_cmp_b1, nsa_cmp_w2, nsa_w_out, fox_w_in, fox_b_f, fox_w_out):
    h = x
    for i in range(DEPTH):
        g = norm_g[i]
        j = i // N_MIXERS
        y = swiglu(rms_norm(h, g[0]), ffn_w_gate[i, 0], ffn_w_up[i, 0], ffn_w_down[i, 0])
        h = h + 0.5 * rms_norm(y, g[1])
        u = rms_norm(h, g[2])
        if i % N_MIXERS == 0:
            y = nsa_mixer(u, nsa_w_in[j], nsa_cmp_pe[j], nsa_cmp_w1[j], nsa_cmp_b1[j],
                          nsa_cmp_w2[j], nsa_w_out[j], rel_bias)
        else:
            y = fox_mixer(u, fox_w_in[j], fox_b_f[j], fox_w_out[j])
        h = h + rms_norm(y, g[3])
        y = swiglu(rms_norm(h, g[4]), ffn_w_gate[i, 1], ffn_w_up[i, 1], ffn_w_down[i, 1])
        h = h + 0.5 * rms_norm(y, g[5])
    return h
```

```cpp
#include <hip/hip_runtime.h>
#include <cstdio>
#include <cstdint>
namespace pg8 {
#define PG8_LAS __attribute__((address_space(3)))
typedef unsigned short bf16_t;
typedef short bf16x8 __attribute__((ext_vector_type(8)));
typedef float f32x4 __attribute__((ext_vector_type(4)));
typedef unsigned u32x4 __attribute__((ext_vector_type(4)));
constexpr int BM = 256, BK = 64, HALF = 128, HTB = HALF * BK * 2  , STAGE_BYTES = 8 * HTB, NXCD = 8, WGM = 8;

__host__ __device__ __forceinline__ int lds_byte(int r, int c) { const int st = (r >> 4) * 2 + (c >> 5), rr = r & 15, cc = c & 31, ob = rr * 64 + cc * 2; return st * 1024 + (ob ^ (((ob >> 9) & 1) << 5)); }
__host__ __device__ __forceinline__ void stage_rc(int b, int& R, int& C) { const int st = b / 1024, sb = b % 1024, swz = sb ^ (((sb >> 9) & 1) << 5); R = (st >> 1) * 16 + swz / 64; C = (st & 1) * 32 + (swz % 64) / 2; }
__host__ __device__ __forceinline__ int perm32(int rho) { const int n = rho >> 4, i = rho & 15; return 8 * (i >> 2) + 4 * n + (i & 3); }

struct Unit { int pm, pn; };
struct Gemm { const bf16_t* A; const bf16_t* Bt; int lda, ldb, K; };

struct StaticOrder {
    int nM, nN, nwg, G, c;
    __host__ __device__ void init(int M, int N, int G_, int c_) { nM = M / BM; nN = N / BM; nwg = nM * nN; G = G_; c = c_; }
    __host__ __device__ bool next(int i, Unit& u) const {
        const long L = (long)i * G + c; if (L >= nwg) return false;
        int wgid = (int)L; { const int q = nwg / NXCD, r = nwg % NXCD, xcd = wgid % NXCD, off = wgid / NXCD; wgid = (xcd < r ? xcd * (q + 1) : r * (q + 1) + (xcd - r) * q) + off; }
        const int nig = WGM * nN, gid = wgid / nig, fm = gid * WGM, gsz = (nM - fm) < WGM ? (nM - fm) : WGM;
        u.pm = fm + ((wgid % nig) % gsz); u.pn = (wgid % nig) / gsz; return true;
    }
    __device__ __forceinline__ void a_ready(const Unit&) const {}
    __device__ __forceinline__ void done(const Unit&) const {}
};

__device__ __forceinline__ unsigned cvt_pk_bf16(float lo, float hi) { unsigned r; asm volatile("v_cvt_pk_bf16_f32 %0, %1, %2" : "=v"(r) : "v"(lo), "v"(hi)); return r; }
typedef float f32x2 __attribute__((ext_vector_type(2)));
__device__ __forceinline__ f32x2 gelu_pk(f32x2 v) {
    const f32x2 av = __builtin_elementwise_abs(v), d = av * 0.2316418882f + 1.0f;
    f32x2 t; t.x = __builtin_amdgcn_rcpf(d.x); t.y = __builtin_amdgcn_rcpf(d.y);
    f32x2 q = t * 0.5307027145f + (-0.7265760135f); q = q * t + 0.7107068705f; q = q * t + (-0.142248368f); q = q * t + 0.127414796f; q = q * t;
    const f32x2 s = (v * v) * (-0.72134752044f);
    f32x2 e; e.x = __builtin_amdgcn_exp2f(s.x); e.y = __builtin_amdgcn_exp2f(s.y);
    const f32x2 m = v * (q * e), r = v - m;
    f32x2 o; o.x = v.x < 0.f ? m.x : r.x; o.y = v.y < 0.f ? m.y : r.y; return o;
}

template <class Epi, class Sched, bool ALIGN_EPI = false, bool SP2 = false>
__device__ __forceinline__ void gemm_phase(PG8_LAS unsigned char* lds, const Gemm g, const Sched& S, const Epi& E) {
    int tid = threadIdx.x; asm volatile("" : "+v"(tid));
    const int wid = __builtin_amdgcn_readfirstlane(tid >> 6), lane = tid & 63, wr = wid >> 2, wc = wid & 3, fr = lane & 15, fq = lane >> 4;
    const int K = g.K, nt = K / BK;
    unsigned voffA[2], voffB[2];
#pragma unroll
    for (int i = 0; i < 2; ++i) { int R, C; stage_rc(tid * 16 + i * 8192, R, C); const int Rb = Epi::PERM ? ((R & ~31) + perm32(R & 31)) : R;
        voffA[i] = (unsigned)(R * g.lda + C) * 2u; voffB[i] = (unsigned)(Rb * g.ldb + C) * 2u; }
    const size_t kstep = (size_t)(BK * 2);
    const size_t hstepA = (size_t)HALF * g.lda * 2, hstepB = (size_t)HALF * g.ldb * 2;
    const size_t tstepA = 2 * hstepA, tstepB = 2 * hstepB;
    const unsigned ldsw = (unsigned)wid * 1024u;
    const int aoff = lds_byte(wr * 64 + fr, fq * 8), boff = lds_byte(wc * 32 + fr, fq * 8);
#define PG8_SA(b, h) (((b) * 2 + (h)) * HTB)
#define PG8_SB(b, h) ((4 + (b) * 2 + (h)) * HTB)
#define PG8_STAGE(bufoff, gbase, voff) do { _Pragma("unroll") for (int _i = 0; _i < 2; ++_i) \
        __builtin_amdgcn_global_load_lds((const unsigned*)((const char*)(gbase) + (voff)[_i]), (PG8_LAS unsigned*)(lds + (bufoff) + ldsw + _i * 8192), 16, 0, 0); } while (0)
#define PG8_LDA(dst, b, h) do { _Pragma("unroll") for (int m = 0; m < 4; ++m) _Pragma("unroll") for (int k = 0; k < 2; ++k) dst[m][k] = *(const PG8_LAS bf16x8*)(lds + PG8_SA(b, h) + aoff + m * 2048 + k * 1024); } while (0)
#define PG8_LDB(dst, b, h) do { _Pragma("unroll") for (int n = 0; n < 2; ++n) _Pragma("unroll") for (int k = 0; k < 2; ++k) dst[n][k] = *(const PG8_LAS bf16x8*)(lds + PG8_SB(b, h) + boff + n * 2048 + k * 1024); } while (0)
#define PG8_MMA(ai, bj, At, Bt) do { __builtin_amdgcn_s_setprio(1); _Pragma("unroll") for (int m = 0; m < 4; ++m) _Pragma("unroll") for (int n = 0; n < 2; ++n) _Pragma("unroll") for (int k = 0; k < 2; ++k) \
        acc[ai][bj][m][n] = __builtin_amdgcn_mfma_f32_16x16x32_bf16(Bt[n][k], At[m][k], acc[ai][bj][m][n], 0, 0, 0); __builtin_amdgcn_s_setprio(0); } while (0)
#define PG8_WAIT_V(n) asm volatile("s_waitcnt vmcnt(" #n ")" ::: "memory")
#define PG8_WAIT_L(n) asm volatile("s_waitcnt lgkmcnt(" #n ")" ::: "memory")
#define PG8_BAR __builtin_amdgcn_s_barrier()
#define PG8_SCHED __builtin_amdgcn_sched_barrier(0)
    Unit cur, nxt; int ui = 0;
    if (!S.next(0, cur)) return;
    f32x4 acc[2][2][4][2];
#pragma unroll
    for (int a = 0; a < 2; ++a)
#pragma unroll
        for (int b = 0; b < 2; ++b)
#pragma unroll
            for (int m = 0; m < 4; ++m)
#pragma unroll
                for (int n = 0; n < 2; ++n) acc[a][b][m][n] = (f32x4){0.f, 0.f, 0.f, 0.f};
    bf16x8 At[4][2], B0[2][2], B1[2][2];
    const char* cA = (const char*)g.A + (size_t)cur.pm * tstepA; const char* cB = (const char*)g.Bt + (size_t)cur.pn * tstepB;
    S.a_ready(cur);
    if constexpr (SP2) {
        PG8_STAGE(PG8_SB(0, 0), cB, voffB); PG8_STAGE(PG8_SB(0, 1), cB + hstepB, voffB); PG8_STAGE(PG8_SA(0, 0), cA, voffA); PG8_STAGE(PG8_SA(0, 1), cA + hstepA, voffA);
        if (wr == 1) PG8_BAR;
        PG8_WAIT_V(2); PG8_BAR;
        PG8_STAGE(PG8_SB(1, 0), cB + kstep, voffB); PG8_STAGE(PG8_SA(1, 0), cA + kstep, voffA); PG8_STAGE(PG8_SB(1, 1), cB + hstepB + kstep, voffB);
        PG8_WAIT_V(6); PG8_BAR;
    } else {
        PG8_STAGE(PG8_SB(0, 0), cB, voffB); PG8_STAGE(PG8_SA(0, 0), cA, voffA); PG8_STAGE(PG8_SB(0, 1), cB + hstepB, voffB); PG8_STAGE(PG8_SA(0, 1), cA + hstepA, voffA);
        if (wr == 1) PG8_BAR;
        PG8_WAIT_V(4); PG8_BAR;
        PG8_STAGE(PG8_SB(1, 0), cB + kstep, voffB); PG8_STAGE(PG8_SA(1, 0), cA + kstep, voffA); PG8_STAGE(PG8_SB(1, 1), cB + hstepB + kstep, voffB);
        PG8_WAIT_V(6); PG8_BAR;
    }
    for (;;) {
        const bool has_next = S.next(ui + 1, nxt);
        const char* nA = has_next ? (const char*)g.A + (size_t)nxt.pm * tstepA : cA; const char* nB = has_next ? (const char*)g.Bt + (size_t)nxt.pn * tstepB : cB;
        for (int t = 0; t < nt; t += 2) {
            const bool last = (t == nt - 2);
            const char* a1 = cA + (size_t)(t + 1) * kstep;
            const char* a2 = last ? nA : cA + (size_t)(t + 2) * kstep; const char* b2 = last ? nB : cB + (size_t)(t + 2) * kstep;
            const char* a3 = a2 + kstep; const char* b3 = b2 + kstep;
            if (last && has_next) S.a_ready(nxt);
            if constexpr (SP2) {
            PG8_LDB(B0, 0, 0); PG8_LDB(B1, 0, 1); PG8_SCHED; PG8_LDA(At, 0, 0); PG8_STAGE(PG8_SA(1, 1), a1 + hstepA, voffA);
            PG8_WAIT_V(8); PG8_WAIT_L(0); PG8_BAR; PG8_MMA(0, 0, At, B0); PG8_MMA(0, 1, At, B1); PG8_BAR; PG8_SCHED;
            PG8_LDA(At, 0, 1); PG8_STAGE(PG8_SB(0, 0), b2, voffB); PG8_STAGE(PG8_SB(0, 1), b2 + hstepB, voffB); PG8_STAGE(PG8_SA(0, 0), a2, voffA);
            PG8_WAIT_V(8); PG8_WAIT_L(0); PG8_BAR; PG8_MMA(1, 0, At, B0); PG8_MMA(1, 1, At, B1); PG8_BAR; PG8_SCHED;
            PG8_LDB(B0, 1, 0); PG8_LDB(B1, 1, 1); PG8_SCHED; PG8_LDA(At, 1, 0); PG8_STAGE(PG8_SA(0, 1), a2 + hstepA, voffA);
            PG8_WAIT_V(8); PG8_WAIT_L(0); PG8_BAR; PG8_MMA(0, 0, At, B0); PG8_MMA(0, 1, At, B1); PG8_BAR; PG8_SCHED;
            PG8_LDA(At, 1, 1); PG8_STAGE(PG8_SB(1, 0), b3, voffB); PG8_STAGE(PG8_SB(1, 1), b3 + hstepB, voffB); PG8_STAGE(PG8_SA(1, 0), a3, voffA);
            PG8_WAIT_V(8); PG8_WAIT_L(0); PG8_BAR; PG8_MMA(1, 0, At, B0); PG8_MMA(1, 1, At, B1); PG8_BAR; PG8_SCHED;
            } else {
            PG8_LDB(B0, 0, 0); PG8_SCHED; PG8_LDA(At, 0, 0); PG8_STAGE(PG8_SA(1, 1), a1 + hstepA, voffA);
            PG8_WAIT_L(8); PG8_BAR; PG8_WAIT_L(0); PG8_MMA(0, 0, At, B0); PG8_BAR; PG8_SCHED;
            PG8_LDB(B1, 0, 1); PG8_STAGE(PG8_SB(0, 0), b2, voffB);
            PG8_BAR; PG8_WAIT_L(0); PG8_MMA(0, 1, At, B1); PG8_BAR;
            PG8_LDA(At, 0, 1); PG8_STAGE(PG8_SA(0, 0), a2, voffA);
            PG8_BAR; PG8_WAIT_L(0); PG8_MMA(1, 0, At, B0); PG8_BAR; PG8_SCHED;
            PG8_STAGE(PG8_SB(0, 1), b2 + hstepB, voffB);
            PG8_WAIT_V(6); PG8_BAR; PG8_MMA(1, 1, At, B1); PG8_BAR;
            PG8_LDB(B0, 1, 0); PG8_SCHED; PG8_LDA(At, 1, 0); PG8_STAGE(PG8_SA(0, 1), a2 + hstepA, voffA);
            PG8_WAIT_L(8); PG8_BAR; PG8_WAIT_L(0); PG8_MMA(0, 0, At, B0); PG8_BAR; PG8_SCHED;
            PG8_LDB(B1, 1, 1); PG8_STAGE(PG8_SB(1, 0), b3, voffB);
            PG8_BAR; PG8_WAIT_L(0); PG8_MMA(0, 1, At, B1); PG8_BAR;
            PG8_LDA(At, 1, 1); PG8_STAGE(PG8_SA(1, 0), a3, voffA);
            PG8_BAR; PG8_WAIT_L(0); PG8_MMA(1, 0, At, B0); PG8_BAR; PG8_SCHED;
            PG8_STAGE(PG8_SB(1, 1), b3 + hstepB, voffB);
            PG8_WAIT_V(6); PG8_BAR; PG8_MMA(1, 1, At, B1); PG8_BAR;
            }
        }
        if constexpr (ALIGN_EPI) { if (wr == 0) PG8_BAR; }
        if constexpr (!Epi::AFTER_DRAIN) { E(acc, cur, wr, wc, fr, fq); S.done(cur); }
        if (!has_next) break;
#pragma unroll
        for (int a = 0; a < 2; ++a)
#pragma unroll
            for (int b = 0; b < 2; ++b)
#pragma unroll
                for (int m = 0; m < 4; ++m)
#pragma unroll
                    for (int n = 0; n < 2; ++n) acc[a][b][m][n] = (f32x4){0.f, 0.f, 0.f, 0.f};
        cur = nxt; cA = nA; cB = nB; ++ui;
        if constexpr (ALIGN_EPI) { if (wr == 1) PG8_BAR; }
    }
    PG8_WAIT_V(0);
    if constexpr (!ALIGN_EPI) { if (wr == 0) PG8_BAR; }
    PG8_BAR;
    if constexpr (Epi::AFTER_DRAIN) { E.fused(acc, cur, wr, wc, fr, fq, lds, wid, lane); S.done(cur); }
#undef PG8_SA
#undef PG8_SB
#undef PG8_STAGE
#undef PG8_LDA
#undef PG8_LDB
#undef PG8_MMA
#undef PG8_WAIT_V
#undef PG8_WAIT_L
#undef PG8_BAR
#undef PG8_SCHED
}
}
#include <hip/hip_bf16.h>
#include <cmath>
namespace attn_body {
using bf16=__hip_bfloat16;
using bf16x8=__attribute__((ext_vector_type(8)))short;
using s16x4=__attribute__((ext_vector_type(4)))short;
using f32x16=__attribute__((ext_vector_type(16)))float;
using u32x4=__attribute__((ext_vector_type(4)))unsigned;
constexpr int BATCH=8,NHEAD=16,SEQ=2048,D=64,DM=NHEAD*D;
constexpr int NW=8,QBLK=32,QB=QBLK*NW,KVBLK=64,NQB=SEQ/QB;
constexpr int ATTN_PITCH=DM, ATTN_UNIT_ROWS=QB;
__device__ __forceinline__ int crow(int r,int hi){return (r&3)+8*(r>>2)+4*hi;}
#define SBAR() __builtin_amdgcn_sched_barrier(0)
__device__ __forceinline__ void cmask(f32x16&p0,f32x16&p1,int jb,int qrel,int hi){
  const float NEG=-INFINITY; int kb=64*jb+4*hi;
  #pragma unroll
  for(int r=0;r<16;++r){int kv=kb+(r&3)+8*(r>>2); if(kv>qrel)p0[r]=NEG; if(kv+32>qrel)p1[r]=NEG;}
}

constexpr int NSLOT=3, SLOTB=8192;
constexpr int LDS_K=0, LDS_V=NSLOT*SLOTB, LDS_WS=2*NSLOT*SLOTB, LDS_OST=LDS_WS+NW*64*4, LDS_BYTES=LDS_OST+NW*4096;
constexpr float C2=0.125f*1.4426950408889634f;
__device__ __forceinline__ void glds16(const void*gsrc,unsigned lds_dst){unsigned keep;
  asm volatile("s_mov_b32 %0, m0\n\ts_mov_b32 m0, %2\n\ts_nop 0\n\tglobal_load_lds_dwordx4 %1, off\n\ts_mov_b32 m0, %0":"=&s"(keep):"v"(gsrc),"s"(lds_dst):"memory");}
__device__ __forceinline__ void glds16s(const void*sbase,unsigned voff,unsigned lds_dst){unsigned keep;
  asm volatile("s_mov_b32 %0, m0\n\ts_mov_b32 m0, %2\n\ts_nop 0\n\tglobal_load_lds_dwordx4 %1, %3\n\ts_mov_b32 m0, %0":"=&s"(keep):"v"(voff),"s"(lds_dst),"s"(sbase):"memory");}
__device__ __forceinline__ float max3f(float a,float b,float c){float r;asm("v_max3_f32 %0, %1, %2, %3":"=v"(r):"v"(a),"v"(b),"v"(c));return r;}
__device__ __forceinline__ float max2f(float a,float b){float r;asm("v_max_f32_e32 %0, %1, %2":"=v"(r):"v"(a),"v"(b));return r;}
__device__ __forceinline__ float fadd_s(float a,float b){float r;asm("v_add_f32_e32 %0, %1, %2":"=v"(r):"v"(a),"v"(b));return r;}
__device__ __forceinline__ float fsub_s(float a,float b){float r;asm("v_sub_f32_e32 %0, %1, %2":"=v"(r):"v"(a),"v"(b));return r;}
typedef float f32x2_t __attribute__((ext_vector_type(2))); typedef __bf16 bf16x2_t __attribute__((ext_vector_type(2)));
__device__ __forceinline__ unsigned cvtpk_s(float lo,float hi){f32x2_t v={lo,hi};bf16x2_t b=__builtin_convertvector(v,bf16x2_t);return __builtin_bit_cast(unsigned,b);}
#define WAIT_BAR(N) asm volatile("s_waitcnt vmcnt(" #N ") lgkmcnt(0)\n\ts_barrier":::"memory")

__device__ __forceinline__ void qkt(f32x16&p0,f32x16&p1,const char*Kslot,const bf16x8*qr,const f32x16&negm,int r32,int hi){
  const char*kb=Kslot+hi*1024+r32*16;
  #pragma unroll
  for(int d0=0;d0<4;++d0){
    const bf16x8 b0=*reinterpret_cast<const bf16x8*>(kb+d0*2048);
    const bf16x8 b1=*reinterpret_cast<const bf16x8*>(kb+d0*2048+512);
    if(d0==0){p0=__builtin_amdgcn_mfma_f32_32x32x16_bf16(b0,qr[0],negm,0,0,0);p1=__builtin_amdgcn_mfma_f32_32x32x16_bf16(b1,qr[0],negm,0,0,0);}
    else{p0=__builtin_amdgcn_mfma_f32_32x32x16_bf16(b0,qr[d0],p0,0,0,0);p1=__builtin_amdgcn_mfma_f32_32x32x16_bf16(b1,qr[d0],p1,0,0,0);}}
}
typedef __attribute__((address_space(3))) const char* lds_cptr;
typedef short v4i16_t __attribute__((ext_vector_type(4)));
__device__ __forceinline__ void kload8(bf16x8*kf,lds_cptr kp){
  kf[0]=*(const __attribute__((address_space(3))) bf16x8*)(kp);      kf[1]=*(const __attribute__((address_space(3))) bf16x8*)(kp+512);
  kf[2]=*(const __attribute__((address_space(3))) bf16x8*)(kp+2048); kf[3]=*(const __attribute__((address_space(3))) bf16x8*)(kp+2560);
  kf[4]=*(const __attribute__((address_space(3))) bf16x8*)(kp+4096); kf[5]=*(const __attribute__((address_space(3))) bf16x8*)(kp+4608);
  kf[6]=*(const __attribute__((address_space(3))) bf16x8*)(kp+6144); kf[7]=*(const __attribute__((address_space(3))) bf16x8*)(kp+6656);
}
__device__ __forceinline__ void kload2(bf16x8*kf,lds_cptr kp,int j){ kf[2*j]=*(const __attribute__((address_space(3))) bf16x8*)(kp+j*2048); kf[2*j+1]=*(const __attribute__((address_space(3))) bf16x8*)(kp+j*2048+512); }
__device__ __forceinline__ s16x4 vtr(lds_cptr p){ return __builtin_bit_cast(s16x4,__builtin_amdgcn_ds_read_tr16_b64_v4i16((__attribute__((address_space(3))) v4i16_t*)p)); }
__device__ __forceinline__ float rowmax(const f32x16&p0,const f32x16&p1){
  float a=max3f(p0[0],p0[1],p1[0]),b=max3f(p0[2],p0[3],p1[1]);a=max3f(a,p1[2],p1[3]);
  #pragma unroll
  for(int r=4;r<16;r+=4){a=max3f(a,p0[r],p0[r+1]);b=max3f(b,p0[r+2],p0[r+3]);a=max3f(a,p1[r],p1[r+1]);b=max3f(b,p1[r+2],p1[r+3]);}
  const float m=max2f(a,b);
  auto rr=__builtin_amdgcn_permlane32_swap(__float_as_uint(m),__float_as_uint(m),false,false);
  return max2f(__uint_as_float(rr[0]),__uint_as_float(rr[1]));
}
__device__ __forceinline__ void pv(f32x16*o,int vb,bf16x8 pa0,bf16x8 pa1,bf16x8 pa2,bf16x8 pa3){
  #pragma unroll
  for(int d0=0;d0<2;++d0){s16x4 lo[4],hi[4];
    #pragma unroll
    for(int ks=0;ks<4;++ks){
      asm volatile("ds_read_b64_tr_b16 %0,%1 offset:%c2":"=&v"(lo[ks]):"v"(vb),"i"(d0*4096+ks*1024):"memory");
      asm volatile("ds_read_b64_tr_b16 %0,%1 offset:%c2":"=&v"(hi[ks]):"v"(vb),"i"(d0*4096+ks*1024+512):"memory");}
    asm volatile("s_waitcnt lgkmcnt(0)":::"memory");SBAR();
    #define PK(k) (bf16x8){lo[k][0],lo[k][1],lo[k][2],lo[k][3],hi[k][0],hi[k][1],hi[k][2],hi[k][3]}
    o[d0]=__builtin_amdgcn_mfma_f32_32x32x16_bf16(pa0,PK(0),o[d0],0,0,0);
    o[d0]=__builtin_amdgcn_mfma_f32_32x32x16_bf16(pa1,PK(1),o[d0],0,0,0);
    o[d0]=__builtin_amdgcn_mfma_f32_32x32x16_bf16(pa2,PK(2),o[d0],0,0,0);
    o[d0]=__builtin_amdgcn_mfma_f32_32x32x16_bf16(pa3,PK(3),o[d0],0,0,0);
    #undef PK
  }
}

#ifndef ATTN_STORE16
#define ATTN_STORE16(p,v) (*(u32x4*)(p)=(v))
#endif
template<int THRL,int VAR=0> __device__ __forceinline__ void attn_unit(int b,int h,int qb,const bf16*Q,const bf16*__restrict__ K,const bf16*__restrict__ V,bf16*O,char*shm,const __attribute__((address_space(3))) float*cumL,int tskip){
  int tid=threadIdx.x; asm volatile("":"+v"(tid));
  const int lane=tid&63,r32=lane&31,hi=lane>>5; const int wid=__builtin_amdgcn_readfirstlane(tid>>6);
  const long rowbase=(long)b*SEQ; const int q0=qb*QB;
  const bf16*Qw=Q+(rowbase+q0+wid*QBLK)*DM+h*D;
  const bf16*Kh=K+(rowbase+(long)tskip*KVBLK)*DM+h*D,*Vh=V+(rowbase+(long)tskip*KVBLK)*DM+h*D;
  const unsigned lds0=(unsigned)(uintptr_t)shm;
  float*wsf=(float*)(shm+LDS_WS)+wid*64;
  const bf16*ksrc=Kh+(long)lane*DM+wid*8;
  const bf16*vsrc=Vh+(long)(16*(wid&3)+(lane>>2))*DM+(wid>>2)*32+(lane&3)*8;
  const unsigned kdst=lds0+LDS_K+wid*1024, vdst=lds0+LDS_V+wid*1024;
  #define DMA_K(t,slot) glds16(ksrc+(long)(t)*KVBLK*DM,(unsigned)__builtin_amdgcn_readfirstlane(kdst+(slot)))
  #define DMA_V(t,slot) glds16(vsrc+(long)(t)*KVBLK*DM,(unsigned)__builtin_amdgcn_readfirstlane(vdst+(slot)))
  const int vb0=(int)(lds0+LDS_V)+((lane>>4)&1)*32+(lane&3)*8+(4*hi+((lane&15)>>2))*64;
  const char*Kbase=shm+LDS_K; bf16x8 kf[8];
  const lds_cptr shm3=(lds_cptr)shm; const lds_cptr kp0=shm3+LDS_K+hi*1024+r32*16; const lds_cptr vp0=shm3+LDS_V+((lane>>4)&1)*32+(lane&3)*8+(4*hi+((lane&15)>>2))*64;
  const int NT=(q0+QB)/KVBLK-tskip;
  DMA_K(0,0);DMA_V(0,0);DMA_K(1,SLOTB);
  bf16x8 qr[4];
  #pragma unroll
  for(int d0=0;d0<4;++d0)qr[d0]=*reinterpret_cast<const bf16x8*>(&Qw[(long)r32*DM+d0*16+hi*8]);
  const float cq=cumL[qb*QB+wid*QBLK+r32];
  float mhat=0.f,l_reg=0.f;f32x16 o[2];o[0]=f32x16{};o[1]=f32x16{};const f32x16 negm=f32x16{};
  typedef float f32x4_t __attribute__((ext_vector_type(4)));
  #define KBIAS(P0,P1,t) do{ if(VAR&1){ const float nm1_=cq-mhat; _Pragma("unroll") for(int r_=0;r_<16;++r_){P0[r_]+=nm1_;P1[r_]+=nm1_;} break; } const float nm_=cq-mhat; const __attribute__((address_space(3))) float*cb_=cumL+64*((t)+tskip)+4*hi; \
    _Pragma("unroll") for(int g_=0;g_<4;++g_){ const f32x4_t k0_=*(const __attribute__((address_space(3))) f32x4_t*)(cb_+8*g_); const f32x4_t k1_=*(const __attribute__((address_space(3))) f32x4_t*)(cb_+32+8*g_); \
      _Pragma("unroll") for(int e_=0;e_<4;++e_){ P0[4*g_+e_]+=(nm_-k0_[e_]); P1[4*g_+e_]+=(nm_-k1_[e_]); } } }while(0)
  const int qrel=wid*QBLK+r32;
  #define CMASK(P0,P1,t) do{int jb_=(t)-(NT-4); if(jb_>=0)cmask(P0,P1,jb_,qrel,hi);}while(0)
  bool resc=false;
  #define START(P0,P1) do{ const float rm=rowmax(P0,P1); resc=false; \
    { const float dl=rm; mhat=fadd_s(mhat,dl); \
      _Pragma("unroll") for(int r=0;r<16;++r){P0[r]=fsub_s(P0[r],dl);P1[r]=fsub_s(P1[r],dl);} \
      } \
    _Pragma("unroll") for(int r=0;r<16;++r)P0[r]=__builtin_amdgcn_exp2f(P0[r]); }while(0)
  #define RESC() do{ if(resc){ asm volatile("s_waitcnt lgkmcnt(0)":::"memory"); \
      _Pragma("unroll") for(int d_=0;d_<2;++d_) _Pragma("unroll") for(int r=0;r<16;++r)o[d_][r]*=wsf[crow(r,hi)]; } }while(0)
  f32x16 pA0,pA1,pB0,pB1;
  int sl_prev=0,sl_cur=0,sl_next=SLOTB;
  #define ROT() do{sl_prev=sl_cur;sl_cur=sl_next;sl_next=(sl_next==(NSLOT-1)*SLOTB)?0:sl_next+SLOTB;}while(0)
  DMA_K(2,2*SLOTB);
  WAIT_BAR(3);
  qkt(pA0,pA1,Kbase,qr,negm,r32,hi);asm volatile("s_nop 15\n\ts_nop 7":"+v"(pA0),"+v"(pA1));KBIAS(pA0,pA1,0);CMASK(pA0,pA1,0);
  START(pA0,pA1);
  _Pragma("unroll") for(int r=0;r<16;++r)pA1[r]=__builtin_amdgcn_exp2f(pA1[r]);
  WAIT_BAR(0);
  DMA_K(3,0);DMA_V(1,SLOTB);
  ROT();
  kload8(kf,kp0+sl_cur);
  WAIT_BAR(2);
  s16x4 vlo[8],vhi[8]; u32x4 pw0,pw1,pw2,pw3;
  #define PKW(P,B) cvtpk_s(P[B],P[B+1])
  #define PAF(k) __builtin_bit_cast(bf16x8,pw##k)
  #define VFR(i) (bf16x8){vlo[i][0],vlo[i][1],vlo[i][2],vlo[i][3],vhi[i][0],vhi[i][1],vhi[i][2],vhi[i][3]}
  #define PIN(x) asm volatile("":"+v"(x))
  #define MX3(a,b,c) __builtin_fmaxf(__builtin_fmaxf((a),(b)),(c))
  #define GAPA(MF,A0,A1,A2,A3,W0,W1,PW) do{ MF; sacc+=A0; sacc+=A1; sacc+=A2; sacc+=A3; PIN(sacc); W0; W1; PIN(PW); SBAR(); }while(0)
  #define EX(v) __builtin_amdgcn_exp2f(v)
  #define GAPB(MF,X,B) do{ MF; X[B]=EX(X[B]); X[B+1]=EX(X[B+1]); X[B+2]=EX(X[B+2]); X[B+3]=EX(X[B+3]); PIN(X); SBAR(); }while(0)
  #define VRD(i) do{ vlo[i]=vtr(vp_+(((i)>>2)*4096+((i)&3)*1024)); vhi[i]=vtr(vp_+(((i)>>2)*4096+((i)&3)*1024+512)); }while(0)
  #define KRD(G,j) do{ if(G){ kload2(kf,kp0+sl_next,j); SBAR(); } }while(0)
  #define STEP(C0,C1,P0,P1,t,GK,GV,GL) do{ SBAR(); \
    const lds_cptr vp_=vp0+sl_prev; \
    VRD(0); SBAR(); float sacc=(P0[0]+P0[1]); \
    GAPA(C0=__builtin_amdgcn_mfma_f32_32x32x16_bf16(kf[0],qr[0],negm,0,0,0), P0[2],P0[3],P0[4],P0[5],     pw0[0]=PKW(P0,0), pw0[1]=PKW(P0,2), pw0); \
    VRD(4); SBAR(); GAPA(C1=__builtin_amdgcn_mfma_f32_32x32x16_bf16(kf[1],qr[0],negm,0,0,0), P0[6],P0[7],P0[8],P0[9],     pw0[2]=PKW(P0,4), pw0[3]=PKW(P0,6), pw0); \
    VRD(1); SBAR(); GAPA(C0=__builtin_amdgcn_mfma_f32_32x32x16_bf16(kf[2],qr[1],C0,0,0,0),   P0[10],P0[11],P0[12],P0[13], pw1[0]=PKW(P0,8), pw1[1]=PKW(P0,10), pw1); \
    VRD(5); SBAR(); GAPA(C1=__builtin_amdgcn_mfma_f32_32x32x16_bf16(kf[3],qr[1],C1,0,0,0),   P0[14],P0[15],P1[0],P1[1],   pw1[2]=PKW(P0,12),pw1[3]=PKW(P0,14), pw1); \
    VRD(2); SBAR(); GAPA(C0=__builtin_amdgcn_mfma_f32_32x32x16_bf16(kf[4],qr[2],C0,0,0,0),   P1[2],P1[3],P1[4],P1[5],     pw2[0]=PKW(P1,0), pw2[1]=PKW(P1,2), pw2); \
    VRD(6); SBAR(); GAPA(C1=__builtin_amdgcn_mfma_f32_32x32x16_bf16(kf[5],qr[2],C1,0,0,0),   P1[6],P1[7],P1[8],P1[9],     pw2[2]=PKW(P1,4), pw2[3]=PKW(P1,6), pw2); \
    VRD(3); SBAR(); GAPA(C0=__builtin_amdgcn_mfma_f32_32x32x16_bf16(kf[6],qr[3],C0,0,0,0),   P1[10],P1[11],P1[12],P1[13], pw3[0]=PKW(P1,8), pw3[1]=PKW(P1,10), pw3); \
    VRD(7); SBAR(); GAPA(C1=__builtin_amdgcn_mfma_f32_32x32x16_bf16(kf[7],qr[3],C1,0,0,0),   P1[14],P1[15],0.f,0.f,       pw3[2]=PKW(P1,12),pw3[3]=PKW(P1,14), pw3); \
    l_reg+=sacc; \
    if(GK){DMA_K((t)+3,sl_cur);} if(GV){DMA_V((t)+1,sl_next);} \
    KBIAS(C0,C1,t); CMASK(C0,C1,t); \
    { float a=MX3(C0[0],C0[1],C1[0]),b=MX3(C0[2],C0[3],C1[1]); a=MX3(a,C1[2],C1[3]); \
      _Pragma("unroll") for(int r=4;r<16;r+=4){a=MX3(a,C0[r],C0[r+1]);b=MX3(b,C0[r+2],C0[r+3]);a=MX3(a,C1[r],C1[r+1]);b=MX3(b,C1[r+2],C1[r+3]);} \
      float rm=__builtin_fmaxf(a,b); { auto rr=__builtin_amdgcn_permlane32_swap(__float_as_uint(rm),__float_as_uint(rm),false,false); rm=__builtin_fmaxf(__uint_as_float(rr[0]),__uint_as_float(rr[1])); } \
      resc=false; \
      if(__builtin_expect(__any(rm>(float)THRL),0)){ const float dl=__builtin_fmaxf(rm,0.f); mhat+=dl; \
        _Pragma("unroll") for(int r=0;r<16;++r){C0[r]-=dl;C1[r]-=dl;} \
        const float f=__builtin_amdgcn_exp2f(-dl); l_reg*=f; if(hi==0)wsf[r32]=f; resc=true; } } \
    SBAR(); \
    GAPB(o[0]=__builtin_amdgcn_mfma_f32_32x32x16_bf16(PAF(0),VFR(0),o[0],0,0,0), C0,0); \
    GAPB(o[1]=__builtin_amdgcn_mfma_f32_32x32x16_bf16(PAF(0),VFR(4),o[1],0,0,0), C0,4); \
    KRD(GL,0); GAPB(o[0]=__builtin_amdgcn_mfma_f32_32x32x16_bf16(PAF(1),VFR(1),o[0],0,0,0), C0,8); \
    KRD(GL,1); GAPB(o[1]=__builtin_amdgcn_mfma_f32_32x32x16_bf16(PAF(1),VFR(5),o[1],0,0,0), C0,12); \
    KRD(GL,2); GAPB(o[0]=__builtin_amdgcn_mfma_f32_32x32x16_bf16(PAF(2),VFR(2),o[0],0,0,0), C1,0); \
    KRD(GL,3); GAPB(o[1]=__builtin_amdgcn_mfma_f32_32x32x16_bf16(PAF(2),VFR(6),o[1],0,0,0), C1,4); \
    GAPB(o[0]=__builtin_amdgcn_mfma_f32_32x32x16_bf16(PAF(3),VFR(3),o[0],0,0,0), C1,8); \
    GAPB(o[1]=__builtin_amdgcn_mfma_f32_32x32x16_bf16(PAF(3),VFR(7),o[1],0,0,0), C1,12); \
    }while(0)
  int t=1;
  #undef CMASK
  #define CMASK(P0,P1,t) do{}while(0)
  for(;t+5<NT;t+=2){
    STEP(pB0,pB1,pA0,pA1,t,true,true,true);     WAIT_BAR(2); RESC(); ROT();
    STEP(pA0,pA1,pB0,pB1,t+1,true,true,true);   WAIT_BAR(2); RESC(); ROT();
  }
  #undef CMASK
  #define CMASK(P0,P1,t) do{int jb_=(t)-(NT-4); if(jb_>=0)cmask(P0,P1,jb_,qrel,hi);}while(0)
  #define ENDW(tt) do{ if((tt)+3<NT){WAIT_BAR(2);} else if((tt)+2<NT){WAIT_BAR(1);} else {WAIT_BAR(0);} }while(0)
  for(;t+1<NT;t+=2){
    STEP(pB0,pB1,pA0,pA1,t,(t+3<NT),(t+1<NT),(t+1<NT));       ENDW(t);   RESC(); ROT();
    STEP(pA0,pA1,pB0,pB1,t+1,(t+4<NT),(t+2<NT),(t+2<NT));     ENDW(t+1); RESC(); ROT();
  }
  STEP(pB0,pB1,pA0,pA1,NT-1,false,false,false); RESC();
  { float sacc=pB0[0]+pB0[1]; _Pragma("unroll") for(int r=2;r<16;++r)sacc+=pB0[r]; _Pragma("unroll") for(int r=0;r<16;++r)sacc+=pB1[r]; l_reg+=sacc;
    pw0=(u32x4){PKW(pB0,0),PKW(pB0,2),PKW(pB0,4),PKW(pB0,6)};pw1=(u32x4){PKW(pB0,8),PKW(pB0,10),PKW(pB0,12),PKW(pB0,14)};pw2=(u32x4){PKW(pB1,0),PKW(pB1,2),PKW(pB1,4),PKW(pB1,6)};pw3=(u32x4){PKW(pB1,8),PKW(pB1,10),PKW(pB1,12),PKW(pB1,14)};
    SBAR(); pv(o,vb0+sl_cur,PAF(0),PAF(1),PAF(2),PAF(3)); }
  #undef PKW
  #undef PAF
  #undef VFR
  #undef PIN
  #undef MX3
  #undef GAPA
  #undef GAPB
  #undef EX
  #undef VRD
  #undef KRD
  #undef STEP
  #undef ENDW
  {auto rr=__builtin_amdgcn_permlane32_swap(__float_as_uint(l_reg),__float_as_uint(l_reg),false,false);l_reg=__uint_as_float(rr[0])+__uint_as_float(rr[1]);}
  if(hi==0)wsf[32+r32]=l_reg;asm volatile("s_waitcnt lgkmcnt(0)":::"memory");
  float rli[16];
  #pragma unroll
  for(int r=0;r<16;++r)rli[r]=__builtin_amdgcn_rcpf(wsf[32+crow(r,hi)]);
  bf16*Ow=O+(rowbase+q0+wid*QBLK)*DM+h*D;
  { bf16*stg=(bf16*)(shm+LDS_OST)+wid*2048;
    #pragma unroll
    for(int r=0;r<16;++r){const int orow=crow(r,hi);
      #pragma unroll
      for(int d0=0;d0<2;++d0)stg[orow*64+d0*32+r32]=__float2bfloat16(o[d0][r]*rli[r]);}
    asm volatile("s_waitcnt lgkmcnt(0)":::"memory");
    #pragma unroll
    for(int i=0;i<4;++i){const int row=i*8+(lane>>3),ch=lane&7; const u32x4 v=*(const u32x4*)(stg+row*64+ch*8); ATTN_STORE16(Ow+(long)row*DM+ch*8,v);} }
  asm volatile("s_waitcnt lgkmcnt(0)\n\ts_barrier":::"memory");
  #undef KBIAS
  #undef DMA_K
  #undef DMA_V
  #undef CMASK
  #undef START
  #undef RESC
  #undef ROT
}
template<bool WIN,int THRL> __device__ __forceinline__ void nsa_branch_pipe(const bf16*__restrict__ Kb,const bf16*__restrict__ Vb,const __attribute__((address_space(3))) int*tl,int NT,int qc,const bf16x8*qr,unsigned selbits,
    const __attribute__((address_space(3))) float*luth,char*shm,float&l_out,f32x16(&o)[2]){
  int tid=threadIdx.x; asm volatile("":"+v"(tid));
  const int lane=tid&63,r32=lane&31,hi=lane>>5; const int wid=__builtin_amdgcn_readfirstlane(tid>>6);
  const unsigned lds0=(unsigned)(uintptr_t)shm;
  float*wsf=(float*)(shm+LDS_WS)+wid*64;
  const unsigned koff=(unsigned)(lane*64+wid*8)*2u, voff=(unsigned)((16*(wid&3)+(lane>>2))*64+(wid>>2)*32+(lane&3)*8)*2u;
  #define TLJ(t) (__builtin_amdgcn_readfirstlane(tl[t])&63)
  const unsigned kdst=lds0+LDS_K+wid*1024, vdst=lds0+LDS_V+wid*1024;
  #define DMA_K(t,slot) glds16s((const char*)Kb+(size_t)TLJ(t)*8192,koff,(unsigned)__builtin_amdgcn_readfirstlane(kdst+(slot)))
  #define DMA_V(t,slot) glds16s((const char*)Vb+(size_t)TLJ(t)*8192,voff,(unsigned)__builtin_amdgcn_readfirstlane(vdst+(slot)))
  const int vb0=(int)(lds0+LDS_V)+((lane>>4)&1)*32+(lane&3)*8+(4*hi+((lane&15)>>2))*64;
  const char*Kbase=shm+LDS_K; bf16x8 kf[8];
  const lds_cptr shm3=(lds_cptr)shm; const lds_cptr kp0=shm3+LDS_K+hi*1024+r32*16; const lds_cptr vp0=shm3+LDS_V+((lane>>4)&1)*32+(lane&3)*8+(4*hi+((lane&15)>>2))*64;
  DMA_K(0,0);DMA_V(0,0);DMA_K(1,SLOTB);
  const int qi=(wid&1)*QBLK+r32;
  float mhat=0.f,l_reg=0.f;o[0]=f32x16{};o[1]=f32x16{};const f32x16 negm=f32x16{};
  unsigned amA=0xffffffffu,amB=0xffffffffu;
  #define NSAHOOK(C0,C1,t,AM) do{ const int e_=__builtin_amdgcn_readfirstlane(tl[t]); const int j_=e_&63, dq_=qc-j_; \
    { const float nm_=-mhat; _Pragma("unroll") for(int r_=0;r_<16;++r_){ C0[r_]+=nm_; C1[r_]+=nm_; } } \
    if(dq_<=2){ const volatile __attribute__((address_space(3))) float*lp_=luth+(64*dq_+qi+1-4*hi);     \
      _Pragma("unroll") for(int r_=0;r_<16;++r_){ const int ko_=(r_&3)+8*(r_>>2); C0[r_]+=lp_[63-ko_]; C1[r_]+=lp_[31-ko_]; } } \
    if(dq_==0){ _Pragma("unroll") for(int r_=0;r_<16;++r_){ const int kid_=4*hi+(r_&3)+8*(r_>>2); if(kid_>qi)C0[r_]=-1e30f; if(kid_+32>qi)C1[r_]=-1e30f; } } \
    if(WIN&&dq_==8){ _Pragma("unroll") for(int r_=0;r_<16;++r_){ const int kid_=4*hi+(r_&3)+8*(r_>>2); if(kid_<=qi)C0[r_]=-1e30f; if(kid_+32<=qi)C1[r_]=-1e30f; } } \
    AM=((e_>=0)&&(WIN||((selbits>>j_)&1u)))?0xffffffffu:0u; }while(0)
  bool resc=false;
  #define START(P0,P1) do{ const float rm=rowmax(P0,P1); resc=false; \
    { const float dl=__builtin_fmaxf(rm,-100.f); mhat=fadd_s(mhat,dl);     \
      _Pragma("unroll") for(int r=0;r<16;++r){P0[r]=fsub_s(P0[r],dl);P1[r]=fsub_s(P1[r],dl);} \
      } \
    _Pragma("unroll") for(int r=0;r<16;++r)P0[r]=__builtin_amdgcn_exp2f(P0[r]); }while(0)
  #define RESC() do{ if(resc){ asm volatile("s_waitcnt lgkmcnt(0)":::"memory"); \
      _Pragma("unroll") for(int d_=0;d_<2;++d_) _Pragma("unroll") for(int r=0;r<16;++r)o[d_][r]*=wsf[crow(r,hi)]; } }while(0)
  f32x16 pA0,pA1,pB0,pB1;
  int sl_prev=0,sl_cur=0,sl_next=SLOTB;
  #define ROT() do{sl_prev=sl_cur;sl_cur=sl_next;sl_next=(sl_next==(NSLOT-1)*SLOTB)?0:sl_next+SLOTB;}while(0)
  DMA_K(2,2*SLOTB);
  WAIT_BAR(3);
  qkt(pA0,pA1,Kbase,qr,negm,r32,hi);asm volatile("s_nop 15\n\ts_nop 7":"+v"(pA0),"+v"(pA1));NSAHOOK(pA0,pA1,0,amA);
  START(pA0,pA1);
  _Pragma("unroll") for(int r=0;r<16;++r)pA1[r]=__builtin_amdgcn_exp2f(pA1[r]);
  WAIT_BAR(0);
  DMA_K(3,0);DMA_V(1,SLOTB);
  ROT();
  kload8(kf,kp0+sl_cur);
  WAIT_BAR(2);
  s16x4 vlo[8],vhi[8]; u32x4 pw0,pw1,pw2,pw3;
  #define PKW(P,B) cvtpk_s(P[B],P[B+1])
  #define PAF(k) __builtin_bit_cast(bf16x8,pw##k)
  #define VFR(i) (bf16x8){vlo[i][0],vlo[i][1],vlo[i][2],vlo[i][3],vhi[i][0],vhi[i][1],vhi[i][2],vhi[i][3]}
  #define PIN(x) asm volatile("":"+v"(x))
  #define MX3(a,b,c) __builtin_fmaxf(__builtin_fmaxf((a),(b)),(c))
  #define GAPA(MF,A0,A1,A2,A3,W0,W1,PW) do{ MF; sacc+=A0; sacc+=A1; sacc+=A2; sacc+=A3; PIN(sacc); W0; W1; PIN(PW); SBAR(); }while(0)
  #define EX(v) __builtin_amdgcn_exp2f(v)
  #define GAPB(MF,X,B) do{ MF; X[B]=EX(X[B]); X[B+1]=EX(X[B+1]); X[B+2]=EX(X[B+2]); X[B+3]=EX(X[B+3]); PIN(X); SBAR(); }while(0)
  #define VRD(i) do{ vlo[i]=vtr(vp_+(((i)>>2)*4096+((i)&3)*1024)); vhi[i]=vtr(vp_+(((i)>>2)*4096+((i)&3)*1024+512)); }while(0)
  #define KRD(G,j) do{ if(G){ kload2(kf,kp0+sl_next,j); SBAR(); } }while(0)
  #define STEP(C0,C1,P0,P1,t,GK,GV,GL,AMC,AMP) do{ SBAR(); \
    const lds_cptr vp_=vp0+sl_prev; \
    VRD(0); SBAR(); float sacc=(P0[0]+P0[1]); \
    GAPA(C0=__builtin_amdgcn_mfma_f32_32x32x16_bf16(kf[0],qr[0],negm,0,0,0), P0[2],P0[3],P0[4],P0[5],     pw0[0]=PKW(P0,0)&AMP, pw0[1]=PKW(P0,2)&AMP, pw0); \
    VRD(4); SBAR(); GAPA(C1=__builtin_amdgcn_mfma_f32_32x32x16_bf16(kf[1],qr[0],negm,0,0,0), P0[6],P0[7],P0[8],P0[9],     pw0[2]=PKW(P0,4)&AMP, pw0[3]=PKW(P0,6)&AMP, pw0); \
    VRD(1); SBAR(); GAPA(C0=__builtin_amdgcn_mfma_f32_32x32x16_bf16(kf[2],qr[1],C0,0,0,0),   P0[10],P0[11],P0[12],P0[13], pw1[0]=PKW(P0,8)&AMP, pw1[1]=PKW(P0,10)&AMP, pw1); \
    VRD(5); SBAR(); GAPA(C1=__builtin_amdgcn_mfma_f32_32x32x16_bf16(kf[3],qr[1],C1,0,0,0),   P0[14],P0[15],P1[0],P1[1],   pw1[2]=PKW(P0,12)&AMP,pw1[3]=PKW(P0,14)&AMP, pw1); \
    VRD(2); SBAR(); GAPA(C0=__builtin_amdgcn_mfma_f32_32x32x16_bf16(kf[4],qr[2],C0,0,0,0),   P1[2],P1[3],P1[4],P1[5],     pw2[0]=PKW(P1,0)&AMP, pw2[1]=PKW(P1,2)&AMP, pw2); \
    VRD(6); SBAR(); GAPA(C1=__builtin_amdgcn_mfma_f32_32x32x16_bf16(kf[5],qr[2],C1,0,0,0),   P1[6],P1[7],P1[8],P1[9],     pw2[2]=PKW(P1,4)&AMP, pw2[3]=PKW(P1,6)&AMP, pw2); \
    VRD(3); SBAR(); GAPA(C0=__builtin_amdgcn_mfma_f32_32x32x16_bf16(kf[6],qr[3],C0,0,0,0),   P1[10],P1[11],P1[12],P1[13], pw3[0]=PKW(P1,8)&AMP, pw3[1]=PKW(P1,10)&AMP, pw3); \
    VRD(7); SBAR(); GAPA(C1=__builtin_amdgcn_mfma_f32_32x32x16_bf16(kf[7],qr[3],C1,0,0,0),   P1[14],P1[15],0.f,0.f,       pw3[2]=PKW(P1,12)&AMP,pw3[3]=PKW(P1,14)&AMP, pw3); \
    l_reg+=(AMP?sacc:0.f); \
    if(GK){DMA_K((t)+3,sl_cur);} if(GV){DMA_V((t)+1,sl_next);} \
    NSAHOOK(C0,C1,t,AMC); \
    { float a=MX3(C0[0],C0[1],C1[0]),b=MX3(C0[2],C0[3],C1[1]); a=MX3(a,C1[2],C1[3]); \
      _Pragma("unroll") for(int r=4;r<16;r+=4){a=MX3(a,C0[r],C0[r+1]);b=MX3(b,C0[r+2],C0[r+3]);a=MX3(a,C1[r],C1[r+1]);b=MX3(b,C1[r+2],C1[r+3]);} \
      float rm=__builtin_fmaxf(a,b); { auto rr=__builtin_amdgcn_permlane32_swap(__float_as_uint(rm),__float_as_uint(rm),false,false); rm=__builtin_fmaxf(__uint_as_float(rr[0]),__uint_as_float(rr[1])); } \
      rm=AMC?rm:-1e30f; resc=false; \
      if(__builtin_expect(__any(rm>(float)THRL),0)){ const float dl=__builtin_fmaxf(rm,0.f); mhat+=dl; \
        _Pragma("unroll") for(int r=0;r<16;++r){C0[r]-=dl;C1[r]-=dl;} \
        const float f=__builtin_amdgcn_exp2f(-dl); l_reg*=f; if(hi==0)wsf[r32]=f; resc=true; } } \
    SBAR(); \
    GAPB(o[0]=__builtin_amdgcn_mfma_f32_32x32x16_bf16(PAF(0),VFR(0),o[0],0,0,0), C0,0); \
    GAPB(o[1]=__builtin_amdgcn_mfma_f32_32x32x16_bf16(PAF(0),VFR(4),o[1],0,0,0), C0,4); \
    KRD(GL,0); GAPB(o[0]=__builtin_amdgcn_mfma_f32_32x32x16_bf16(PAF(1),VFR(1),o[0],0,0,0), C0,8); \
    KRD(GL,1); GAPB(o[1]=__builtin_amdgcn_mfma_f32_32x32x16_bf16(PAF(1),VFR(5),o[1],0,0,0), C0,12); \
    KRD(GL,2); GAPB(o[0]=__builtin_amdgcn_mfma_f32_32x32x16_bf16(PAF(2),VFR(2),o[0],0,0,0), C1,0); \
    KRD(GL,3); GAPB(o[1]=__builtin_amdgcn_mfma_f32_32x32x16_bf16(PAF(2),VFR(6),o[1],0,0,0), C1,4); \
    GAPB(o[0]=__builtin_amdgcn_mfma_f32_32x32x16_bf16(PAF(3),VFR(3),o[0],0,0,0), C1,8); \
    GAPB(o[1]=__builtin_amdgcn_mfma_f32_32x32x16_bf16(PAF(3),VFR(7),o[1],0,0,0), C1,12); \
    }while(0)
  int t=1;
  for(;t+5<NT;t+=2){
    STEP(pB0,pB1,pA0,pA1,t,true,true,true,amB,amA);     WAIT_BAR(2); RESC(); ROT();
    STEP(pA0,pA1,pB0,pB1,t+1,true,true,true,amA,amB);   WAIT_BAR(2); RESC(); ROT();
  }
  #define ENDW(tt) do{ if((tt)+3<NT){WAIT_BAR(2);} else if((tt)+2<NT){WAIT_BAR(1);} else {WAIT_BAR(0);} }while(0)
  for(;t+1<NT;t+=2){
    STEP(pB0,pB1,pA0,pA1,t,(t+3<NT),(t+1<NT),(t+1<NT),amB,amA);       ENDW(t);   RESC(); ROT();
    STEP(pA0,pA1,pB0,pB1,t+1,(t+4<NT),(t+2<NT),(t+2<NT),amA,amB);     ENDW(t+1); RESC(); ROT();
  }
  STEP(pB0,pB1,pA0,pA1,NT-1,false,false,false,amB,amA); RESC();
  { float sacc=pB0[0]+pB0[1]; _Pragma("unroll") for(int r=2;r<16;++r)sacc+=pB0[r]; _Pragma("unroll") for(int r=0;r<16;++r)sacc+=pB1[r]; l_reg+=(amB?sacc:0.f);
    pw0=(u32x4){PKW(pB0,0)&amB,PKW(pB0,2)&amB,PKW(pB0,4)&amB,PKW(pB0,6)&amB};pw1=(u32x4){PKW(pB0,8)&amB,PKW(pB0,10)&amB,PKW(pB0,12)&amB,PKW(pB0,14)&amB};pw2=(u32x4){PKW(pB1,0)&amB,PKW(pB1,2)&amB,PKW(pB1,4)&amB,PKW(pB1,6)&amB};pw3=(u32x4){PKW(pB1,8)&amB,PKW(pB1,10)&amB,PKW(pB1,12)&amB,PKW(pB1,14)&amB};
    SBAR(); pv(o,vb0+sl_cur,PAF(0),PAF(1),PAF(2),PAF(3)); }
  #undef PKW
  #undef PAF
  #undef VFR
  #undef PIN
  #undef MX3
  #undef GAPA
  #undef GAPB
  #undef EX
  #undef VRD
  #undef KRD
  #undef STEP
  #undef ENDW
  {auto rr=__builtin_amdgcn_permlane32_swap(__float_as_uint(l_reg),__float_as_uint(l_reg),false,false);l_out=__uint_as_float(rr[0])+__uint_as_float(rr[1]);}
  asm volatile("s_waitcnt lgkmcnt(0)\n\ts_barrier":::"memory");
  #undef NSAHOOK
  #undef TLJ
  #undef DMA_K
  #undef DMA_V
  #undef START
  #undef RESC
  #undef ROT
}
constexpr int ATTN_LDS_BYTES=LDS_BYTES;
struct AttnTensors { const bf16* Q; const bf16* K; const bf16* V; bf16* O; };
struct AttnUnit { int bh; int qb; };
#undef SBAR
#undef WAIT_BAR
}
namespace nsa {
using namespace attn_body;
typedef __attribute__((address_space(3))) char* lds_ptr;
typedef __attribute__((address_space(3))) float* lds_fptr;
typedef float f32x4_t __attribute__((ext_vector_type(4)));
constexpr int L_K = LDS_K, L_V = LDS_V, L_WS = LDS_WS, L_OST = LDS_WS + 2048;
constexpr int L_IMP = L_OST;
constexpr int L_IMPT = L_K + 2 * 8192;
constexpr int L_LUTPAD = L_OST + 65536, L_LUT = L_LUTPAD + 64;
constexpr int L_MASK = L_LUT + 4096 + 192;
constexpr int L_TL = L_MASK + 256;
constexpr int L_GATE = L_TL + 384;
constexpr int NSA_LDS_END = L_GATE + 8 * 3 * 64 * 4;
#define NSA_WAIT_BAR(N) asm volatile("s_waitcnt vmcnt(" #N ") lgkmcnt(0)\n\ts_barrier" ::: "memory")
#define NSA_SBAR() __builtin_amdgcn_sched_barrier(0)

__device__ __forceinline__ float rowmax_cv(const f32x16& p0, const f32x16& p1) {
    float a = __builtin_fmaxf(p0[0], p1[0]), b = __builtin_fmaxf(p0[1], p1[1]);
#pragma unroll
    for (int r = 2; r < 16; r += 2) { a = __builtin_fmaxf(a, __builtin_fmaxf(p0[r], p1[r])); b = __builtin_fmaxf(b, __builtin_fmaxf(p0[r + 1], p1[r + 1])); }
    const float m = __builtin_fmaxf(a, b);
    return __builtin_fmaxf(m, __shfl_xor(m, 32));
}
__device__ __forceinline__ bf16x8 pack8f(const f32x16& p, int base, unsigned amask) {
    u32x4 w; w[0] = cvtpk_s(p[base], p[base + 1]) & amask; w[1] = cvtpk_s(p[base + 2], p[base + 3]) & amask; w[2] = cvtpk_s(p[base + 4], p[base + 5]) & amask; w[3] = cvtpk_s(p[base + 6], p[base + 7]) & amask;
    return __builtin_bit_cast(bf16x8, w);
}
__device__ __forceinline__ void pv2(f32x16 (&o)[2], int vb, bf16x8 pa0, bf16x8 pa1, bf16x8 pa2, bf16x8 pa3) {
    s16x4 lo[2][4], hi[2][4];
#pragma unroll
    for (int d0 = 0; d0 < 2; ++d0)
#pragma unroll
        for (int ks = 0; ks < 4; ++ks) {
            asm volatile("ds_read_b64_tr_b16 %0,%1 offset:%c2" : "=&v"(lo[d0][ks]) : "v"(vb), "i"(d0 * 4096 + ks * 1024) : "memory");
            asm volatile("ds_read_b64_tr_b16 %0,%1 offset:%c2" : "=&v"(hi[d0][ks]) : "v"(vb), "i"(d0 * 4096 + ks * 1024 + 512) : "memory"); }
    asm volatile("s_waitcnt lgkmcnt(0)" ::: "memory"); NSA_SBAR();
#define NSA_PK(d, k) (bf16x8){lo[d][k][0], lo[d][k][1], lo[d][k][2], lo[d][k][3], hi[d][k][0], hi[d][k][1], hi[d][k][2], hi[d][k][3]}
    o[0] = __builtin_amdgcn_mfma_f32_32x32x16_bf16(pa0, NSA_PK(0, 0), o[0], 0, 0, 0); o[1] = __builtin_amdgcn_mfma_f32_32x32x16_bf16(pa0, NSA_PK(1, 0), o[1], 0, 0, 0);
    o[0] = __builtin_amdgcn_mfma_f32_32x32x16_bf16(pa1, NSA_PK(0, 1), o[0], 0, 0, 0); o[1] = __builtin_amdgcn_mfma_f32_32x32x16_bf16(pa1, NSA_PK(1, 1), o[1], 0, 0, 0);
    o[0] = __builtin_amdgcn_mfma_f32_32x32x16_bf16(pa2, NSA_PK(0, 2), o[0], 0, 0, 0); o[1] = __builtin_amdgcn_mfma_f32_32x32x16_bf16(pa2, NSA_PK(1, 2), o[1], 0, 0, 0);
    o[0] = __builtin_amdgcn_mfma_f32_32x32x16_bf16(pa3, NSA_PK(0, 3), o[0], 0, 0, 0); o[1] = __builtin_amdgcn_mfma_f32_32x32x16_bf16(pa3, NSA_PK(1, 3), o[1], 0, 0, 0);
#undef NSA_PK
}
__device__ __forceinline__ void stash_acc(lds_fptr stash, const f32x16 (&ob)[2], float f, lds_fptr wsf, int lane, int r32, int hi, bool first) {
    if (hi == 0) wsf[r32] = f;
    asm volatile("s_waitcnt lgkmcnt(0)" ::: "memory");
#pragma unroll
    for (int g = 0; g < 4; ++g) { const f32x4_t fv = *(const __attribute__((address_space(3))) f32x4_t*)(wsf + 8 * g + 4 * hi);
#pragma unroll
        for (int e = 0; e < 4; ++e) { const int r = 4 * g + e;
#pragma unroll
            for (int d0 = 0; d0 < 2; ++d0) { const lds_fptr p = stash + (d0 * 16 + r) * 64 + lane; float v = ob[d0][r] * fv[e]; if (!first) v += *p; *p = v; } } }
    asm volatile("s_waitcnt lgkmcnt(0)" ::: "memory");
}

__device__ __forceinline__ void nsa_unit(int b, int g, int qc, const bf16* Q, const bf16* KV, const bf16* KC2, size_t kvstride, size_t kc2stride, const float* gates, const float* lutg, bf16* O, char* shm) {
    int tid = threadIdx.x; asm volatile("" : "+v"(tid));
    const int lane = tid & 63, r32 = lane & 31, hi = lane >> 5; const int wid = __builtin_amdgcn_readfirstlane(tid >> 6);
    const int hr = wid >> 1, qh = wid & 1, hh = g * 4 + hr, bg = b * 4 + g;
    const int qi = 32 * qh + r32, t = 64 * qc + qi;
    const size_t tok = (size_t)b * SEQ + t;
    const lds_ptr shm3 = (lds_ptr)shm; const unsigned lds0 = (unsigned)(uintptr_t)shm;
    const lds_fptr lutN = (lds_fptr)(shm3 + L_LUT); const lds_fptr wsf = (lds_fptr)(shm3 + L_WS) + wid * 64;
    const bf16* Qw = Q + ((size_t)b * SEQ + 64 * qc + 32 * qh) * 1024 + hh * 64;
    bf16x8 qr[4];
#pragma unroll
    for (int d0 = 0; d0 < 4; ++d0) qr[d0] = *reinterpret_cast<const bf16x8*>(&Qw[(size_t)r32 * 1024 + d0 * 16 + hi * 8]);
    const lds_fptr gl = (lds_fptr)(shm3 + L_GATE) + wid * 192;
    { const float* gt = gates + tok * 48; const float g0 = gt[hh], g1 = gt[16 + hh], g2 = gt[32 + hh];
      const bf16* kcm = KC2 + (size_t)bg * 128 * 64; const bf16* vcm = KC2 + kc2stride + (size_t)bg * 128 * 64;
      const bf16* ksrc = kcm + (size_t)lane * 64 + wid * 8;
      const bf16* vsrc = vcm + (size_t)(16 * (wid & 3) + (lane >> 2)) * 64 + (wid >> 2) * 32 + (lane & 3) * 8;
      glds16(ksrc, (unsigned)__builtin_amdgcn_readfirstlane(lds0 + L_K + wid * 1024)); glds16(vsrc, (unsigned)__builtin_amdgcn_readfirstlane(lds0 + L_V + wid * 1024));
      glds16(ksrc + 4096, (unsigned)__builtin_amdgcn_readfirstlane(lds0 + L_K + 8192 + wid * 1024)); glds16(vsrc + 4096, (unsigned)__builtin_amdgcn_readfirstlane(lds0 + L_V + 8192 + wid * 1024));
      for (int e = tid; e < 1024; e += 512) { const int hd = e >> 8, rel = (e & 255) - 64; const float* lg = lutg + (g * 4 + hd) * 132; lutN[e] = rel < 0 ? 0.f : lg[rel > 128 ? 128 : rel] - lg[128]; }
      if (tid < 16) ((lds_fptr)(shm3 + L_LUTPAD))[tid] = 0.f;
      gl[lane] = g0; gl[64 + lane] = g1; gl[128 + lane] = g2; }
    NSA_WAIT_BAR(0);
    const lds_fptr stash = (lds_fptr)(shm3 + L_OST) + wid * 2048;
    f32x16 obc[2]; obc[0] = f32x16{}; obc[1] = f32x16{};
    {
        const f32x16 zero = f32x16{};
        f32x16 pc[2][2];
        qkt(pc[0][0], pc[0][1], shm + L_K, qr, zero, r32, hi);
        qkt(pc[1][0], pc[1][1], shm + L_K + 8192, qr, zero, r32, hi);
        const lds_fptr lh = lutN + hr * 256 + 64;
        float mx = -1e30f;
#pragma unroll
        for (int T = 0; T < 2; ++T)
#pragma unroll
            for (int v = 0; v < 2; ++v)
#pragma unroll
                for (int r = 0; r < 16; ++r) { const int c = 64 * T + 32 * v + 4 * hi + (r & 3) + 8 * (r >> 2); const int rel = t - 31 - 16 * c; const bool ok = (rel >= 0) && (c <= 126);
                    const int idx = rel < 0 ? 0 : (rel > 128 ? 128 : rel); const float x = ok ? pc[T][v][r] + lh[idx] : -1e30f; pc[T][v][r] = x; mx = __builtin_fmaxf(mx, x); }
        mx = __builtin_fmaxf(mx, __shfl_xor(mx, 32));
        float ls = 0.f;
#pragma unroll
        for (int T = 0; T < 2; ++T)
#pragma unroll
            for (int v = 0; v < 2; ++v)
#pragma unroll
                for (int r = 0; r < 16; ++r) { const float x = pc[T][v][r]; const float p = (x > -1e29f) ? __builtin_amdgcn_exp2f(x - mx) : 0.f; pc[T][v][r] = p; ls += p; }
        ls += __shfl_xor(ls, 32);
        const float inv = ls > 0.f ? 1.0f / ls : 0.f;
#pragma unroll
        for (int T = 0; T < 2; ++T)
#pragma unroll
            for (int v = 0; v < 2; ++v)
#pragma unroll
                for (int r = 0; r < 16; ++r) pc[T][v][r] *= inv;
        {
            float Gv[16], Ev[16], Er[16];
#pragma unroll
            for (int n = 0; n < 16; ++n) { const int T = n >> 3, v = (n >> 2) & 1, gI = n & 3; const f32x16& pp = pc[T][v];
                Gv[n] = (pp[4 * gI] + pp[4 * gI + 1]) + (pp[4 * gI + 2] + pp[4 * gI + 3]); Ev[n] = pp[4 * gI + 3]; }
#pragma unroll
            for (int n = 0; n < 16; ++n) Er[n] = __shfl_xor(Ev[n], 32);
            const lds_fptr impw = (lds_fptr)(shm3 + L_IMP) + (hr * 64 + qi) * 32 + hi;
#pragma unroll
            for (int n = 0; n < 16; ++n) { const float prev = hi ? Er[n] : (n > 0 ? Er[n > 0 ? n - 1 : 0] : 0.f); impw[2 * n] = Gv[n] + prev; }
        }
        const int vb0 = (int)(lds0 + L_V) + ((lane >> 4) & 1) * 32 + (lane & 3) * 8 + (4 * hi + ((lane & 15) >> 2)) * 64;
#pragma unroll
        for (int T = 0; T < 2; ++T) {
            const bf16x8 pa0 = pack8f(pc[T][0], 0, 0xffffffffu), pa1 = pack8f(pc[T][0], 8, 0xffffffffu), pa2 = pack8f(pc[T][1], 0, 0xffffffffu), pa3 = pack8f(pc[T][1], 8, 0xffffffffu);
            NSA_SBAR();
            pv2(obc, vb0 + T * 8192, pa0, pa1, pa2, pa3);
        }
    }
    asm volatile("s_waitcnt lgkmcnt(0)\n\ts_barrier" ::: "memory");
    unsigned selm, uni;
    if (qc >= 16) {
        const lds_fptr ip = (lds_fptr)(shm3 + L_IMP); const lds_fptr it = (lds_fptr)(shm3 + L_IMPT);
        const int q = tid >> 3, jj = tid & 7;
        {
            f32x4_t s = *(const __attribute__((address_space(3))) f32x4_t*)(ip + (0 * 64 + q) * 32 + 4 * jj);
            s += *(const __attribute__((address_space(3))) f32x4_t*)(ip + (1 * 64 + q) * 32 + 4 * jj);
            s += *(const __attribute__((address_space(3))) f32x4_t*)(ip + (2 * 64 + q) * 32 + 4 * jj);
            s += *(const __attribute__((address_space(3))) f32x4_t*)(ip + (3 * 64 + q) * 32 + 4 * jj);
            *(__attribute__((address_space(3))) f32x4_t*)(it + q * 32 + 4 * jj) = s;
        }
        asm volatile("s_waitcnt lgkmcnt(0)\n\ts_barrier" ::: "memory");
        {
            const f32x4_t v = *(const __attribute__((address_space(3))) f32x4_t*)(it + q * 32 + 4 * jj);
            int rk0 = 0, rk1 = 0, rk2 = 0, rk3 = 0;
            for (int i = 1; i <= qc - 2; ++i) { const float vi = it[q * 32 + i];
                rk0 += ((vi > v[0]) || (vi == v[0] && i < 4 * jj + 0)) ? 1 : 0; rk1 += ((vi > v[1]) || (vi == v[1] && i < 4 * jj + 1)) ? 1 : 0;
                rk2 += ((vi > v[2]) || (vi == v[2] && i < 4 * jj + 2)) ? 1 : 0; rk3 += ((vi > v[3]) || (vi == v[3] && i < 4 * jj + 3)) ? 1 : 0; }
            unsigned bits = 0u;
            { const int j = 4 * jj + 0; const bool forced = (j == 0) || (j == qc) || (j == qc - 1), cand = (j >= 1) && (j <= qc - 2); if (forced || (cand && rk0 < 13)) bits |= 1u << j; }
            { const int j = 4 * jj + 1; const bool forced = (j == 0) || (j == qc) || (j == qc - 1), cand = (j >= 1) && (j <= qc - 2); if (forced || (cand && rk1 < 13)) bits |= 1u << j; }
            { const int j = 4 * jj + 2; const bool forced = (j == 0) || (j == qc) || (j == qc - 1), cand = (j >= 1) && (j <= qc - 2); if (forced || (cand && rk2 < 13)) bits |= 1u << j; }
            { const int j = 4 * jj + 3; const bool forced = (j == 0) || (j == qc) || (j == qc - 1), cand = (j >= 1) && (j <= qc - 2); if (forced || (cand && rk3 < 13)) bits |= 1u << j; }
            bits |= (unsigned)__shfl_xor((int)bits, 1); bits |= (unsigned)__shfl_xor((int)bits, 2); bits |= (unsigned)__shfl_xor((int)bits, 4);
            if (jj == 0) ((__attribute__((address_space(3))) unsigned*)(shm3 + L_MASK))[q] = bits;
        }
        asm volatile("s_waitcnt lgkmcnt(0)\n\ts_barrier" ::: "memory");
        const __attribute__((address_space(3))) unsigned* mk = (const __attribute__((address_space(3))) unsigned*)(shm3 + L_MASK);
        selm = mk[qi];
        unsigned u = mk[lane];
#pragma unroll
        for (int o = 1; o < 64; o <<= 1) u |= (unsigned)__shfl_xor((int)u, o);
        uni = (unsigned)__builtin_amdgcn_readfirstlane((int)u);
    } else { selm = (2u << qc) - 1u; uni = selm; }
    stash_acc(stash, obc, gl[lane], wsf, lane, r32, hi, true);
    const int j0w = qc >= 8 ? qc - 8 : 0; const unsigned wt = ((2u << qc) - 1u) & ~((1u << j0w) - 1u);
    const int ns = __builtin_popcount(uni), nw = __builtin_popcount(wt);
    const int NTs = ns < 4 ? 4 : ns + (ns & 1), NTw = nw < 4 ? 4 : nw + (nw & 1);
    { __attribute__((address_space(3))) int* tls = (__attribute__((address_space(3))) int*)(shm3 + L_TL); int dmk = (int)0x80000000u; asm volatile("" : "+v"(dmk));
      if (tid < 32) { if ((uni >> tid) & 1u) tls[__builtin_popcount(uni & ((1u << tid) - 1u))] = tid; if (tid >= ns && tid < NTs) tls[tid] = dmk; if (tid == 0 && NTs > 32) tls[32] = dmk, tls[33] = dmk; }
      else if (tid < 64) { const int i = tid - 32; if ((wt >> i) & 1u) tls[48 + __builtin_popcount(wt & ((1u << i) - 1u))] = i; if (i >= nw && i < NTw) tls[48 + i] = dmk; } }
    asm volatile("s_waitcnt lgkmcnt(0)\n\ts_barrier" ::: "memory");
    const lds_fptr luth = lutN + hr * 256;
    const bf16* kvb = KV + (size_t)bg * SEQ * 64;
    { f32x16 ob[2]; float lt;
      nsa_branch_pipe<false, 32>(kvb + 2 * kvstride, kvb + 3 * kvstride, (const __attribute__((address_space(3))) int*)(shm3 + L_TL), NTs, qc, qr, selm, luth, shm, lt, ob);
      const float gs = gl[64 + lane]; stash_acc(stash, ob, lt > 0.f ? gs * __builtin_amdgcn_rcpf(lt) : 0.f, wsf, lane, r32, hi, false); }
    { f32x16 ob[2]; float lt;
      nsa_branch_pipe<true, 32>(kvb + 4 * kvstride, kvb + 5 * kvstride, (const __attribute__((address_space(3))) int*)(shm3 + L_TL) + 48, NTw, qc, qr, 0xffffffffu, luth, shm, lt, ob);
      const float gw = gl[128 + lane]; stash_acc(stash, ob, lt > 0.f ? gw * __builtin_amdgcn_rcpf(lt) : 0.f, wsf, lane, r32, hi, false); }
    bf16* Ow = O + ((size_t)b * SEQ + 64 * qc + 32 * qh) * 1024 + hh * 64;
    { f32x16 ot[2];
#pragma unroll
      for (int d0 = 0; d0 < 2; ++d0)
#pragma unroll
          for (int r = 0; r < 16; ++r) ot[d0][r] = stash[(d0 * 16 + r) * 64 + lane];
      asm volatile("s_waitcnt lgkmcnt(0)" ::: "memory");
      bf16* stg = (bf16*)(shm + L_OST) + wid * 4096;
#pragma unroll
      for (int r = 0; r < 16; ++r) { const int orow = crow(r, hi);
#pragma unroll
          for (int d0 = 0; d0 < 2; ++d0) stg[orow * 64 + d0 * 32 + r32] = __float2bfloat16(ot[d0][r]); }
      asm volatile("s_waitcnt lgkmcnt(0)" ::: "memory");
#pragma unroll
      for (int i = 0; i < 4; ++i) { const int row = i * 8 + (lane >> 3), ch = lane & 7; const u32x4 v = *(const u32x4*)(stg + row * 64 + ch * 8); *(u32x4*)(Ow + (size_t)row * 1024 + ch * 8) = v; } }
    asm volatile("s_waitcnt lgkmcnt(0)\n\ts_barrier" ::: "memory");
}
#undef NSA_WAIT_BAR
#undef NSA_SBAR
}

namespace pg8 {
__device__ __forceinline__ float sigm(float x) { return __builtin_amdgcn_rcpf(1.0f + __builtin_amdgcn_exp2f(-1.4426950408889634f * x)); }
__device__ __forceinline__ u32x4 pack8(const f32x4 a, const f32x4 b) { u32x4 w; w.x = cvt_pk_bf16(a[0], a[1]); w.y = cvt_pk_bf16(a[2], a[3]); w.z = cvt_pk_bf16(b[0], b[1]); w.w = cvt_pk_bf16(b[2], b[3]); return w; }
__device__ __forceinline__ float gelu_tanh(float x) { const float t = 0.7978845608028654f * (x + 0.044715f * x * x * x); return x * sigm(2.0f * t); }

struct EpiSwiglu {
    static constexpr bool PERM = true, AFTER_DRAIN = false;
    bf16_t* O; int ldc;
    __device__ __forceinline__ void operator()(const f32x4 (&acc)[2][2][4][2], const Unit& u, int wr, int wc, int fr, int fq) const {
        const int row0 = u.pm * BM + wr * 64 + fr, col0 = u.pn * HALF + wc * 32 + 8 * fq;
#pragma unroll
        for (int ai = 0; ai < 2; ++ai)
#pragma unroll
            for (int m = 0; m < 4; ++m) {
                bf16_t* rowp = O + (size_t)(row0 + ai * HALF + m * 16) * ldc + col0;
                f32x4 h[2];
#pragma unroll
                for (int n = 0; n < 2; ++n) { const f32x4 gt = acc[ai][0][m][n], up = acc[ai][1][m][n];
#pragma unroll
                    for (int e = 0; e < 4; ++e) h[n][e] = gt[e] * sigm(gt[e]) * up[e]; }
                *(u32x4*)rowp = pack8(h[0], h[1]);
            }
    }
};
struct EpiPlain {
    static constexpr bool PERM = true, AFTER_DRAIN = false;
    bf16_t* O; int ldc;
    __device__ __forceinline__ void operator()(const f32x4 (&acc)[2][2][4][2], const Unit& u, int wr, int wc, int fr, int fq) const {
        const int row0 = u.pm * BM + wr * 64 + fr, col0 = u.pn * BM + wc * 32 + 8 * fq;
#pragma unroll
        for (int ai = 0; ai < 2; ++ai)
#pragma unroll
            for (int m = 0; m < 4; ++m) {
                bf16_t* rowp = O + (size_t)(row0 + ai * HALF + m * 16) * ldc + col0;
#pragma unroll
                for (int bj = 0; bj < 2; ++bj) *(u32x4*)(rowp + bj * HALF) = pack8(acc[ai][bj][m][0], acc[ai][bj][m][1]);
            }
    }
};
struct EpiNsaIn {
    static constexpr bool PERM = true, AFTER_DRAIN = false;
    bf16_t* Q; bf16_t* KV; float* gates; float qscale; size_t kvstride;
    __device__ __forceinline__ void operator()(const f32x4 (&acc)[2][2][4][2], const Unit& u, int wr, int wc, int fr, int fq) const {
        const int row0 = u.pm * BM + wr * 64 + fr, ct0 = wc * 32 + 8 * fq;
        if (u.pn < 4) {
#pragma unroll
            for (int ai = 0; ai < 2; ++ai)
#pragma unroll
                for (int m = 0; m < 4; ++m) { bf16_t* rowp = Q + (size_t)(row0 + ai * HALF + m * 16) * 1024 + u.pn * BM + ct0;
#pragma unroll
                    for (int bj = 0; bj < 2; ++bj) *(u32x4*)(rowp + bj * HALF) = pack8(acc[ai][bj][m][0] * qscale, acc[ai][bj][m][1] * qscale); }
        } else if (u.pn < 10) {
            bf16_t* base = KV + (size_t)(u.pn - 4) * kvstride;
#pragma unroll
            for (int ai = 0; ai < 2; ++ai)
#pragma unroll
                for (int m = 0; m < 4; ++m) { const int row = row0 + ai * HALF + m * 16, b = row >> 11, s = row & 2047;
#pragma unroll
                    for (int bj = 0; bj < 2; ++bj) { const int ct = bj * HALF + ct0, g = ct >> 6, d = ct & 63;
                        *(u32x4*)(base + ((size_t)((b * 4 + g) * 2048 + s)) * 64 + d) = pack8(acc[ai][bj][m][0], acc[ai][bj][m][1]); } }
        } else {
            if (ct0 < 48) {
#pragma unroll
                for (int ai = 0; ai < 2; ++ai)
#pragma unroll
                    for (int m = 0; m < 4; ++m) { float* gp = gates + (size_t)(row0 + ai * HALF + m * 16) * 48 + ct0;
#pragma unroll
                        for (int n = 0; n < 2; ++n) { const f32x4 v = acc[ai][0][m][n]; *(f32x4*)(gp + 4 * n) = (f32x4){sigm(v[0]), sigm(v[1]), sigm(v[2]), sigm(v[3])}; } }
            }
        }
    }
};
struct EpiFoxIn {
    static constexpr bool PERM = true, AFTER_DRAIN = false;
    bf16_t* QKV; float* flog; float qscale; size_t tstride;
    __device__ __forceinline__ void operator()(const f32x4 (&acc)[2][2][4][2], const Unit& u, int wr, int wc, int fr, int fq) const {
        const int row0 = u.pm * BM + wr * 64 + fr, ct0 = wc * 32 + 8 * fq;
        if (u.pn < 12) {
            const int t = u.pn >> 2; const float sc = (t == 0) ? qscale : 1.0f;
            bf16_t* base = QKV + (size_t)t * tstride + (u.pn & 3) * BM + ct0;
#pragma unroll
            for (int ai = 0; ai < 2; ++ai)
#pragma unroll
                for (int m = 0; m < 4; ++m) { bf16_t* rowp = base + (size_t)(row0 + ai * HALF + m * 16) * 1024;
#pragma unroll
                    for (int bj = 0; bj < 2; ++bj) *(u32x4*)(rowp + bj * HALF) = pack8(acc[ai][bj][m][0] * sc, acc[ai][bj][m][1] * sc); }
        } else {
            if (ct0 < 16) {
#pragma unroll
                for (int ai = 0; ai < 2; ++ai)
#pragma unroll
                    for (int m = 0; m < 4; ++m) { float* fp = flog + (size_t)(row0 + ai * HALF + m * 16) * 16 + ct0;
#pragma unroll
                        for (int n = 0; n < 2; ++n) *(f32x4*)(fp + 4 * n) = acc[ai][0][m][n]; }
            }
        }
    }
};
struct EpiCmp {
    static constexpr bool PERM = true, AFTER_DRAIN = false;
    bf16_t* Hc; const float* b1f;
    __device__ __forceinline__ void operator()(const f32x4 (&acc)[2][2][4][2], const Unit& u, int wr, int wc, int fr, int fq) const {
        const int row0 = u.pm * BM + wr * 64 + fr, ct0 = wc * 32 + 8 * fq;
        f32x4 bv[2][2];
#pragma unroll
        for (int bj = 0; bj < 2; ++bj)
#pragma unroll
            for (int n = 0; n < 2; ++n) bv[bj][n] = *(const f32x4*)(b1f + u.pn * BM + bj * HALF + ct0 + 4 * n);
#pragma unroll
        for (int ai = 0; ai < 2; ++ai)
#pragma unroll
            for (int m = 0; m < 4; ++m) { bf16_t* rowp = Hc + (size_t)(row0 + ai * HALF + m * 16) * 256 + ct0;
#pragma unroll
                for (int bj = 0; bj < 2; ++bj) { f32x4 v0 = acc[ai][bj][m][0] + bv[bj][0], v1 = acc[ai][bj][m][1] + bv[bj][1];
#pragma unroll
                    for (int e = 0; e < 4; ++e) { v0[e] = gelu_tanh(v0[e]); v1[e] = gelu_tanh(v1[e]); }
                    *(u32x4*)(rowp + bj * HALF) = pack8(v0, v1); } }
    }
};
struct CmpOrder {
    int G, c;
    __device__ __forceinline__ bool next(int i, Unit& u) const { const int L = i * G + c; if (L >= 32) return false; u.pm = L; u.pn = L >> 4; return true; }
    __device__ __forceinline__ void a_ready(const Unit&) const {}
    __device__ __forceinline__ void done(const Unit&) const {}
};
struct EpiSlab {
    static constexpr bool PERM = true, AFTER_DRAIN = false;
    float* S;
    __device__ __forceinline__ void operator()(const f32x4 (&acc)[2][2][4][2], const Unit& u, int wr, int wc, int fr, int fq) const {
        const int row0 = u.pm * BM + wr * 64 + fr, ct0 = wc * 32 + 8 * fq;
#pragma unroll
        for (int ai = 0; ai < 2; ++ai)
#pragma unroll
            for (int m = 0; m < 4; ++m) { float* rowp = S + (size_t)(row0 + ai * HALF + m * 16) * 256 + ct0;
#pragma unroll
                for (int bj = 0; bj < 2; ++bj)
#pragma unroll
                    for (int n = 0; n < 2; ++n) *(f32x4*)(rowp + bj * HALF + 4 * n) = acc[ai][bj][m][n]; }
    }
};
struct OneUnit {
    int pm, pn;
    __device__ __forceinline__ bool next(int i, Unit& u) const { if (i != 0) return false; u.pm = pm; u.pn = pn; return true; }
    __device__ __forceinline__ void a_ready(const Unit&) const {}
    __device__ __forceinline__ void done(const Unit&) const {}
};
}

constexpr int NWAVES = 8;
constexpr int BATCH = 8, SEQ = 2048, D = 1024, H = 16, HD = 64, FF = 2816, NGU = 2 * FF;
constexpr int M = BATCH * SEQ;
constexpr int NSA_IN = 2608, NSA_IN_PAD = 2816, FOX_IN = 3088, FOX_IN_PAD = 3328;
constexpr float RMS_EPS = 1e-6f;
constexpr float LOG2E = 1.4426950408889634f;
constexpr float QSCALE = 0.125f * LOG2E;
#ifndef MK_PER_PHASE
#define MK_PER_PHASE 0
#endif
#ifndef FOX_NAIVE
#define FOX_NAIVE 0
#endif
#ifndef NSA_NAIVE
#define NSA_NAIVE 0
#endif
constexpr int N_PHASES = 47 - (FOX_NAIVE ? 0 : 2);

constexpr size_t MiB = 1u << 20;
constexpr size_t WS_CTL = 0, CTL_ZERO_BYTES = 1 * MiB;
constexpr size_t WS_LUT = 1 * MiB;
constexpr size_t WS_B1F = 1 * MiB + 16384;
constexpr size_t WS_W2T = 1 * MiB + 32768;
constexpr size_t WS_CUM = 2 * MiB;
constexpr size_t WS_FLOG = 3 * MiB;
constexpr size_t WS_GATES = 4 * MiB;
constexpr size_t WS_WGU = 8 * MiB;
constexpr size_t WS_WD = 96 * MiB;
constexpr size_t WS_WNIN = 140 * MiB;
constexpr size_t WS_WNOUT = 151 * MiB;
constexpr size_t WS_WFIN = 155 * MiB;
constexpr size_t WS_WFOUT = 168 * MiB;
constexpr size_t WS_W1T = 172 * MiB;
constexpr size_t WS_U = 176 * MiB;
constexpr size_t WS_Y = 208 * MiB;
constexpr size_t WS_O = 240 * MiB;
constexpr size_t WS_R1 = 272 * MiB;
constexpr size_t WS_END = 368 * MiB;
constexpr size_t R1_KV = 32 * MiB, KV_STRIDE_E = (size_t)32 * 2048 * 64  , R1_HC = 80 * MiB, R1_KC2 = 84 * MiB, KC2_STRIDE_E = (size_t)32 * 128 * 64;
constexpr int CW_BAR = 4096;

constexpr int RING_OFF = 0, RING_BYTES = 131072;
constexpr int LDSCTL_OFF = 139264, MISC_OFF = LDSCTL_OFF + 320;
constexpr int LDS_BYTES = 147456;

#define GAS __attribute__((address_space(1)))
#define LAS __attribute__((address_space(3)))
typedef unsigned short bf16;
typedef unsigned v4u __attribute__((ext_vector_type(4)));
typedef float f32x4 __attribute__((ext_vector_type(4)));
typedef GAS unsigned gu32;
#define RLX_AGENT __ATOMIC_RELAXED, __HIP_MEMORY_SCOPE_AGENT
#define LDS_WAIT() asm volatile("s_waitcnt lgkmcnt(0)" ::: "memory")
__device__ __forceinline__ unsigned f2bf(float f) { unsigned u = __builtin_bit_cast(unsigned, f); return (u + 0x7fffu + ((u >> 16) & 1u)) >> 16; }
__device__ __forceinline__ unsigned pk2(float lo, float hi) { return f2bf(lo) | (f2bf(hi) << 16); }
__device__ __forceinline__ float bf_lo(unsigned u) { return __builtin_bit_cast(float, u << 16); }
__device__ __forceinline__ float bf_hi(unsigned u) { return __builtin_bit_cast(float, u & 0xffff0000u); }
__device__ __forceinline__ float bf2f(bf16 h) { return __builtin_bit_cast(float, (unsigned)h << 16); }
__device__ __forceinline__ float wave_sum(float v) {
#pragma unroll
    for (int o = 1; o < 64; o <<= 1) v += __shfl_xor(v, o);
    return v;
}
__device__ __forceinline__ float wave_max(float v) {
#pragma unroll
    for (int o = 1; o < 64; o <<= 1) v = fmaxf(v, __shfl_xor(v, o));
    return v;
}
__device__ __forceinline__ float ex2(float x) { return __builtin_amdgcn_exp2f(x); }

#define XB_TMO      128
#define XB_XCNT(j)  (256  + 64 * (j))
#define XB_XSUB(j)  (1280 + 64 * (j))
#define XB_XGEN(j)  (2304 + 64 * (j))
#define XB_TOP      3328
#define XB_TOPGEN   3392
#define XCD_BAR_WORDS 3456
#define XB_SPIN_CAP (1u << 18)

__device__ __forceinline__ unsigned xb_ld(unsigned* p)              { return __hip_atomic_load(p, __ATOMIC_RELAXED, __HIP_MEMORY_SCOPE_AGENT); }
__device__ __forceinline__ unsigned xb_add(unsigned* p, unsigned v) { return __hip_atomic_fetch_add(p, v, __ATOMIC_RELAXED, __HIP_MEMORY_SCOPE_AGENT); }
__device__ __forceinline__ unsigned xb_xcc_id() { return (unsigned)__builtin_amdgcn_s_getreg((3 << 11) | 20) & 0xFu; }
#define XB_SPIN(cond, bar) do { unsigned _sp = 0; while (cond) { __builtin_amdgcn_s_sleep(1); \
    if ((++_sp & 255u) == 0u) { if (xb_ld(&(bar)[XB_TMO])) break; if (_sp > XB_SPIN_CAP) { atomicAdd(&(bar)[XB_TMO], 1u); break; } } } } while (0)

struct XcdBarrier {
    unsigned* bar; unsigned x;
    volatile LAS unsigned* st;
};
__device__ __forceinline__ XcdBarrier xcd_barrier_post(unsigned* bar, volatile LAS unsigned* st) {
    XcdBarrier b; b.bar = bar; b.x = xb_xcc_id(); b.st = st;
    if (threadIdx.x == 0) (void)xb_add(&bar[XB_XCNT(b.x)], 1u);
    return b;
}
__device__ __forceinline__ void xcd_barrier_complete(unsigned* bar, unsigned x, unsigned& nloc, unsigned& nx) {
    const unsigned G = gridDim.x * gridDim.y * gridDim.z;
    unsigned sum, cnt, mine, sp = 0u;
    for (;;) {
        sum = 0u; cnt = 0u; mine = 0u;
#pragma unroll
        for (unsigned j = 0; j < 16; ++j) { const unsigned c = xb_ld(&bar[XB_XCNT(j)]); sum += c; cnt += (c > 0u) ? 1u : 0u; mine = (j == x) ? c : mine; }
        if (sum == G) break;
        __builtin_amdgcn_s_sleep(1);
        if ((++sp & 255u) == 0u) { if (xb_ld(&bar[XB_TMO])) break; if (sp > XB_SPIN_CAP) { atomicAdd(&bar[XB_TMO], 1u); break; } }
    }
    nloc = mine > 0u ? mine : 1u; nx = cnt > 0u ? cnt : 1u;
}
__device__ __forceinline__ void xcd_barrier(const XcdBarrier& b) {
    asm volatile("s_waitcnt vmcnt(0)" ::: "memory");
    __syncthreads();
    if (threadIdx.x == 0) {
        unsigned* bar = b.bar;
        __builtin_amdgcn_s_waitcnt(0);
        unsigned nloc = b.st[0], nx = b.st[1];
        if (nloc == 0u) { xcd_barrier_complete(bar, b.x, nloc, nx); b.st[0] = nloc; b.st[1] = nx; }
        const unsigned old = xb_add(&bar[XB_XSUB(b.x)], 1u);
        const unsigned gen = old / nloc;
        if (old + 1u == (gen + 1u) * nloc) {
            __builtin_amdgcn_fence(__ATOMIC_RELEASE, "agent");
            asm volatile("s_waitcnt vmcnt(0)" ::: "memory");
            const unsigned og = xb_add(&bar[XB_TOP], 1u);
            const unsigned tg = og / nx;
            if (og + 1u == (tg + 1u) * nx) xb_add(&bar[XB_TOPGEN], 1u);
            else XB_SPIN(xb_ld(&bar[XB_TOPGEN]) == tg, bar);
            __builtin_amdgcn_fence(__ATOMIC_ACQUIRE, "agent");
            xb_add(&bar[XB_XGEN(b.x)], 1u);
            asm volatile("s_waitcnt vmcnt(0)" ::: "memory");
        } else {
            XB_SPIN(xb_ld(&bar[XB_XGEN(b.x)]) == gen, bar);
            __builtin_amdgcn_fence(__ATOMIC_ACQUIRE, "agent");
            asm volatile("s_waitcnt vmcnt(0)" ::: "memory");
        }
    }
    __syncthreads();
}

struct Ctx { LAS unsigned char* lds; int tid, lane, wave, vcu, G, gw, ngw, bx; };

__device__ __forceinline__ void transpose_item(const float* W, int K, int N, bf16* WT, int drow0, int kb, int n0, LAS float* scr, int lane) {
    const int k0 = 64 * kb; const int c4 = 4 * (lane & 7); const bool ok = (n0 + c4) < N;
    f32x4 v[8];
#pragma unroll
    for (int i = 0; i < 8; ++i) { const int kk = 8 * i + (lane >> 3); v[i] = ok ? *(const f32x4*)(W + (size_t)(k0 + kk) * N + n0 + c4) : (f32x4){0.f, 0.f, 0.f, 0.f}; }
#pragma unroll
    for (int i = 0; i < 8; ++i) { const int kk = 8 * i + (lane >> 3); LAS float* d = scr + kk * 33 + c4; d[0] = v[i][0]; d[1] = v[i][1]; d[2] = v[i][2]; d[3] = v[i][3]; }
    LDS_WAIT(); asm volatile("" ::: "memory");
    const int c = lane & 7;
#pragma unroll
    for (int j = 0; j < 4; ++j) { const int n = (lane >> 3) + 8 * j; const LAS float* s = scr + (8 * c) * 33 + n;
        v4u o; o.x = pk2(s[0 * 33], s[1 * 33]); o.y = pk2(s[2 * 33], s[3 * 33]); o.z = pk2(s[4 * 33], s[5 * 33]); o.w = pk2(s[6 * 33], s[7 * 33]);
        *(GAS v4u*)(WT + (size_t)(drow0 + n) * K + k0 + 8 * c) = o; }
    LDS_WAIT(); asm volatile("" ::: "memory");
}
__device__ __forceinline__ int t5_bucket(int n) {
    if (n < 16) return n;
    int b = 16;
    b += (n >= 19); b += (n >= 21); b += (n >= 24); b += (n >= 27); b += (n >= 31); b += (n >= 35); b += (n >= 40); b += (n >= 46);
    b += (n >= 52); b += (n >= 59); b += (n >= 67); b += (n >= 77); b += (n >= 87); b += (n >= 99); b += (n >= 113);
    return b;
}
struct In {
    const float *x, *norm_g, *w_gate, *w_up, *w_down, *rel_bias, *nsa_w_in, *nsa_pe, *nsa_w1, *nsa_b1, *nsa_w2, *nsa_w_out, *fox_w_in, *fox_b_f, *fox_w_out;
};
__device__ __forceinline__ void first_norm_row(const float* xrow, const float* g, bf16* urow, bf16* hrow, int lane) {
    const f32x4* xp = (const f32x4*)xrow; const f32x4* gp = (const f32x4*)g;
    f32x4 v[4] = {xp[2 * lane], xp[2 * lane + 1], xp[128 + 2 * lane], xp[128 + 2 * lane + 1]};
    float ss = 0.f;
#pragma unroll
    for (int i = 0; i < 4; ++i) ss += (v[i][0] * v[i][0] + v[i][1] * v[i][1]) + (v[i][2] * v[i][2] + v[i][3] * v[i][3]);
    const float r = 1.0f / sqrtf(wave_sum(ss) * (1.0f / D) + RMS_EPS);
    { v4u h0, h1; h0.x = pk2(v[0][0], v[0][1]); h0.y = pk2(v[0][2], v[0][3]); h0.z = pk2(v[1][0], v[1][1]); h0.w = pk2(v[1][2], v[1][3]);
      h1.x = pk2(v[2][0], v[2][1]); h1.y = pk2(v[2][2], v[2][3]); h1.z = pk2(v[3][0], v[3][1]); h1.w = pk2(v[3][2], v[3][3]);
      ((v4u*)hrow)[lane] = h0; ((v4u*)hrow)[64 + lane] = h1; }
    const f32x4 g4[4] = {gp[2 * lane], gp[2 * lane + 1], gp[128 + 2 * lane], gp[128 + 2 * lane + 1]};
#pragma unroll
    for (int i = 0; i < 4; ++i) v[i] = v[i] * r * g4[i];
    v4u o0, o1; o0.x = pk2(v[0][0], v[0][1]); o0.y = pk2(v[0][2], v[0][3]); o0.z = pk2(v[1][0], v[1][1]); o0.w = pk2(v[1][2], v[1][3]);
    o1.x = pk2(v[2][0], v[2][1]); o1.y = pk2(v[2][2], v[2][3]); o1.z = pk2(v[3][0], v[3][1]); o1.w = pk2(v[3][2], v[3][3]);
    ((v4u*)urow)[lane] = o0; ((v4u*)urow)[64 + lane] = o1;
}
namespace cv {
constexpr int I_G = 16 * 88, I_D = 44 * 32, I_FFN = 2 * I_G + I_D;
constexpr int I_NIN = 16 * 88, I_SQ = 16 * 32, I_FIN = 16 * 104, I_W1 = 32 * 8, I_W2 = 8;
constexpr int T0 = 8 * I_FFN, T1 = T0 + 2 * I_NIN, T2 = T1 + 2 * I_SQ, T3 = T2 + 2 * I_FIN, T4 = T3 + 2 * I_SQ, T5 = T4 + 4 * I_W1, T6 = T5 + 4 * I_W2;
}
__device__ __forceinline__ void convert_item(const In& I, unsigned char* ws, int it, LAS float* scr, int lane) {
    using namespace cv;
    bf16* Wgu = (bf16*)(ws + WS_WGU); bf16* Wd = (bf16*)(ws + WS_WD); bf16* Wnin = (bf16*)(ws + WS_WNIN); bf16* Wnout = (bf16*)(ws + WS_WNOUT);
    bf16* Wfin = (bf16*)(ws + WS_WFIN); bf16* Wfout = (bf16*)(ws + WS_WFOUT); bf16* W1t = (bf16*)(ws + WS_W1T); bf16* W2t = (bf16*)(ws + WS_W2T);
    int r = it;
    if (r < T0) { const int f = r / I_FFN; r -= f * I_FFN;
        if (r < 2 * I_G) { const int up = r >= I_G; r -= up * I_G; const int kb = r / 88, nb = r % 88;
            transpose_item((up ? I.w_up : I.w_gate) + (size_t)f * D * FF, D, FF, Wgu + (size_t)f * NGU * D, 256 * (nb >> 2) + 32 * (nb & 3) + 128 * up, kb, 32 * nb, scr, lane); }
        else { r -= 2 * I_G; const int kb = r / 32, nb = r % 32; transpose_item(I.w_down + (size_t)f * FF * D, FF, D, Wd + (size_t)f * D * FF, 32 * nb, kb, 32 * nb, scr, lane); }
        return; }
    r -= T0;
    if (r < 2 * I_NIN) { const int j = r / I_NIN; r -= j * I_NIN; const int kb = r / 88, nb = r % 88;
        transpose_item(I.nsa_w_in + (size_t)j * D * NSA_IN, D, NSA_IN, Wnin + (size_t)j * NSA_IN_PAD * D, 32 * nb, kb, 32 * nb, scr, lane); return; }
    r -= 2 * I_NIN;
    if (r < 2 * I_SQ) { const int j = r / I_SQ; r -= j * I_SQ; const int kb = r / 32, nb = r % 32;
        transpose_item(I.nsa_w_out + (size_t)j * D * D, D, D, Wnout + (size_t)j * D * D, 32 * nb, kb, 32 * nb, scr, lane); return; }
    r -= 2 * I_SQ;
    if (r < 2 * I_FIN) { const int j = r / I_FIN; r -= j * I_FIN; const int kb = r / 104, nb = r % 104;
        transpose_item(I.fox_w_in + (size_t)j * D * FOX_IN, D, FOX_IN, Wfin + (size_t)j * FOX_IN_PAD * D, 32 * nb, kb, 32 * nb, scr, lane); return; }
    r -= 2 * I_FIN;
    if (r < 2 * I_SQ) { const int j = r / I_SQ; r -= j * I_SQ; const int kb = r / 32, nb = r % 32;
        transpose_item(I.fox_w_out + (size_t)j * D * D, D, D, Wfout + (size_t)j * D * D, 32 * nb, kb, 32 * nb, scr, lane); return; }
    r -= 2 * I_SQ;
    if (r < 4 * I_W1) { const int jk = r / I_W1; r -= jk * I_W1; const int kb = r / 8, nb = r % 8;
        transpose_item(I.nsa_w1 + (size_t)jk * 2048 * 256, 2048, 256, W1t + (size_t)jk * 256 * 2048, 32 * nb, kb, 32 * nb, scr, lane); return; }
    r -= 4 * I_W1;
    { const int jk = r >> 3; r &= 7; const int kb = r >> 1, nb = r & 1;
        transpose_item(I.nsa_w2 + (size_t)jk * 256 * 64, 256, 64, W2t + (size_t)jk * 64 * 256, 32 * nb, kb, 32 * nb, scr, lane); }
}
__device__ __forceinline__ void convert_range(const In& I, unsigned char* ws, int start, int count, int widx, int nw, LAS float* scr, int lane) {
    for (int it = start + widx; it < start + count; it += nw) convert_item(I, ws, it, scr, lane);
}
__device__ __forceinline__ void convert_for_next(const In& I, unsigned char* ws, int s, int widx, int nw, LAS float* scr, int lane) {
    using namespace cv;
    if (s >= 7) return;
    if ((s & 1) == 0) { const int L = s >> 1, j = L >> 1;
        if ((L & 1) == 0) { convert_range(I, ws, T0 + j * I_NIN, I_NIN, widx, nw, scr, lane); convert_range(I, ws, T1 + j * I_SQ, I_SQ, widx, nw, scr, lane);
                            convert_range(I, ws, T4 + j * 2 * I_W1, 2 * I_W1, widx, nw, scr, lane); convert_range(I, ws, T5 + j * 2 * I_W2, 2 * I_W2, widx, nw, scr, lane); }
        else { convert_range(I, ws, T2 + j * I_FIN, I_FIN, widx, nw, scr, lane); convert_range(I, ws, T3 + j * I_SQ, I_SQ, widx, nw, scr, lane); } }
    convert_range(I, ws, (s + 1) * I_FFN, I_FFN, widx, nw, scr, lane);
}
__device__ __forceinline__ void prologue(const Ctx& C, const In& I, unsigned char* ws, bf16* hs0) {
    LAS float* scr = (LAS float*)(C.lds + RING_OFF + C.wave * 16384);
    convert_range(I, ws, 0, (C.G == 256) ? cv::I_FFN : cv::T6, C.gw, C.ngw, scr, C.lane);
    float* lut = (float*)(ws + WS_LUT);
    for (int e = C.gw * 64 + C.lane; e < 16 * 132; e += C.ngw * 64) { const int h = e / 132, rel = e % 132; lut[e] = I.rel_bias[t5_bucket(rel > 128 ? 128 : rel) * 16 + h] * LOG2E; }
    float* b1f = (float*)(ws + WS_B1F);
    for (int w = C.ngw - 1 - C.gw; w < 256; w += C.ngw) {
        const int e0 = 4 * w, jk = e0 >> 8, col = (e0 & 255) + (C.lane & 3), ks = C.lane >> 2;
        const float* pe = I.nsa_pe + (size_t)jk * 2048 + 128 * ks; const float* w1 = I.nsa_w1 + (size_t)jk * 2048 * 256 + (size_t)(128 * ks) * 256 + col; float sacc = 0.f;
#pragma unroll 8
        for (int i = 0; i < 128; ++i) sacc += pe[i] * w1[(size_t)i * 256];
        sacc += __shfl_xor(sacc, 4); sacc += __shfl_xor(sacc, 8); sacc += __shfl_xor(sacc, 16); sacc += __shfl_xor(sacc, 32);
        if (C.lane < 4) b1f[e0 + C.lane] = sacc + I.nsa_b1[e0 + C.lane];
    }
    bf16* U = (bf16*)(ws + WS_U);
    for (int m = C.gw; m < M; m += C.ngw) first_norm_row(I.x + (size_t)m * D, I.norm_g, U + (size_t)m * D, hs0 + (size_t)m * D, C.lane);
}

__device__ __forceinline__ void thin_pass(const Ctx& C, const bf16* hin, bf16* hout, bf16* u, float* out, const bf16* y, const float* gpost, float cmul, const float* gpre, bool last) {
    constexpr int RB = 4;
    const int lane = C.lane;
    const f32x4* gp = (const f32x4*)gpost; const f32x4 g4[4] = {gp[2 * lane], gp[2 * lane + 1], gp[128 + 2 * lane], gp[128 + 2 * lane + 1]};
    const f32x4* qp = (const f32x4*)(last ? gpost : gpre); const f32x4 q4[4] = {qp[2 * lane], qp[2 * lane + 1], qp[128 + 2 * lane], qp[128 + 2 * lane + 1]};
    for (int m0 = C.gw * RB; m0 < M; m0 += C.ngw * RB) {
        v4u yr[RB][2], hr[RB][2];
#pragma unroll
        for (int b = 0; b < RB; ++b) { const v4u* yp = (const v4u*)(y + (size_t)(m0 + b) * D); const v4u* hp = (const v4u*)(hin + (size_t)(m0 + b) * D);
            yr[b][0] = yp[lane]; yr[b][1] = yp[64 + lane]; hr[b][0] = hp[lane]; hr[b][1] = hp[64 + lane]; }
#pragma unroll
        for (int b = 0; b < RB; ++b) {
            const int m = m0 + b; const v4u y0 = yr[b][0], y1 = yr[b][1], h0 = hr[b][0], h1 = hr[b][1];
            f32x4 yv[4], h[4];
            yv[0] = (f32x4){bf_lo(y0.x), bf_hi(y0.x), bf_lo(y0.y), bf_hi(y0.y)}; yv[1] = (f32x4){bf_lo(y0.z), bf_hi(y0.z), bf_lo(y0.w), bf_hi(y0.w)};
            yv[2] = (f32x4){bf_lo(y1.x), bf_hi(y1.x), bf_lo(y1.y), bf_hi(y1.y)}; yv[3] = (f32x4){bf_lo(y1.z), bf_hi(y1.z), bf_lo(y1.w), bf_hi(y1.w)};
            h[0] = (f32x4){bf_lo(h0.x), bf_hi(h0.x), bf_lo(h0.y), bf_hi(h0.y)}; h[1] = (f32x4){bf_lo(h0.z), bf_hi(h0.z), bf_lo(h0.w), bf_hi(h0.w)};
            h[2] = (f32x4){bf_lo(h1.x), bf_hi(h1.x), bf_lo(h1.y), bf_hi(h1.y)}; h[3] = (f32x4){bf_lo(h1.z), bf_hi(h1.z), bf_lo(h1.w), bf_hi(h1.w)};
            float ss = 0.f;
#pragma unroll
            for (int i = 0; i < 4; ++i) ss += (yv[i][0] * yv[i][0] + yv[i][1] * yv[i][1]) + (yv[i][2] * yv[i][2] + yv[i][3] * yv[i][3]);
            const float ry = cmul / sqrtf(wave_sum(ss) * (1.0f / D) + RMS_EPS);
#pragma unroll
            for (int i = 0; i < 4; ++i) h[i] = h[i] + yv[i] * ry * g4[i];
            if (last) { f32x4* op = (f32x4*)(out + (size_t)m * D); op[2 * lane] = h[0]; op[2 * lane + 1] = h[1]; op[128 + 2 * lane] = h[2]; op[128 + 2 * lane + 1] = h[3]; }
            else {
                float s2 = 0.f;
#pragma unroll
                for (int i = 0; i < 4; ++i) s2 += (h[i][0] * h[i][0] + h[i][1] * h[i][1]) + (h[i][2] * h[i][2] + h[i][3] * h[i][3]);
                const float rh = 1.0f / sqrtf(wave_sum(s2) * (1.0f / D) + RMS_EPS);
                v4u o0, o1; o0.x = pk2(h[0][0], h[0][1]); o0.y = pk2(h[0][2], h[0][3]); o0.z = pk2(h[1][0], h[1][1]); o0.w = pk2(h[1][2], h[1][3]);
                o1.x = pk2(h[2][0], h[2][1]); o1.y = pk2(h[2][2], h[2][3]); o1.z = pk2(h[3][0], h[3][1]); o1.w = pk2(h[3][2], h[3][3]);
                v4u* hp = (v4u*)(hout + (size_t)m * D); hp[lane] = o0; hp[64 + lane] = o1;
#pragma unroll
                for (int i = 0; i < 4; ++i) h[i] = h[i] * rh * q4[i];
                o0.x = pk2(h[0][0], h[0][1]); o0.y = pk2(h[0][2], h[0][3]); o0.z = pk2(h[1][0], h[1][1]); o0.w = pk2(h[1][2], h[1][3]);
                o1.x = pk2(h[2][0], h[2][1]); o1.y = pk2(h[2][2], h[2][3]); o1.z = pk2(h[3][0], h[3][1]); o1.w = pk2(h[3][2], h[3][3]);
                v4u* up = (v4u*)(u + (size_t)m * D); up[lane] = o0; up[64 + lane] = o1;
            }
        }
    }
}

__device__ __forceinline__ void load_row64(const bf16* p, v4u (&r)[8]) { const v4u* q = (const v4u*)p;
#pragma unroll
    for (int i = 0; i < 8; ++i) r[i] = q[i]; }
__device__ __forceinline__ float dot64(const v4u (&a)[8], const v4u (&b)[8]) {
    float s0 = 0.f, s1 = 0.f;
#pragma unroll
    for (int i = 0; i < 8; ++i) {
        s0 += bf_lo(a[i].x) * bf_lo(b[i].x); s1 += bf_hi(a[i].x) * bf_hi(b[i].x);
        s0 += bf_lo(a[i].y) * bf_lo(b[i].y); s1 += bf_hi(a[i].y) * bf_hi(b[i].y);
        s0 += bf_lo(a[i].z) * bf_lo(b[i].z); s1 += bf_hi(a[i].z) * bf_hi(b[i].z);
        s0 += bf_lo(a[i].w) * bf_lo(b[i].w); s1 += bf_hi(a[i].w) * bf_hi(b[i].w);
    }
    return s0 + s1;
}
__device__ __forceinline__ int clampi(int v, int lo, int hi) { return v < lo ? lo : (v > hi ? hi : v); }

__device__ __forceinline__ void cmp2_naive(const Ctx& C, const bf16* Hc, const float* w2, bf16* KC2) {
    const int nth = C.ngw * 64;
    for (int e = C.gw * 64 + C.lane; e < 2 * 4096 * 64; e += nth) {
        const int d = e & 63, m = (e >> 6) & 4095, kv = e >> 18;
        float s = 0.f;
        if ((m & 127) != 127) { const bf16* hr = Hc + (size_t)(kv * 4096 + m) * 256; const float* w = w2 + (size_t)kv * 256 * 64 + d;
            for (int k = 0; k < 256; ++k) s += bf2f(hr[k]) * w[(size_t)k * 64]; }
        KC2[(size_t)kv * KC2_STRIDE_E + (size_t)m * 64 + d] = (bf16)f2bf(s);
    }
}

__device__ __forceinline__ void nsa_naive_token(int b, int g, int t, const bf16* Q, const bf16* KV, const bf16* KC2, const float* gates, const float* lut, bf16* O, int lane) {
    const int bg = b * 4 + g, cur = t >> 6;
    const size_t tok = (size_t)b * SEQ + t;
    const bf16* ks = KV + 2 * KV_STRIDE_E + (size_t)bg * SEQ * 64; const bf16* vs = KV + 3 * KV_STRIDE_E + (size_t)bg * SEQ * 64;
    const bf16* kw = KV + 4 * KV_STRIDE_E + (size_t)bg * SEQ * 64; const bf16* vw = KV + 5 * KV_STRIDE_E + (size_t)bg * SEQ * 64;
    const bf16* kcm = KC2 + (size_t)bg * 128 * 64; const bf16* vcm = KC2 + KC2_STRIDE_E + (size_t)bg * 128 * 64;
    float P0 = 0.f, P1 = 0.f; float oc[4];
    const int c0 = lane, c1 = lane + 64;
    const int rel0 = t - (16 * c0 + 31), rel1 = t - (16 * c1 + 31);
    const bool v0 = rel0 >= 0, v1 = (c1 <= 126) && (rel1 >= 0);
    const int cmax = (t >= 31) ? (((t - 31) >> 4) > 126 ? 126 : ((t - 31) >> 4)) : -1;
    {
        v4u k0[8], k1[8]; load_row64(kcm + (size_t)c0 * 64, k0); load_row64(kcm + (size_t)c1 * 64, k1);
#pragma unroll
        for (int r = 0; r < 4; ++r) {
            asm volatile("" ::: "memory");
            const int hh = g * 4 + r; v4u q[8]; load_row64(Q + tok * 1024 + hh * 64, q);
            const float* lh = lut + hh * 132;
            const float x0 = v0 ? dot64(q, k0) + lh[clampi(rel0, 0, 128)] : -1e30f;
            const float x1 = v1 ? dot64(q, k1) + lh[clampi(rel1, 0, 128)] : -1e30f;
            const float mx = wave_max(fmaxf(x0, x1));
            float p0 = v0 ? ex2(x0 - mx) : 0.f, p1 = v1 ? ex2(x1 - mx) : 0.f;
            const float sum = wave_sum(p0 + p1); const float inv = sum > 0.f ? 1.0f / sum : 0.f;
            p0 *= inv; p1 *= inv; P0 += p0; P1 += p1;
            float acc = 0.f;
#pragma unroll 4
            for (int c = 0; c <= cmax; ++c) { const float pc = __shfl(c < 64 ? p0 : p1, c & 63); acc += pc * bf2f(vcm[(size_t)c * 64 + lane]); }
            oc[r] = acc;
        }
    }
    unsigned mask;
    {
        const int j = lane & 31; float imp = 0.f;
#pragma unroll
        for (int dc = -1; dc <= 3; ++dc) { const int c = 4 * j + dc; const bool ok = (c >= 0) && (c <= 126); const int cc = ok ? c : 0;
            const float a0 = __shfl(P0, cc & 63), a1 = __shfl(P1, cc & 63); imp += ok ? (cc < 64 ? a0 : a1) : 0.f; }
        const bool forced = (j == 0) || (j == cur) || (j == cur - 1);
        const float sc = forced ? 1e9f : (j <= cur ? imp : -1e30f);
        int rank = 0;
#pragma unroll
        for (int i = 0; i < 32; ++i) { const float si = __shfl(sc, i); rank += ((si > sc) || (si == sc && i < j)) ? 1 : 0; }
        const unsigned long long bal = __ballot((rank < 16) && (lane < 32));
        mask = (unsigned)__builtin_amdgcn_readfirstlane((int)(unsigned)(bal & 0xffffffffull));
    }
#pragma unroll 1
    for (int r = 0; r < 4; ++r) {
        const int hh = g * 4 + r; v4u q[8]; load_row64(Q + tok * 1024 + hh * 64, q);
        const float* lh = lut + hh * 132;
        float osel, owin;
        {
            float mrun = -1e30f, l = 0.f, acc = 0.f;
            for (int jb = 0; jb <= cur; ++jb) {
                if (!((mask >> jb) & 1u)) continue;
                const int pos = jb * 64 + lane, rel = t - pos; const bool val = rel >= 0;
                v4u kr[8]; load_row64(ks + (size_t)pos * 64, kr);
                const float x = val ? dot64(q, kr) + lh[clampi(rel, 0, 128)] : -1e30f;
                const float mn = fmaxf(mrun, wave_max(x)), alpha = ex2(mrun - mn);
                const float p = val ? ex2(x - mn) : 0.f;
                l = l * alpha + wave_sum(p); acc *= alpha; mrun = mn;
#pragma unroll 8
                for (int k = 0; k < 64; ++k) acc += __shfl(p, k) * bf2f(vs[(size_t)(jb * 64 + k) * 64 + lane]);
            }
            osel = l > 0.f ? acc / l : 0.f;
        }
        {
            float mrun = -1e30f, l = 0.f, acc = 0.f;
            for (int i = 0; i < 8; ++i) {
                const int p0 = t - 511 + 64 * i; if (p0 + 63 < 0) continue;
                const int pos = p0 + lane, rel = t - pos; const bool val = pos >= 0;
                v4u kr[8]; load_row64(kw + (size_t)(val ? pos : 0) * 64, kr);
                const float x = val ? dot64(q, kr) + lh[clampi(rel, 0, 128)] : -1e30f;
                const float mn = fmaxf(mrun, wave_max(x)), alpha = ex2(mrun - mn);
                const float p = val ? ex2(x - mn) : 0.f;
                l = l * alpha + wave_sum(p); acc *= alpha; mrun = mn;
#pragma unroll 8
                for (int k = 0; k < 64; ++k) { const int pk = p0 + k; if (pk >= 0) acc += __shfl(p, k) * bf2f(vw[(size_t)pk * 64 + lane]); }
            }
            owin = l > 0.f ? acc / l : 0.f;
        }
        const float* gt = gates + tok * 48;
        const float o = gt[hh] * oc[r] + gt[16 + hh] * osel + gt[32 + hh] * owin;
        O[tok * 1024 + hh * 64 + lane] = (bf16)f2bf(o);
    }
}
__device__ __forceinline__ void nsa_naive_phase(const Ctx& C, const bf16* Q, const bf16* KV, const bf16* KC2, const float* gates, const float* lut, bf16* O) {
    for (int task = C.gw; task < BATCH * 4 * SEQ; task += C.ngw) { const int bg = task & 31, t = task >> 5; nsa_naive_token(bg >> 2, bg & 3, t, Q, KV, KC2, gates, lut, O, C.lane); }
}

__device__ __forceinline__ void fox_cum_phase(const Ctx& C, const float* flog, const float* bfp, float* cum) {
    for (int bh = C.gw; bh < BATCH * H; bh += C.ngw) {
        const int b = bh >> 4, h = bh & 15; const float bias = bfp[h]; float carry = 0.f;
        for (int i = 0; i < SEQ / 64; ++i) { const int s = 64 * i + C.lane;
            const float x = flog[((size_t)b * SEQ + s) * 16 + h] + bias;
            float v = (fminf(x, 0.f) - log1pf(expf(-fabsf(x)))) * LOG2E;
#pragma unroll
            for (int o = 1; o < 64; o <<= 1) { const float n = __shfl_up(v, o); if (C.lane >= o) v += n; }
            cum[(size_t)bh * SEQ + s] = carry + v;
            carry += __shfl(v, 63);
        }
    }
}
__device__ __forceinline__ void fox_naive_phase(const Ctx& C, const bf16* Q, const bf16* K, const bf16* V, const float* cum, bf16* O) {
    const int lane = C.lane;
    for (int task = C.gw; task < BATCH * H * SEQ; task += C.ngw) {
        const int bh = task & 127, t = task >> 7, b = bh >> 4, h = bh & 15;
        const size_t tok = (size_t)b * SEQ + t;
        v4u q[8]; load_row64(Q + tok * 1024 + h * 64, q);
        const float* cb = cum + (size_t)bh * SEQ; const float ct = cb[t];
        float mrun = -1e30f, l = 0.f, acc = 0.f;
        for (int i = 0; i <= (t >> 6); ++i) {
            const int pos = 64 * i + lane; const bool val = pos <= t; const int pc = val ? pos : t;
            v4u kr[8]; load_row64(K + ((size_t)b * SEQ + pc) * 1024 + h * 64, kr);
            const float x = val ? dot64(q, kr) + (ct - cb[pc]) : -1e30f;
            const float mn = fmaxf(mrun, wave_max(x)), alpha = ex2(mrun - mn);
            const float p = val ? ex2(x - mn) : 0.f;
            l = l * alpha + wave_sum(p); acc *= alpha; mrun = mn;
#pragma unroll 8
            for (int k = 0; k < 64; ++k) { const int pk = 64 * i + k; if (pk <= t) acc += __shfl(p, k) * bf2f(V[((size_t)b * SEQ + pk) * 1024 + h * 64 + lane]); }
        }
        O[tok * 1024 + h * 64 + lane] = (bf16)f2bf(acc / l);
    }
}

typedef short bf16x8_t __attribute__((ext_vector_type(8)));
__device__ __forceinline__ void cmp_tail_phase(const Ctx& C, const float* slabs, const float* b1f, const bf16* w2t, bf16* KC2) {
    LAS float* red = (LAS float*)(C.lds + RING_OFF);
    const int fr = C.lane & 15, fq = C.lane >> 4, tsel = C.wave >> 2, kq = C.wave & 3;
    for (int cu = C.vcu; cu < 256; cu += C.G) {
        const int tile = tsel * 256 + cu, row = tile * 16 + fr, kv = row >> 12;
        f32x4 acc[4];
#pragma unroll
        for (int nt = 0; nt < 4; ++nt) acc[nt] = (f32x4){0.f, 0.f, 0.f, 0.f};
#pragma unroll
        for (int kk = 0; kk < 2; ++kk) {
            const int k0 = 32 * (2 * kq + kk) + 8 * fq;
            f32x4 s0 = (f32x4){0.f, 0.f, 0.f, 0.f}, s1 = s0;
#pragma unroll
            for (int kc = 0; kc < 8; ++kc) { const float* sp = slabs + ((size_t)kc * 8192 + row) * 256 + k0; s0 += *(const f32x4*)sp; s1 += *(const f32x4*)(sp + 4); }
            const float* bp = b1f + kv * 256 + k0; s0 += *(const f32x4*)bp; s1 += *(const f32x4*)(bp + 4);
#pragma unroll
            for (int e = 0; e < 4; ++e) { s0[e] = pg8::gelu_tanh(s0[e]); s1[e] = pg8::gelu_tanh(s1[e]); }
            const pg8::u32x4 bw = pg8::pack8(s0, s1); const bf16x8_t bfrag = __builtin_bit_cast(bf16x8_t, bw);
#pragma unroll
            for (int nt = 0; nt < 4; ++nt) { const bf16x8_t afrag = *(const bf16x8_t*)(w2t + ((size_t)kv * 64 + 16 * nt + fr) * 256 + k0);
                acc[nt] = __builtin_amdgcn_mfma_f32_16x16x32_bf16(afrag, bfrag, acc[nt], 0, 0, 0); }
        }
        LAS f32x4* rp = (LAS f32x4*)(red + (C.wave * 64 + C.lane) * 16);
#pragma unroll
        for (int nt = 0; nt < 4; ++nt) rp[nt] = acc[nt];
        __syncthreads();
        if (kq == 0) {
#pragma unroll
            for (int w = 1; w < 4; ++w) { const LAS f32x4* op = (const LAS f32x4*)(red + ((C.wave + w) * 64 + C.lane) * 16);
#pragma unroll
                for (int nt = 0; nt < 4; ++nt) acc[nt] += op[nt]; }
            const int m = row & 4095; const bool pad = (m & 127) == 127;
#pragma unroll
            for (int nt = 0; nt < 4; ++nt) { unsigned lo = pk2(acc[nt][0], acc[nt][1]), hi2 = pk2(acc[nt][2], acc[nt][3]); if (pad) { lo = 0u; hi2 = 0u; }
                *(unsigned long long*)(KC2 + (size_t)kv * KC2_STRIDE_E + (size_t)m * 64 + 16 * nt + 4 * fq) = (unsigned long long)lo | ((unsigned long long)hi2 << 32); }
        }
        __syncthreads();
    }
}

__device__ __forceinline__ void fox_flog_tasks(const Ctx& C, const bf16* U, const bf16* WfT, float* flog) {
    if (C.wave >= 4) return;
    const int fr = C.lane & 15, fq = C.lane >> 4;
    for (int task = C.vcu * 4 + C.wave; task < M / 16; task += C.G * 4) {
        const bf16* ap = U + (size_t)(task * 16 + fr) * D + 8 * fq; const bf16* bp = WfT + (size_t)fr * D + 8 * fq;
        f32x4 acc = (f32x4){0.f, 0.f, 0.f, 0.f};
#pragma unroll 8
        for (int ks = 0; ks < D / 32; ++ks) { const bf16x8_t a = *(const bf16x8_t*)(ap + 32 * ks), b = *(const bf16x8_t*)(bp + 32 * ks); acc = __builtin_amdgcn_mfma_f32_16x16x32_bf16(a, b, acc, 0, 0, 0); }
#pragma unroll
        for (int e = 0; e < 4; ++e) flog[(size_t)(task * 16 + 4 * fq + e) * 16 + fr] = acc[e];
    }
}

constexpr int FOX_CUM_OFF = 86016, FOX_WTOT_OFF = 94208, FOX_ROWQ_OFF = 95232;
static_assert(FOX_ROWQ_OFF + 2 * 2048 * 4 <= 139264, "FoX LDS map");
__device__ __forceinline__ void fox_fast_phase(const Ctx& C, char* ldsg, const bf16* Q, const bf16* K, const bf16* V, bf16* O, const float* flog, const float* bfp, bf16* Odummy) {
    LAS float* cumL = (LAS float*)(C.lds + FOX_CUM_OFF); LAS float* wtot = (LAS float*)(C.lds + FOX_WTOT_OFF);
    LAS float* rowq = (LAS float*)(C.lds + FOX_ROWQ_OFF); LAS float* rowd = rowq + SEQ;
    for (int cu = C.vcu; cu < 256; cu += C.G) {
        const int bh = cu >> 1, b = bh >> 4, h = bh & 15;
        int tid_ = C.tid; asm volatile("" : "+v"(tid_));
        const int lane_ = tid_ & 63, wave_ = __builtin_amdgcn_readfirstlane(tid_ >> 6);
#if defined(PROBE_FOXPRE)
#pragma unroll 1
        for (int prep_ = 0; prep_ < 1 + PROBE_FOXPRE; ++prep_) {
#endif
        {
            const int s0 = 4 * tid_; const float bias = bfp[h]; float a[4];
#pragma unroll
            for (int i = 0; i < 4; ++i) { const float x = flog[((size_t)b * SEQ + s0 + i) * 16 + h] + bias; a[i] = (fminf(x, 0.f) - log1pf(expf(-fabsf(x)))) * LOG2E; }
            a[1] += a[0]; a[2] += a[1]; a[3] += a[2];
            const float tot = a[3]; float v = tot;
#pragma unroll
            for (int o = 1; o < 64; o <<= 1) { const float n = __shfl_up(v, o); if (lane_ >= o) v += n; }
            if (lane_ == 63) wtot[wave_] = v;
            __syncthreads();
            float off = 0.f;
            for (int w = 0; w < wave_; ++w) off += wtot[w];
            const float ex = off + v - tot;
            *(LAS f32x4*)(cumL + s0) = (f32x4){ex + a[0], ex + a[1], ex + a[2], ex + a[3]};
            __syncthreads();
        }
        {
            float qm = 0.f, km = 0.f;
            const int sub = tid_ & 7, r8 = tid_ >> 3;
            const GAS v4u* Qg = (const GAS v4u*)(Q + ((size_t)b * SEQ) * 1024 + h * 64 + sub * 8); const GAS v4u* Kg = (const GAS v4u*)(K + ((size_t)b * SEQ) * 1024 + h * 64 + sub * 8);
            const int par = cu & 1;
#pragma unroll
            for (int hb = 0; hb < 2; ++hb) {
                v4u qa_[8], ka_[8];
#pragma unroll
                for (int j = 0; j < 8; ++j) { const int u = 2 * hb + (j >> 2), qbu = 2 * u + ((u >> 1) ^ par), row = 256 * qbu + 64 * (j & 3) + r8; qa_[j] = Qg[(size_t)row * 128]; ka_[j] = Kg[(size_t)row * 128]; }
#pragma unroll
                for (int j = 0; j < 8; ++j) { const int u = 2 * hb + (j >> 2), qbu = 2 * u + ((u >> 1) ^ par), row = 256 * qbu + 64 * (j & 3) + r8; const v4u a = qa_[j], c = ka_[j];
                    float sq = bf_lo(a.x) * bf_lo(a.x) + bf_hi(a.x) * bf_hi(a.x) + bf_lo(a.y) * bf_lo(a.y) + bf_hi(a.y) * bf_hi(a.y) + bf_lo(a.z) * bf_lo(a.z) + bf_hi(a.z) * bf_hi(a.z) + bf_lo(a.w) * bf_lo(a.w) + bf_hi(a.w) * bf_hi(a.w);
                    float sk = bf_lo(c.x) * bf_lo(c.x) + bf_hi(c.x) * bf_hi(c.x) + bf_lo(c.y) * bf_lo(c.y) + bf_hi(c.y) * bf_hi(c.y) + bf_lo(c.z) * bf_lo(c.z) + bf_hi(c.z) * bf_hi(c.z) + bf_lo(c.w) * bf_lo(c.w) + bf_hi(c.w) * bf_hi(c.w);
                    float dq = bf_lo(a.x) * bf_lo(c.x) + bf_hi(a.x) * bf_hi(c.x) + bf_lo(a.y) * bf_lo(c.y) + bf_hi(a.y) * bf_hi(c.y) + bf_lo(a.z) * bf_lo(c.z) + bf_hi(a.z) * bf_hi(c.z) + bf_lo(a.w) * bf_lo(c.w) + bf_hi(a.w) * bf_hi(c.w);
                    sq += __shfl_xor(sq, 1); sk += __shfl_xor(sk, 1); dq += __shfl_xor(dq, 1); sq += __shfl_xor(sq, 2); sk += __shfl_xor(sk, 2); dq += __shfl_xor(dq, 2); sq += __shfl_xor(sq, 4); sk += __shfl_xor(sk, 4); dq += __shfl_xor(dq, 4);
                    qm = fmaxf(qm, sq); km = fmaxf(km, sk);
                    if (sub == 0) { rowq[row] = sq; rowd[row] = dq; } }
            }
            {
                v4u ka_[16];
#pragma unroll
                for (int j = 0; j < 16; ++j) { const int u = j >> 2, qbu = 2 * u + ((u >> 1) ^ par ^ 1), row = 256 * qbu + 64 * (j & 3) + r8; ka_[j] = Kg[(size_t)row * 128]; }
#pragma unroll
                for (int j = 0; j < 16; ++j) { const v4u c = ka_[j];
                    float sk = bf_lo(c.x) * bf_lo(c.x) + bf_hi(c.x) * bf_hi(c.x) + bf_lo(c.y) * bf_lo(c.y) + bf_hi(c.y) * bf_hi(c.y) + bf_lo(c.z) * bf_lo(c.z) + bf_hi(c.z) * bf_hi(c.z) + bf_lo(c.w) * bf_lo(c.w) + bf_hi(c.w) * bf_hi(c.w);
                    sk += __shfl_xor(sk, 1); sk += __shfl_xor(sk, 2); sk += __shfl_xor(sk, 4); km = fmaxf(km, sk); }
            }
            qm = wave_max(qm); km = wave_max(km);
            if (lane_ == 0) { wtot[8 + wave_] = qm; wtot[16 + wave_] = km; }
            __syncthreads();
            float qa = 0.f, ka = 0.f;
#pragma unroll
            for (int w = 0; w < 8; ++w) { qa = fmaxf(qa, wtot[8 + w]); ka = fmaxf(ka, wtot[16 + w]); }
            const float Kmax = sqrtf(ka); if (tid_ == 0) wtot[48] = 0.02f * sqrtf(qa * ka) + 32.0f;
#pragma unroll
            for (int uu = 0; uu < 2; ++uu) { const int u = 2 * uu + (tid_ >> 8), qbu = 2 * u + ((u >> 1) ^ par), row = 256 * qbu + (tid_ & 255);
                const float t = wave_max(sqrtf(rowq[row]) * Kmax - rowd[row]); if (lane_ == 0) wtot[32 + 4 * u + (wave_ & 3)] = t; }
            __syncthreads();
        }
#if defined(PROBE_FOXPRE)
        }
#endif
#pragma unroll 1
        for (int i = 0; i < 4; ++i) {
            const int qb = (cu & 1) ? (i == 0 ? 6 : i == 1 ? 1 : i == 2 ? 4 : 3) : (i == 0 ? 7 : i == 1 ? 0 : i == 2 ? 5 : 2);
            const int uo = qb >> 1; const float Tskip = fmaxf(fmaxf(wtot[32 + 4 * uo], wtot[33 + 4 * uo]), fmaxf(wtot[34 + 4 * uo], wtot[35 + 4 * uo])) + wtot[48];
            int tskip = 0; { const float c0 = cumL[qb * 256]; for (int t = 0; t + 4 < 4 * qb + 4; ++t) { if (c0 - cumL[64 * t + 63] < -Tskip) tskip = t + 1; else break; } }
            tskip = __builtin_amdgcn_readfirstlane(tskip) & ~1;
#if defined(PROBE_FOXDIAG)
            attn_body::attn_unit<64>(b, h, qb, (const attn_body::bf16*)Q, (const attn_body::bf16*)K, (const attn_body::bf16*)V, (attn_body::bf16*)Odummy, ldsg + RING_OFF, cumL, (PROBE_FOXDIAG == 2 && qb >= 1) ? 4 * qb - 4 : 4 * qb);
#endif
#if defined(PROBE_FOX)
            attn_body::attn_unit<64, PROBE_FOX>(b, h, qb, (const attn_body::bf16*)Q, (const attn_body::bf16*)K, (const attn_body::bf16*)V, (attn_body::bf16*)Odummy, ldsg + RING_OFF, cumL, tskip);
#endif
            attn_body::attn_unit<64>(b, h, qb, (const attn_body::bf16*)Q, (const attn_body::bf16*)K, (const attn_body::bf16*)V, (attn_body::bf16*)O, ldsg + RING_OFF, cumL, tskip);
        }
        __syncthreads();
    }
}

__device__ __forceinline__ void nsa_fast_phase(const Ctx& C, char* ldsg, const bf16* Q, const bf16* KV, const bf16* KC2, const float* gates, const float* lutg, bf16* O) {
    static_assert(nsa::NSA_LDS_END <= LDSCTL_OFF, "NSA LDS map");
    for (int cu = C.vcu; cu < 256; cu += C.G) {
        const int bg = cu >> 3, s = cu & 7;
#pragma unroll 1
        for (int i = 0; i < 4; ++i) {
            const int qc = (i == 0) ? 31 - s : (i == 1) ? s : (i == 2) ? 16 + s : 15 - s;
            nsa::nsa_unit(bg >> 2, bg & 3, qc, (const attn_body::bf16*)Q, (const attn_body::bf16*)KV, (const attn_body::bf16*)KC2, KV_STRIDE_E, KC2_STRIDE_E, gates, lutg, (attn_body::bf16*)O, ldsg + RING_OFF);
        }
    }
}

struct Args { const float* in[15]; float* out; unsigned char* ws; int ph_lo, ph_hi; };
__device__ __forceinline__ Ctx make_ctx(unsigned char* lds) {
    Ctx C; int tid = threadIdx.x; asm volatile("" : "+v"(tid));
    C.lds = (LAS unsigned char*)lds; C.tid = tid; C.lane = tid & 63; C.wave = __builtin_amdgcn_readfirstlane(tid >> 6);
    int bx = blockIdx.x, G = gridDim.x; asm volatile("" : "+s"(bx), "+s"(G));
    C.G = G; C.bx = bx; C.vcu = (C.G % 8 == 0) ? (bx % 8) * (C.G / 8) + bx / 8 : bx;
    C.gw = C.vcu * NWAVES + C.wave; C.ngw = C.G * NWAVES;
    return C;
}
__device__ __forceinline__ unsigned char* opaque_ptr(unsigned char* p) { asm volatile("" : "+s"(p)); return p; }
__global__ void __launch_bounds__(NWAVES * 64, 2) fwd_kernel(Args args) {
    extern __shared__ __attribute__((aligned(16))) unsigned char lds[];
    volatile LAS unsigned* MISC = (volatile LAS unsigned*)((LAS unsigned char*)lds + MISC_OFF);
    for (int u = threadIdx.x; u < LDS_BYTES / 4; u += NWAVES * 64) ((LAS unsigned*)((LAS unsigned char*)lds))[u] = 0u;
    __syncthreads();
    const int lo = args.ph_lo, hi = args.ph_hi;
    XcdBarrier bar; bar.bar = (unsigned*)(args.ws + WS_CTL) + CW_BAR; bar.x = 0; bar.st = nullptr;
    if (hi - lo > 1) bar = xcd_barrier_post((unsigned*)(args.ws + WS_CTL) + CW_BAR, MISC + 8);
    int ph = 0;
#ifndef PROBE_DUP
#define PROBE_DUP 0
#endif
#define PH_BEGIN_K(kind) if (ph >= lo && ph < hi) { for (int rep_ = (PROBE_DUP >> (kind)) & 1; rep_ >= 0; --rep_) { unsigned char* const ws = opaque_ptr(args.ws); const Ctx C = make_ctx(lds); (void)ws; (void)C;
#define PH_BEGIN PH_BEGIN_K(0)
#define PH_END   } if (ph + 1 < hi) { XcdBarrier b2 = bar; b2.bar = (unsigned*)opaque_ptr((unsigned char*)bar.bar); asm volatile("" : "+s"(b2.x)); xcd_barrier(b2); } } ++ph;
#define WSP(T, off) ((T*)(ws + (off)))

    PH_BEGIN_K(9) {
        In I; I.x = args.in[0]; I.norm_g = args.in[1]; I.w_gate = args.in[2]; I.w_up = args.in[3]; I.w_down = args.in[4]; I.rel_bias = args.in[5]; I.nsa_w_in = args.in[6]; I.nsa_pe = args.in[7];
        I.nsa_w1 = args.in[8]; I.nsa_b1 = args.in[9]; I.nsa_w2 = args.in[10]; I.nsa_w_out = args.in[11]; I.fox_w_in = args.in[12]; I.fox_b_f = args.in[13]; I.fox_w_out = args.in[14];
        prologue(C, I, ws, (bf16*)((unsigned char*)args.out + 32 * MiB)); } PH_END

#pragma unroll 1
    for (int s = 0; s < 8; ++s) {
        const int L = s >> 1, half = s & 1;
        PH_BEGIN_K(0) { pg8::Gemm g{WSP(bf16, WS_U), WSP(bf16, WS_WGU) + (size_t)s * NGU * D, D, D, D}; pg8::StaticOrder S; S.init(M, NGU, C.G, C.bx);
            pg8::EpiSwiglu E{WSP(bf16, WS_R1), FF}; pg8::gemm_phase<pg8::EpiSwiglu, pg8::StaticOrder, true, true>(C.lds + RING_OFF, g, S, E);
            if (C.G == 256 && C.bx >= 128 && rep_ == 0) {
                In I; I.x = args.in[0]; I.norm_g = args.in[1]; I.w_gate = args.in[2]; I.w_up = args.in[3]; I.w_down = args.in[4]; I.rel_bias = args.in[5]; I.nsa_w_in = args.in[6]; I.nsa_pe = args.in[7];
                I.nsa_w1 = args.in[8]; I.nsa_b1 = args.in[9]; I.nsa_w2 = args.in[10]; I.nsa_w_out = args.in[11]; I.fox_w_in = args.in[12]; I.fox_b_f = args.in[13]; I.fox_w_out = args.in[14];
                convert_for_next(I, ws, s, (C.bx - 128) * NWAVES + C.wave, 128 * NWAVES, (LAS float*)(C.lds + RING_OFF + C.wave * 16384), C.lane); } } PH_END
        PH_BEGIN_K(1) { pg8::Gemm g{WSP(bf16, WS_R1), WSP(bf16, WS_WD) + (size_t)s * D * FF, FF, FF, FF}; pg8::StaticOrder S; S.init(M, D, C.G, C.bx);
            pg8::EpiPlain E{WSP(bf16, WS_Y), D}; pg8::gemm_phase<pg8::EpiPlain, pg8::StaticOrder, true, true>(C.lds + RING_OFF, g, S, E); } PH_END
        PH_BEGIN_K(8) { const float* gL = args.in[1] + (size_t)L * 6 * D; const float* gpost = gL + (half ? 5 : 1) * D; const float* gpre = half ? (L < 3 ? gL + 6 * D : nullptr) : gL + 2 * D;
            bf16* hsd = (bf16*)((unsigned char*)args.out + 32 * MiB); const bool last = (s == 7);
            thin_pass(C, last ? WSP(bf16, WS_O) : hsd, rep_ ? WSP(bf16, WS_R1) : hsd, rep_ ? WSP(bf16, WS_R1 + 32 * MiB) : WSP(bf16, WS_U), rep_ ? WSP(float, WS_R1) : args.out, WSP(bf16, WS_Y), gpost, 0.5f, gpre, last); } PH_END
        if (half == 0) {
            const int j = L >> 1;
            if ((L & 1) == 0) {
                PH_BEGIN_K(2) { pg8::Gemm g{WSP(bf16, WS_U), WSP(bf16, WS_WNIN) + (size_t)j * NSA_IN_PAD * D, D, D, D}; pg8::StaticOrder S; S.init(M, NSA_IN_PAD, C.G, C.bx);
                    pg8::EpiNsaIn E{WSP(bf16, WS_R1), WSP(bf16, WS_R1 + R1_KV), WSP(float, WS_GATES), QSCALE, KV_STRIDE_E};
                    pg8::gemm_phase<pg8::EpiNsaIn, pg8::StaticOrder, true, true>(C.lds + RING_OFF, g, S, E); } PH_END
                PH_BEGIN_K(3) { const int kc = C.bx & 7, Lu = (C.bx >> 3) & 31;
                    if (C.bx < 256) { int kch = 256; asm volatile("" : "+s"(kch));
                        pg8::Gemm g{WSP(bf16, WS_R1 + R1_KV) + kc * 256, WSP(bf16, WS_W1T) + (size_t)j * 512 * 2048 + kc * 256, 1024, 2048, kch}; pg8::OneUnit S{Lu, Lu >> 4};
                        pg8::EpiSlab E{WSP(float, WS_Y) + (size_t)kc * 8192 * 256}; pg8::gemm_phase<pg8::EpiSlab, pg8::OneUnit, true, true>(C.lds + RING_OFF, g, S, E); } } PH_END
                PH_BEGIN_K(5) cmp_tail_phase(C, WSP(float, WS_Y), WSP(float, WS_B1F) + j * 512, WSP(bf16, WS_W2T) + (size_t)j * 2 * 64 * 256, WSP(bf16, WS_R1 + R1_KC2)); PH_END
#if NSA_NAIVE
                PH_BEGIN_K(6) nsa_naive_phase(C, WSP(bf16, WS_R1), WSP(bf16, WS_R1 + R1_KV), WSP(bf16, WS_R1 + R1_KC2), WSP(float, WS_GATES), WSP(float, WS_LUT), WSP(bf16, WS_O)); PH_END
#else
                PH_BEGIN_K(6) nsa_fast_phase(C, (char*)lds, WSP(bf16, WS_R1), WSP(bf16, WS_R1 + R1_KV), WSP(bf16, WS_R1 + R1_KC2), WSP(float, WS_GATES), WSP(float, WS_LUT), WSP(bf16, WS_O)); PH_END
#endif
                PH_BEGIN_K(4) { pg8::Gemm g{WSP(bf16, WS_O), WSP(bf16, WS_WNOUT) + (size_t)j * D * D, D, D, D}; pg8::StaticOrder S; S.init(M, D, C.G, C.bx);
                    pg8::EpiPlain E{WSP(bf16, WS_Y), D}; pg8::gemm_phase<pg8::EpiPlain, pg8::StaticOrder, true, true>(C.lds + RING_OFF, g, S, E); } PH_END
            } else {
                PH_BEGIN_K(2) { fox_flog_tasks(C, WSP(bf16, WS_U), WSP(bf16, WS_WFIN) + ((size_t)j * FOX_IN_PAD + 3 * D) * D, WSP(float, WS_FLOG));
                    pg8::Gemm g{WSP(bf16, WS_U), WSP(bf16, WS_WFIN) + (size_t)j * FOX_IN_PAD * D, D, D, D}; pg8::StaticOrder S; S.init(M, 3 * D, C.G, C.bx);
                    pg8::EpiFoxIn E{WSP(bf16, WS_R1), WSP(float, WS_FLOG), QSCALE, (size_t)M * D}; pg8::gemm_phase<pg8::EpiFoxIn, pg8::StaticOrder, true, true>(C.lds + RING_OFF, g, S, E); } PH_END
#if FOX_NAIVE
                PH_BEGIN_K(7) fox_cum_phase(C, WSP(float, WS_FLOG), args.in[13] + j * 16, WSP(float, WS_CUM)); PH_END
                PH_BEGIN_K(7) fox_naive_phase(C, WSP(bf16, WS_R1), WSP(bf16, WS_R1) + (size_t)M * D, WSP(bf16, WS_R1) + (size_t)2 * M * D, WSP(float, WS_CUM), WSP(bf16, WS_O)); PH_END
#else
                PH_BEGIN_K(7) fox_fast_phase(C, (char*)lds, WSP(bf16, WS_R1), WSP(bf16, WS_R1) + (size_t)M * D, WSP(bf16, WS_R1) + (size_t)2 * M * D, WSP(bf16, WS_O), WSP(float, WS_FLOG), args.in[13] + j * 16, WSP(bf16, WS_Y)); PH_END
#endif
                PH_BEGIN_K(4) { pg8::Gemm g{WSP(bf16, WS_O), WSP(bf16, WS_WFOUT) + (size_t)j * D * D, D, D, D}; pg8::StaticOrder S; S.init(M, D, C.G, C.bx);
                    pg8::EpiPlain E{WSP(bf16, WS_Y), D}; pg8::gemm_phase<pg8::EpiPlain, pg8::StaticOrder, true, true>(C.lds + RING_OFF, g, S, E); } PH_END
            }
            PH_BEGIN_K(8) { const float* gL = args.in[1] + (size_t)L * 6 * D; bf16* hsd = (bf16*)((unsigned char*)args.out + 32 * MiB);
                thin_pass(C, hsd, rep_ ? WSP(bf16, WS_R1) : (L == 3 ? WSP(bf16, WS_O) : hsd), rep_ ? WSP(bf16, WS_R1 + 32 * MiB) : WSP(bf16, WS_U), args.out, WSP(bf16, WS_Y), gL + 3 * D, 1.0f, gL + 4 * D, false); } PH_END
        }
    }
#undef PH_BEGIN
#undef PH_END
#undef WSP
}

extern "C" void kernel_launch(void* const* d_in, const int* in_sizes, int n_in, void* d_out, int out_size, void* d_ws, size_t ws_size, hipStream_t stream) {
    static int grid = 0;
    if (grid == 0) {
        if (n_in != 15 || in_sizes[0] != M * D || out_size != M * D || ws_size < WS_END) { fprintf(stderr, "kernel_launch: unexpected shapes (n_in %d, in0 %d, out %d, ws %zu < %zu); nothing launched\n", n_in, n_in > 0 ? in_sizes[0] : -1, out_size, ws_size, (size_t)WS_END); grid = -1; return; }
        int dev = 0, cus = 0, per_cu = 0;
        if (hipGetDevice(&dev) != hipSuccess || hipDeviceGetAttribute(&cus, hipDeviceAttributeMultiprocessorCount, dev) != hipSuccess) { grid = -1; return; }
        if (hipFuncSetAttribute((const void*)fwd_kernel, hipFuncAttributeMaxDynamicSharedMemorySize, LDS_BYTES) != hipSuccess) { fprintf(stderr, "kernel_launch: hipFuncSetAttribute failed\n"); grid = -1; return; }
        if (hipOccupancyMaxActiveBlocksPerMultiprocessor(&per_cu, (const void*)fwd_kernel, NWAVES * 64, LDS_BYTES) != hipSuccess || per_cu < 1)
            fprintf(stderr, "kernel_launch: note: occupancy query reports %d workgroups per CU\n", per_cu);
        (void)hipGetLastError();
        grid = cus;
    }
    if (grid < 0) return;
    if (hipMemsetAsync((char*)d_ws + WS_CTL, 0, CTL_ZERO_BYTES, stream) != hipSuccess) { fprintf(stderr, "kernel_launch: hipMemsetAsync failed\n"); return; }
    Args a{};
    for (int i = 0; i < 15; ++i) a.in[i] = (const float*)d_in[i];
    a.out = (float*)d_out; a.ws = (unsigned char*)d_ws;
#if MK_PER_PHASE
    for (int p = 0; p < N_PHASES; ++p) { a.ph_lo = p; a.ph_hi = p + 1; hipLaunchKernelGGL(fwd_kernel, dim3(grid), dim3(NWAVES * 64), LDS_BYTES, stream, a); }
#else
    a.ph_lo = 0; a.ph_hi = N_PHASES;
    hipLaunchKernelGGL(fwd_kernel, dim3(grid), dim3(NWAVES * 64), LDS_BYTES, stream, a);
#endif
    const hipError_t le = hipPeekAtLastError();
    if (le != hipSuccess) fprintf(stderr, "kernel_launch: launch failed: %s\n", hipGetErrorName(le));
}
```

```cpp
#include <hip/hip_runtime.h>
#include <cstdio>
#include <cstdint>
#define PG8_STR2(x) #x
#define PG8_STR(x) PG8_STR2(x)
namespace pg8 {
#define PG8_LAS __attribute__((address_space(3)))
typedef unsigned short bf16_t;
typedef short bf16x8 __attribute__((ext_vector_type(8)));
typedef float f32x4 __attribute__((ext_vector_type(4)));
typedef unsigned u32x4 __attribute__((ext_vector_type(4)));
constexpr int BM = 256, BK = 64, HALF = 128, HTB = HALF * BK * 2  , STAGE_BYTES = 8 * HTB, NXCD = 8, WGM = 8;

__host__ __device__ __forceinline__ int lds_byte(int r, int c) { const int st = (r >> 4) * 2 + (c >> 5), rr = r & 15, cc = c & 31, ob = rr * 64 + cc * 2; return st * 1024 + (ob ^ (((ob >> 9) & 1) << 5)); }
__host__ __device__ __forceinline__ void stage_rc(int b, int& R, int& C) { const int st = b / 1024, sb = b % 1024, swz = sb ^ (((sb >> 9) & 1) << 5); R = (st >> 1) * 16 + swz / 64; C = (st & 1) * 32 + (swz % 64) / 2; }
__host__ __device__ __forceinline__ int perm32(int rho) { const int n = rho >> 4, i = rho & 15; return 8 * (i >> 2) + 4 * n + (i & 3); }

struct Unit { int pm, pn; };
struct Gemm { const bf16_t* A; const bf16_t* Bt; int lda, ldb, K; };

struct StaticOrder {
    int nM, nN, nwg, G, c;
    __host__ __device__ void init(int M, int N, int G_, int c_) { nM = M / BM; nN = N / BM; nwg = nM * nN; G = G_; c = c_; }
    __host__ __device__ bool next(int i, Unit& u) const {
        const long L = (long)i * G + c; if (L >= nwg) return false;
        int wgid = (int)L; { const int q = nwg / NXCD, r = nwg % NXCD, xcd = wgid % NXCD, off = wgid / NXCD; wgid = (xcd < r ? xcd * (q + 1) : r * (q + 1) + (xcd - r) * q) + off; }
        const int nig = WGM * nN, gid = wgid / nig, fm = gid * WGM, gsz = (nM - fm) < WGM ? (nM - fm) : WGM;
        u.pm = fm + ((wgid % nig) % gsz); u.pn = (wgid % nig) / gsz; return true;
    }
    __device__ __forceinline__ void a_ready(const Unit&) const {}
    __device__ __forceinline__ void done(const Unit&) const {}
};

__device__ __forceinline__ unsigned cvt_pk_bf16(float lo, float hi) { unsigned r; asm volatile("v_cvt_pk_bf16_f32 %0, %1, %2" : "=v"(r) : "v"(lo), "v"(hi)); return r; }
typedef float f32x2 __attribute__((ext_vector_type(2)));
__device__ __forceinline__ f32x2 gelu_pk(f32x2 v) {
    const f32x2 av = __builtin_elementwise_abs(v), d = av * 0.2316418882f + 1.0f;
    f32x2 t; t.x = __builtin_amdgcn_rcpf(d.x); t.y = __builtin_amdgcn_rcpf(d.y);
    f32x2 q = t * 0.5307027145f + (-0.7265760135f); q = q * t + 0.7107068705f; q = q * t + (-0.142248368f); q = q * t + 0.127414796f; q = q * t;
    const f32x2 s = (v * v) * (-0.72134752044f);
    f32x2 e; e.x = __builtin_amdgcn_exp2f(s.x); e.y = __builtin_amdgcn_exp2f(s.y);
    const f32x2 m = v * (q * e), r = v - m;
    f32x2 o; o.x = v.x < 0.f ? m.x : r.x; o.y = v.y < 0.f ? m.y : r.y; return o;
}

template <class Epi, class Sched, bool ALIGN_EPI = false, bool SP2 = false>
__device__ __forceinline__ void gemm_phase(PG8_LAS unsigned char* lds, const Gemm g, const Sched& S, const Epi& E) {
    int tid = threadIdx.x; asm volatile("" : "+v"(tid));
    const int wid = __builtin_amdgcn_readfirstlane(tid >> 6), lane = tid & 63, wr = wid >> 2, wc = wid & 3, fr = lane & 15, fq = lane >> 4;
    const int K = g.K, nt = K / BK;
    unsigned voffA[2], voffB[2];
#pragma unroll
    for (int i = 0; i < 2; ++i) { int R, C; stage_rc(tid * 16 + i * 8192, R, C); const int Rb = Epi::PERM ? ((R & ~31) + perm32(R & 31)) : R;
        voffA[i] = (unsigned)(R * g.lda + C) * 2u; voffB[i] = (unsigned)(Rb * g.ldb + C) * 2u; }
    const size_t kstep = (size_t)(BK * 2);
    const size_t hstepA = (size_t)HALF * g.lda * 2, hstepB = (size_t)HALF * g.ldb * 2;
    const size_t tstepA = 2 * hstepA, tstepB = 2 * hstepB;
    const unsigned ldsw = (unsigned)wid * 1024u;
    const int aoff = lds_byte(wr * 64 + fr, fq * 8), boff = lds_byte(wc * 32 + fr, fq * 8);
#define PG8_SA(b, h) (((b) * 2 + (h)) * HTB)
#define PG8_SB(b, h) ((4 + (b) * 2 + (h)) * HTB)
#define PG8_STAGE(bufoff, gbase, voff) do { _Pragma("unroll") for (int _i = 0; _i < 2; ++_i) \
        __builtin_amdgcn_global_load_lds((const unsigned*)((const char*)(gbase) + (voff)[_i]), (PG8_LAS unsigned*)(lds + (bufoff) + ldsw + _i * 8192), 16, 0, 0); } while (0)
#define PG8_LDA(dst, b, h) do { _Pragma("unroll") for (int m = 0; m < 4; ++m) _Pragma("unroll") for (int k = 0; k < 2; ++k) dst[m][k] = *(const PG8_LAS bf16x8*)(lds + PG8_SA(b, h) + aoff + m * 2048 + k * 1024); } while (0)
#define PG8_LDB(dst, b, h) do { _Pragma("unroll") for (int n = 0; n < 2; ++n) _Pragma("unroll") for (int k = 0; k < 2; ++k) dst[n][k] = *(const PG8_LAS bf16x8*)(lds + PG8_SB(b, h) + boff + n * 2048 + k * 1024); } while (0)
#define PG8_MMA(ai, bj, At, Bt) do { __builtin_amdgcn_s_setprio(1); _Pragma("unroll") for (int m = 0; m < 4; ++m) _Pragma("unroll") for (int n = 0; n < 2; ++n) _Pragma("unroll") for (int k = 0; k < 2; ++k) \
        acc[ai][bj][m][n] = __builtin_amdgcn_mfma_f32_16x16x32_bf16(Bt[n][k], At[m][k], acc[ai][bj][m][n], 0, 0, 0); __builtin_amdgcn_s_setprio(0); } while (0)
#define PG8_WAIT_V(n) asm volatile("s_waitcnt vmcnt(" #n ")" ::: "memory")
#define PG8_WAIT_L(n) asm volatile("s_waitcnt lgkmcnt(" #n ")" ::: "memory")
#define PG8_BAR __builtin_amdgcn_s_barrier()
#define PG8_SCHED __builtin_amdgcn_sched_barrier(0)
    Unit cur, nxt; int ui = 0;
    if (!S.next(0, cur)) return;
    f32x4 acc[2][2][4][2];
#pragma unroll
    for (int a = 0; a < 2; ++a)
#pragma unroll
        for (int b = 0; b < 2; ++b)
#pragma unroll
            for (int m = 0; m < 4; ++m)
#pragma unroll
                for (int n = 0; n < 2; ++n) acc[a][b][m][n] = (f32x4){0.f, 0.f, 0.f, 0.f};
    bf16x8 At[4][2], B0[2][2], B1[2][2];
    const char* cA = (const char*)g.A + (size_t)cur.pm * tstepA; const char* cB = (const char*)g.Bt + (size_t)cur.pn * tstepB;
    S.a_ready(cur);
    if constexpr (SP2) {
        PG8_STAGE(PG8_SB(0, 0), cB, voffB); PG8_STAGE(PG8_SB(0, 1), cB + hstepB, voffB); PG8_STAGE(PG8_SA(0, 0), cA, voffA); PG8_STAGE(PG8_SA(0, 1), cA + hstepA, voffA);
        if (wr == 1) PG8_BAR;
        PG8_WAIT_V(2); PG8_BAR;
        PG8_STAGE(PG8_SB(1, 0), cB + kstep, voffB); PG8_STAGE(PG8_SA(1, 0), cA + kstep, voffA); PG8_STAGE(PG8_SB(1, 1), cB + hstepB + kstep, voffB);
        PG8_WAIT_V(6); PG8_BAR;
    } else {
        PG8_STAGE(PG8_SB(0, 0), cB, voffB); PG8_STAGE(PG8_SA(0, 0), cA, voffA); PG8_STAGE(PG8_SB(0, 1), cB + hstepB, voffB); PG8_STAGE(PG8_SA(0, 1), cA + hstepA, voffA);
        if (wr == 1) PG8_BAR;
        PG8_WAIT_V(4); PG8_BAR;
        PG8_STAGE(PG8_SB(1, 0), cB + kstep, voffB); PG8_STAGE(PG8_SA(1, 0), cA + kstep, voffA); PG8_STAGE(PG8_SB(1, 1), cB + hstepB + kstep, voffB);
        PG8_WAIT_V(6); PG8_BAR;
    }
    for (;;) {
        const bool has_next = S.next(ui + 1, nxt);
        const char* nA = has_next ? (const char*)g.A + (size_t)nxt.pm * tstepA : cA; const char* nB = has_next ? (const char*)g.Bt + (size_t)nxt.pn * tstepB : cB;
        for (int t = 0; t < nt; t += 2) {
#if defined(KLOOP_ALIGN)
            asm volatile(".p2align 6\n\t.rept " PG8_STR(KLOOP_ALIGN) "\n\ts_nop 0\n\t.endr");
#endif
            const bool last = (t == nt - 2);
            const char* a1 = cA + (size_t)(t + 1) * kstep;
            const char* a2 = last ? nA : cA + (size_t)(t + 2) * kstep; const char* b2 = last ? nB : cB + (size_t)(t + 2) * kstep;
            const char* a3 = a2 + kstep; const char* b3 = b2 + kstep;
            if (last && has_next) S.a_ready(nxt);
            if constexpr (SP2) {
            PG8_LDB(B0, 0, 0); PG8_LDB(B1, 0, 1); PG8_SCHED; PG8_LDA(At, 0, 0); PG8_STAGE(PG8_SA(1, 1), a1 + hstepA, voffA);
            PG8_WAIT_V(8); PG8_WAIT_L(0); PG8_BAR; PG8_MMA(0, 0, At, B0); PG8_MMA(0, 1, At, B1); PG8_BAR; PG8_SCHED;
            PG8_LDA(At, 0, 1); PG8_STAGE(PG8_SB(0, 0), b2, voffB); PG8_STAGE(PG8_SB(0, 1), b2 + hstepB, voffB); PG8_STAGE(PG8_SA(0, 0), a2, voffA);
            PG8_WAIT_V(8); PG8_WAIT_L(0); PG8_BAR; PG8_MMA(1, 0, At, B0); PG8_MMA(1, 1, At, B1); PG8_BAR; PG8_SCHED;
            PG8_LDB(B0, 1, 0); PG8_LDB(B1, 1, 1); PG8_SCHED; PG8_LDA(At, 1, 0); PG8_STAGE(PG8_SA(0, 1), a2 + hstepA, voffA);
            PG8_WAIT_V(8); PG8_WAIT_L(0); PG8_BAR; PG8_MMA(0, 0, At, B0); PG8_MMA(0, 1, At, B1); PG8_BAR; PG8_SCHED;
            PG8_LDA(At, 1, 1); PG8_STAGE(PG8_SB(1, 0), b3, voffB); PG8_STAGE(PG8_SB(1, 1), b3 + hstepB, voffB); PG8_STAGE(PG8_SA(1, 0), a3, voffA);
            PG8_WAIT_V(8); PG8_WAIT_L(0); PG8_BAR; PG8_MMA(1, 0, At, B0); PG8_MMA(1, 1, At, B1); PG8_BAR; PG8_SCHED;
            } else {
            PG8_LDB(B0, 0, 0); PG8_SCHED; PG8_LDA(At, 0, 0); PG8_STAGE(PG8_SA(1, 1), a1 + hstepA, voffA);
            PG8_WAIT_L(8); PG8_BAR; PG8_WAIT_L(0); PG8_MMA(0, 0, At, B0); PG8_BAR; PG8_SCHED;
            PG8_LDB(B1, 0, 1); PG8_STAGE(PG8_SB(0, 0), b2, voffB);
            PG8_BAR; PG8_WAIT_L(0); PG8_MMA(0, 1, At, B1); PG8_BAR;
            PG8_LDA(At, 0, 1); PG8_STAGE(PG8_SA(0, 0), a2, voffA);
            PG8_BAR; PG8_WAIT_L(0); PG8_MMA(1, 0, At, B0); PG8_BAR; PG8_SCHED;
            PG8_STAGE(PG8_SB(0, 1), b2 + hstepB, voffB);
            PG8_WAIT_V(6); PG8_BAR; PG8_MMA(1, 1, At, B1); PG8_BAR;
            PG8_LDB(B0, 1, 0); PG8_SCHED; PG8_LDA(At, 1, 0); PG8_STAGE(PG8_SA(0, 1), a2 + hstepA, voffA);
            PG8_WAIT_L(8); PG8_BAR; PG8_WAIT_L(0); PG8_MMA(0, 0, At, B0); PG8_BAR; PG8_SCHED;
            PG8_LDB(B1, 1, 1); PG8_STAGE(PG8_SB(1, 0), b3, voffB);
            PG8_BAR; PG8_WAIT_L(0); PG8_MMA(0, 1, At, B1); PG8_BAR;
            PG8_LDA(At, 1, 1); PG8_STAGE(PG8_SA(1, 0), a3, voffA);
            PG8_BAR; PG8_WAIT_L(0); PG8_MMA(1, 0, At, B0); PG8_BAR; PG8_SCHED;
            PG8_STAGE(PG8_SB(1, 1), b3 + hstepB, voffB);
            PG8_WAIT_V(6); PG8_BAR; PG8_MMA(1, 1, At, B1); PG8_BAR;
            }
        }
        if constexpr (ALIGN_EPI) { if (wr == 0) PG8_BAR; }
        if constexpr (!Epi::AFTER_DRAIN) { E(acc, cur, wr, wc, fr, fq); S.done(cur); }
        if (!has_next) break;
#pragma unroll
        for (int a = 0; a < 2; ++a)
#pragma unroll
            for (int b = 0; b < 2; ++b)
#pragma unroll
                for (int m = 0; m < 4; ++m)
#pragma unroll
                    for (int n = 0; n < 2; ++n) acc[a][b][m][n] = (f32x4){0.f, 0.f, 0.f, 0.f};
        cur = nxt; cA = nA; cB = nB; ++ui;
        if constexpr (ALIGN_EPI) { if (wr == 1) PG8_BAR; }
    }
    PG8_WAIT_V(0);
    if constexpr (!ALIGN_EPI) { if (wr == 0) PG8_BAR; }
    PG8_BAR;
    if constexpr (Epi::AFTER_DRAIN) { E.fused(acc, cur, wr, wc, fr, fq, lds, wid, lane); S.done(cur); }
#undef PG8_SA
#undef PG8_SB
#undef PG8_STAGE
#undef PG8_LDA
#undef PG8_LDB
#undef PG8_MMA
#undef PG8_WAIT_V
#undef PG8_WAIT_L
#undef PG8_BAR
#undef PG8_SCHED
}
}
#include <hip/hip_bf16.h>
#include <cmath>
namespace attn_body {
using bf16=__hip_bfloat16;
using bf16x8=__attribute__((ext_vector_type(8)))short;
using s16x4=__attribute__((ext_vector_type(4)))short;
using f32x16=__attribute__((ext_vector_type(16)))float;
using u32x4=__attribute__((ext_vector_type(4)))unsigned;
constexpr int BATCH=8,NHEAD=16,SEQ=2048,D=64,DM=NHEAD*D;
constexpr int NW=8,QBLK=32,QB=QBLK*NW,KVBLK=64,NQB=SEQ/QB;
constexpr int ATTN_PITCH=DM, ATTN_UNIT_ROWS=QB;
__device__ __forceinline__ int crow(int r,int hi){return (r&3)+8*(r>>2)+4*hi;}
#define SBAR() __builtin_amdgcn_sched_barrier(0)
__device__ __forceinline__ void cmask(f32x16&p0,f32x16&p1,int jb,int qrel,int hi){
  const float NEG=-INFINITY; int kb=64*jb+4*hi;
  #pragma unroll
  for(int r=0;r<16;++r){int kv=kb+(r&3)+8*(r>>2); if(kv>qrel)p0[r]=NEG; if(kv+32>qrel)p1[r]=NEG;}
}

constexpr int NSLOT=3, SLOTB=8192;
constexpr int LDS_K=0, LDS_V=NSLOT*SLOTB, LDS_WS=2*NSLOT*SLOTB, LDS_OST=LDS_WS+NW*64*4, LDS_BYTES=LDS_OST+NW*4096;
constexpr float C2=0.125f*1.4426950408889634f;
__device__ __forceinline__ void glds16(const void*gsrc,unsigned lds_dst){unsigned keep;
  asm volatile("s_mov_b32 %0, m0\n\ts_mov_b32 m0, %2\n\ts_nop 0\n\tglobal_load_lds_dwordx4 %1, off\n\ts_mov_b32 m0, %0":"=&s"(keep):"v"(gsrc),"s"(lds_dst):"memory");}
__device__ __forceinline__ void glds16s(const void*sbase,unsigned voff,unsigned lds_dst){unsigned keep;
  asm volatile("s_mov_b32 %0, m0\n\ts_mov_b32 m0, %2\n\ts_nop 0\n\tglobal_load_lds_dwordx4 %1, %3\n\ts_mov_b32 m0, %0":"=&s"(keep):"v"(voff),"s"(lds_dst),"s"(sbase):"memory");}
__device__ __forceinline__ float max3f(float a,float b,float c){float r;asm("v_max3_f32 %0, %1, %2, %3":"=v"(r):"v"(a),"v"(b),"v"(c));return r;}
__device__ __forceinline__ float max2f(float a,float b){float r;asm("v_max_f32_e32 %0, %1, %2":"=v"(r):"v"(a),"v"(b));return r;}
__device__ __forceinline__ float fadd_s(float a,float b){float r;asm("v_add_f32_e32 %0, %1, %2":"=v"(r):"v"(a),"v"(b));return r;}
__device__ __forceinline__ float fsub_s(float a,float b){float r;asm("v_sub_f32_e32 %0, %1, %2":"=v"(r):"v"(a),"v"(b));return r;}
typedef float f32x2_t __attribute__((ext_vector_type(2))); typedef __bf16 bf16x2_t __attribute__((ext_vector_type(2)));
__device__ __forceinline__ unsigned cvtpk_s(float lo,float hi){f32x2_t v={lo,hi};bf16x2_t b=__builtin_convertvector(v,bf16x2_t);return __builtin_bit_cast(unsigned,b);}
#define WAIT_BAR(N) asm volatile("s_waitcnt vmcnt(" #N ") lgkmcnt(0)\n\ts_barrier":::"memory")

__device__ __forceinline__ void qkt(f32x16&p0,f32x16&p1,const char*Kslot,const bf16x8*qr,const f32x16&negm,int r32,int hi){
  const char*kb=Kslot+hi*1024+r32*16;
  #pragma unroll
  for(int d0=0;d0<4;++d0){
    const bf16x8 b0=*reinterpret_cast<const bf16x8*>(kb+d0*2048);
    const bf16x8 b1=*reinterpret_cast<const bf16x8*>(kb+d0*2048+512);
    if(d0==0){p0=__builtin_amdgcn_mfma_f32_32x32x16_bf16(b0,qr[0],negm,0,0,0);p1=__builtin_amdgcn_mfma_f32_32x32x16_bf16(b1,qr[0],negm,0,0,0);}
    else{p0=__builtin_amdgcn_mfma_f32_32x32x16_bf16(b0,qr[d0],p0,0,0,0);p1=__builtin_amdgcn_mfma_f32_32x32x16_bf16(b1,qr[d0],p1,0,0,0);}}
}
typedef __attribute__((address_space(3))) const char* lds_cptr;
typedef short v4i16_t __attribute__((ext_vector_type(4)));
__device__ __forceinline__ void kload8(bf16x8*kf,lds_cptr kp){
  kf[0]=*(const __attribute__((address_space(3))) bf16x8*)(kp);      kf[1]=*(const __attribute__((address_space(3))) bf16x8*)(kp+512);
  kf[2]=*(const __attribute__((address_space(3))) bf16x8*)(kp+2048); kf[3]=*(const __attribute__((address_space(3))) bf16x8*)(kp+2560);
  kf[4]=*(const __attribute__((address_space(3))) bf16x8*)(kp+4096); kf[5]=*(const __attribute__((address_space(3))) bf16x8*)(kp+4608);
  kf[6]=*(const __attribute__((address_space(3))) bf16x8*)(kp+6144); kf[7]=*(const __attribute__((address_space(3))) bf16x8*)(kp+6656);
}
__device__ __forceinline__ void kload2(bf16x8*kf,lds_cptr kp,int j){ kf[2*j]=*(const __attribute__((address_space(3))) bf16x8*)(kp+j*2048); kf[2*j+1]=*(const __attribute__((address_space(3))) bf16x8*)(kp+j*2048+512); }
__device__ __forceinline__ s16x4 vtr(lds_cptr p){ return __builtin_bit_cast(s16x4,__builtin_amdgcn_ds_read_tr16_b64_v4i16((__attribute__((address_space(3))) v4i16_t*)p)); }
__device__ __forceinline__ float rowmax(const f32x16&p0,const f32x16&p1){
  float a=max3f(p0[0],p0[1],p1[0]),b=max3f(p0[2],p0[3],p1[1]);a=max3f(a,p1[2],p1[3]);
  #pragma unroll
  for(int r=4;r<16;r+=4){a=max3f(a,p0[r],p0[r+1]);b=max3f(b,p0[r+2],p0[r+3]);a=max3f(a,p1[r],p1[r+1]);b=max3f(b,p1[r+2],p1[r+3]);}
  const float m=max2f(a,b);
  auto rr=__builtin_amdgcn_permlane32_swap(__float_as_uint(m),__float_as_uint(m),false,false);
  return max2f(__uint_as_float(rr[0]),__uint_as_float(rr[1]));
}
__device__ __forceinline__ void pv(f32x16*o,int vb,bf16x8 pa0,bf16x8 pa1,bf16x8 pa2,bf16x8 pa3){
  #pragma unroll
  for(int d0=0;d0<2;++d0){s16x4 lo[4],hi[4];
    #pragma unroll
    for(int ks=0;ks<4;++ks){
      asm volatile("ds_read_b64_tr_b16 %0,%1 offset:%c2":"=&v"(lo[ks]):"v"(vb),"i"(d0*4096+ks*1024):"memory");
      asm volatile("ds_read_b64_tr_b16 %0,%1 offset:%c2":"=&v"(hi[ks]):"v"(vb),"i"(d0*4096+ks*1024+512):"memory");}
    asm volatile("s_waitcnt lgkmcnt(0)":::"memory");SBAR();
    #define PK(k) (bf16x8){lo[k][0],lo[k][1],lo[k][2],lo[k][3],hi[k][0],hi[k][1],hi[k][2],hi[k][3]}
    o[d0]=__builtin_amdgcn_mfma_f32_32x32x16_bf16(pa0,PK(0),o[d0],0,0,0);
    o[d0]=__builtin_amdgcn_mfma_f32_32x32x16_bf16(pa1,PK(1),o[d0],0,0,0);
    o[d0]=__builtin_amdgcn_mfma_f32_32x32x16_bf16(pa2,PK(2),o[d0],0,0,0);
    o[d0]=__builtin_amdgcn_mfma_f32_32x32x16_bf16(pa3,PK(3),o[d0],0,0,0);
    #undef PK
  }
}

#ifndef ATTN_STORE16
#define ATTN_STORE16(p,v) (*(u32x4*)(p)=(v))
#endif
template<int THRL,int VAR=0> __device__ __forceinline__ void attn_unit(int b,int h,int qb,const bf16*Q,const bf16*__restrict__ K,const bf16*__restrict__ V,bf16*O,char*shm,const __attribute__((address_space(3))) float*cumL,int tskip){
  int tid=threadIdx.x; asm volatile("":"+v"(tid));
  const int lane=tid&63,r32=lane&31,hi=lane>>5; const int wid=__builtin_amdgcn_readfirstlane(tid>>6);
  const long rowbase=(long)b*SEQ; const int q0=qb*QB;
  const bf16*Qw=Q+(rowbase+q0+wid*QBLK)*DM+h*D;
  const bf16*Kh=K+(rowbase+(long)tskip*KVBLK)*DM+h*D,*Vh=V+(rowbase+(long)tskip*KVBLK)*DM+h*D;
  const unsigned lds0=(unsigned)(uintptr_t)shm;
  float*wsf=(float*)(shm+LDS_WS)+wid*64;
  const bf16*ksrc=Kh+(long)lane*DM+wid*8;
  const bf16*vsrc=Vh+(long)(16*(wid&3)+(lane>>2))*DM+(wid>>2)*32+(lane&3)*8;
  const unsigned kdst=lds0+LDS_K+wid*1024, vdst=lds0+LDS_V+wid*1024;
  #define DMA_K(t,slot) glds16(ksrc+(long)(t)*KVBLK*DM,(unsigned)__builtin_amdgcn_readfirstlane(kdst+(slot)))
  #define DMA_V(t,slot) glds16(vsrc+(long)(t)*KVBLK*DM,(unsigned)__builtin_amdgcn_readfirstlane(vdst+(slot)))
  const int vb0=(int)(lds0+LDS_V)+((lane>>4)&1)*32+(lane&3)*8+(4*hi+((lane&15)>>2))*64;
  const char*Kbase=shm+LDS_K; bf16x8 kf[8];
  const lds_cptr shm3=(lds_cptr)shm; const lds_cptr kp0=shm3+LDS_K+hi*1024+r32*16; const lds_cptr vp0=shm3+LDS_V+((lane>>4)&1)*32+(lane&3)*8+(4*hi+((lane&15)>>2))*64;
  const int NT=(q0+QB)/KVBLK-tskip;
  DMA_K(0,0);DMA_V(0,0);DMA_K(1,SLOTB);
  bf16x8 qr[4];
  #pragma unroll
  for(int d0=0;d0<4;++d0)qr[d0]=*reinterpret_cast<const bf16x8*>(&Qw[(long)r32*DM+d0*16+hi*8]);
  const float cq=cumL[qb*QB+wid*QBLK+r32];
  float mhat=0.f,l_reg=0.f;f32x16 o[2];o[0]=f32x16{};o[1]=f32x16{};const f32x16 negm=f32x16{};
  typedef float f32x4_t __attribute__((ext_vector_type(4)));
  #define KBIAS(P0,P1,t) do{ if(VAR&1){ const float nm1_=cq-mhat; _Pragma("unroll") for(int r_=0;r_<16;++r_){P0[r_]+=nm1_;P1[r_]+=nm1_;} break; } const float nm_=cq-mhat; const __attribute__((address_space(3))) float*cb_=cumL+64*((t)+tskip)+4*hi; \
    _Pragma("unroll") for(int g_=0;g_<4;++g_){ const f32x4_t k0_=*(const __attribute__((address_space(3))) f32x4_t*)(cb_+8*g_); const f32x4_t k1_=*(const __attribute__((address_space(3))) f32x4_t*)(cb_+32+8*g_); \
      _Pragma("unroll") for(int e_=0;e_<4;++e_){ P0[4*g_+e_]+=(nm_-k0_[e_]); P1[4*g_+e_]+=(nm_-k1_[e_]); } } }while(0)
  const int qrel=wid*QBLK+r32;
  #define CMASK(P0,P1,t) do{int jb_=(t)-(NT-4); if(jb_>=0)cmask(P0,P1,jb_,qrel,hi);}while(0)
  bool resc=false;
  #define START(P0,P1) do{ const float rm=rowmax(P0,P1); resc=false; \
    { const float dl=rm; mhat=fadd_s(mhat,dl); \
      _Pragma("unroll") for(int r=0;r<16;++r){P0[r]=fsub_s(P0[r],dl);P1[r]=fsub_s(P1[r],dl);} \
      } \
    _Pragma("unroll") for(int r=0;r<16;++r)P0[r]=__builtin_amdgcn_exp2f(P0[r]); }while(0)
  #define RESC() do{ if(resc){ asm volatile("s_waitcnt lgkmcnt(0)":::"memory"); \
      _Pragma("unroll") for(int d_=0;d_<2;++d_) _Pragma("unroll") for(int r=0;r<16;++r)o[d_][r]*=wsf[crow(r,hi)]; } }while(0)
  f32x16 pA0,pA1,pB0,pB1;
  int sl_prev=0,sl_cur=0,sl_next=SLOTB;
  #define ROT() do{sl_prev=sl_cur;sl_cur=sl_next;sl_next=(sl_next==(NSLOT-1)*SLOTB)?0:sl_next+SLOTB;}while(0)
  DMA_K(2,2*SLOTB);
  WAIT_BAR(3);
  qkt(pA0,pA1,Kbase,qr,negm,r32,hi);asm volatile("s_nop 15\n\ts_nop 7":"+v"(pA0),"+v"(pA1));KBIAS(pA0,pA1,0);CMASK(pA0,pA1,0);
  START(pA0,pA1);
  _Pragma("unroll") for(int r=0;r<16;++r)pA1[r]=__builtin_amdgcn_exp2f(pA1[r]);
  WAIT_BAR(0);
  DMA_K(3,0);DMA_V(1,SLOTB);
  ROT();
  kload8(kf,kp0+sl_cur);
  WAIT_BAR(2);
  s16x4 vlo[8],vhi[8]; u32x4 pw0,pw1,pw2,pw3;
  #define PKW(P,B) cvtpk_s(P[B],P[B+1])
  #define PAF(k) __builtin_bit_cast(bf16x8,pw##k)
  #define VFR(i) (bf16x8){vlo[i][0],vlo[i][1],vlo[i][2],vlo[i][3],vhi[i][0],vhi[i][1],vhi[i][2],vhi[i][3]}
  #define PIN(x) asm volatile("":"+v"(x))
  #define MX3(a,b,c) __builtin_fmaxf(__builtin_fmaxf((a),(b)),(c))
  #define GAPA(MF,A0,A1,A2,A3,W0,W1,PW) do{ MF; sacc+=A0; sacc+=A1; sacc+=A2; sacc+=A3; PIN(sacc); W0; W1; PIN(PW); SBAR(); }while(0)
  #define EX(v) __builtin_amdgcn_exp2f(v)
  #define GAPB(MF,X,B) do{ MF; X[B]=EX(X[B]); X[B+1]=EX(X[B+1]); X[B+2]=EX(X[B+2]); X[B+3]=EX(X[B+3]); PIN(X); SBAR(); }while(0)
  #define VRD(i) do{ vlo[i]=vtr(vp_+(((i)>>2)*4096+((i)&3)*1024)); vhi[i]=vtr(vp_+(((i)>>2)*4096+((i)&3)*1024+512)); }while(0)
  #define KRD(G,j) do{ if(G){ kload2(kf,kp0+sl_next,j); SBAR(); } }while(0)
  #define STEP(C0,C1,P0,P1,t,GK,GV,GL) do{ SBAR(); \
    const lds_cptr vp_=vp0+sl_prev; \
    VRD(0); SBAR(); float sacc=(P0[0]+P0[1]); \
    GAPA(C0=__builtin_amdgcn_mfma_f32_32x32x16_bf16(kf[0],qr[0],negm,0,0,0), P0[2],P0[3],P0[4],P0[5],     pw0[0]=PKW(P0,0), pw0[1]=PKW(P0,2), pw0); \
    VRD(4); SBAR(); GAPA(C1=__builtin_amdgcn_mfma_f32_32x32x16_bf16(kf[1],qr[0],negm,0,0,0), P0[6],P0[7],P0[8],P0[9],     pw0[2]=PKW(P0,4), pw0[3]=PKW(P0,6), pw0); \
    VRD(1); SBAR(); GAPA(C0=__builtin_amdgcn_mfma_f32_32x32x16_bf16(kf[2],qr[1],C0,0,0,0),   P0[10],P0[11],P0[12],P0[13], pw1[0]=PKW(P0,8), pw1[1]=PKW(P0,10), pw1); \
    VRD(5); SBAR(); GAPA(C1=__builtin_amdgcn_mfma_f32_32x32x16_bf16(kf[3],qr[1],C1,0,0,0),   P0[14],P0[15],P1[0],P1[1],   pw1[2]=PKW(P0,12),pw1[3]=PKW(P0,14), pw1); \
    VRD(2); SBAR(); GAPA(C0=__builtin_amdgcn_mfma_f32_32x32x16_bf16(kf[4],qr[2],C0,0,0,0),   P1[2],P1[3],P1[4],P1[5],     pw2[0]=PKW(P1,0), pw2[1]=PKW(P1,2), pw2); \
    VRD(6); SBAR(); GAPA(C1=__builtin_amdgcn_mfma_f32_32x32x16_bf16(kf[5],qr[2],C1,0,0,0),   P1[6],P1[7],P1[8],P1[9],     pw2[2]=PKW(P1,4), pw2[3]=PKW(P1,6), pw2); \
    VRD(3); SBAR(); GAPA(C0=__builtin_amdgcn_mfma_f32_32x32x16_bf16(kf[6],qr[3],C0,0,0,0),   P1[10],P1[11],P1[12],P1[13], pw3[0]=PKW(P1,8), pw3[1]=PKW(P1,10), pw3); \
    VRD(7); SBAR(); GAPA(C1=__builtin_amdgcn_mfma_f32_32x32x16_bf16(kf[7],qr[3],C1,0,0,0),   P1[14],P1[15],0.f,0.f,       pw3[2]=PKW(P1,12),pw3[3]=PKW(P1,14), pw3); \
    l_reg+=sacc; \
    if(GK){DMA_K((t)+3,sl_cur);} if(GV){DMA_V((t)+1,sl_next);} \
    KBIAS(C0,C1,t); CMASK(C0,C1,t); \
    { float a=MX3(C0[0],C0[1],C1[0]),b=MX3(C0[2],C0[3],C1[1]); a=MX3(a,C1[2],C1[3]); \
      _Pragma("unroll") for(int r=4;r<16;r+=4){a=MX3(a,C0[r],C0[r+1]);b=MX3(b,C0[r+2],C0[r+3]);a=MX3(a,C1[r],C1[r+1]);b=MX3(b,C1[r+2],C1[r+3]);} \
      float rm=__builtin_fmaxf(a,b); { auto rr=__builtin_amdgcn_permlane32_swap(__float_as_uint(rm),__float_as_uint(rm),false,false); rm=__builtin_fmaxf(__uint_as_float(rr[0]),__uint_as_float(rr[1])); } \
      resc=false; \
      if(__builtin_expect(__any(rm>(float)THRL),0)){ const float dl=__builtin_fmaxf(rm,0.f); mhat+=dl; \
        _Pragma("unroll") for(int r=0;r<16;++r){C0[r]-=dl;C1[r]-=dl;} \
        const float f=__builtin_amdgcn_exp2f(-dl); l_reg*=f; if(hi==0)wsf[r32]=f; resc=true; } } \
    SBAR(); \
    GAPB(o[0]=__builtin_amdgcn_mfma_f32_32x32x16_bf16(PAF(0),VFR(0),o[0],0,0,0), C0,0); \
    GAPB(o[1]=__builtin_amdgcn_mfma_f32_32x32x16_bf16(PAF(0),VFR(4),o[1],0,0,0), C0,4); \
    KRD(GL,0); GAPB(o[0]=__builtin_amdgcn_mfma_f32_32x32x16_bf16(PAF(1),VFR(1),o[0],0,0,0), C0,8); \
    KRD(GL,1); GAPB(o[1]=__builtin_amdgcn_mfma_f32_32x32x16_bf16(PAF(1),VFR(5),o[1],0,0,0), C0,12); \
    KRD(GL,2); GAPB(o[0]=__builtin_amdgcn_mfma_f32_32x32x16_bf16(PAF(2),VFR(2),o[0],0,0,0), C1,0); \
    KRD(GL,3); GAPB(o[1]=__builtin_amdgcn_mfma_f32_32x32x16_bf16(PAF(2),VFR(6),o[1],0,0,0), C1,4); \
    GAPB(o[0]=__builtin_amdgcn_mfma_f32_32x32x16_bf16(PAF(3),VFR(3),o[0],0,0,0), C1,8); \
    GAPB(o[1]=__builtin_amdgcn_mfma_f32_32x32x16_bf16(PAF(3),VFR(7),o[1],0,0,0), C1,12); \
    }while(0)
  int t=1;
  #undef CMASK
  #define CMASK(P0,P1,t) do{}while(0)
  for(;t+5<NT;t+=2){
    STEP(pB0,pB1,pA0,pA1,t,true,true,true);     WAIT_BAR(2); RESC(); ROT();
    STEP(pA0,pA1,pB0,pB1,t+1,true,true,true);   WAIT_BAR(2); RESC(); ROT();
  }
  #undef CMASK
  #define CMASK(P0,P1,t) do{int jb_=(t)-(NT-4); if(jb_>=0)cmask(P0,P1,jb_,qrel,hi);}while(0)
  #define ENDW(tt) do{ if((tt)+3<NT){WAIT_BAR(2);} else if((tt)+2<NT){WAIT_BAR(1);} else {WAIT_BAR(0);} }while(0)
  for(;t+1<NT;t+=2){
    STEP(pB0,pB1,pA0,pA1,t,(t+3<NT),(t+1<NT),(t+1<NT));       ENDW(t);   RESC(); ROT();
    STEP(pA0,pA1,pB0,pB1,t+1,(t+4<NT),(t+2<NT),(t+2<NT));     ENDW(t+1); RESC(); ROT();
  }
  STEP(pB0,pB1,pA0,pA1,NT-1,false,false,false); RESC();
  { float sacc=pB0[0]+pB0[1]; _Pragma("unroll") for(int r=2;r<16;++r)sacc+=pB0[r]; _Pragma("unroll") for(int r=0;r<16;++r)sacc+=pB1[r]; l_reg+=sacc;
    pw0=(u32x4){PKW(pB0,0),PKW(pB0,2),PKW(pB0,4),PKW(pB0,6)};pw1=(u32x4){PKW(pB0,8),PKW(pB0,10),PKW(pB0,12),PKW(pB0,14)};pw2=(u32x4){PKW(pB1,0),PKW(pB1,2),PKW(pB1,4),PKW(pB1,6)};pw3=(u32x4){PKW(pB1,8),PKW(pB1,10),PKW(pB1,12),PKW(pB1,14)};
    SBAR(); pv(o,vb0+sl_cur,PAF(0),PAF(1),PAF(2),PAF(3)); }
  #undef PKW
  #undef PAF
  #undef VFR
  #undef PIN
  #undef MX3
  #undef GAPA
  #undef GAPB
  #undef EX
  #undef VRD
  #undef KRD
  #undef STEP
  #undef ENDW
  {auto rr=__builtin_amdgcn_permlane32_swap(__float_as_uint(l_reg),__float_as_uint(l_reg),false,false);l_reg=__uint_as_float(rr[0])+__uint_as_float(rr[1]);}
  if(hi==0)wsf[32+r32]=l_reg;asm volatile("s_waitcnt lgkmcnt(0)":::"memory");
  float rli[16];
  #pragma unroll
  for(int r=0;r<16;++r)rli[r]=__builtin_amdgcn_rcpf(wsf[32+crow(r,hi)]);
  bf16*Ow=O+(rowbase+q0+wid*QBLK)*DM+h*D;
  { bf16*stg=(bf16*)(shm+LDS_OST)+wid*2048;
    #pragma unroll
    for(int r=0;r<16;++r){const int orow=crow(r,hi);
      #pragma unroll
      for(int d0=0;d0<2;++d0)stg[orow*64+d0*32+r32]=__float2bfloat16(o[d0][r]*rli[r]);}
    asm volatile("s_waitcnt lgkmcnt(0)":::"memory");
    #pragma unroll
    for(int i=0;i<4;++i){const int row=i*8+(lane>>3),ch=lane&7; const u32x4 v=*(const u32x4*)(stg+row*64+ch*8); ATTN_STORE16(Ow+(long)row*DM+ch*8,v);} }
  asm volatile("s_waitcnt lgkmcnt(0)\n\ts_barrier":::"memory");
  #undef KBIAS
  #undef DMA_K
  #undef DMA_V
  #undef CMASK
  #undef START
  #undef RESC
  #undef ROT
}
template<bool WIN,int THRL> __device__ __forceinline__ void nsa_branch_pipe(const bf16*__restrict__ Kb,const bf16*__restrict__ Vb,const __attribute__((address_space(3))) int*tl,int NT,int qc,const bf16x8*qr,unsigned selbits,
    const __attribute__((address_space(3))) float*luth,char*shm,float&l_out,f32x16(&o)[2]){
  int tid=threadIdx.x; asm volatile("":"+v"(tid));
  const int lane=tid&63,r32=lane&31,hi=lane>>5; const int wid=__builtin_amdgcn_readfirstlane(tid>>6);
  const unsigned lds0=(unsigned)(uintptr_t)shm;
  float*wsf=(float*)(shm+LDS_WS)+wid*64;
  const unsigned koff=(unsigned)(lane*64+wid*8)*2u, voff=(unsigned)((16*(wid&3)+(lane>>2))*64+(wid>>2)*32+(lane&3)*8)*2u;
  #define TLJ(t) (__builtin_amdgcn_readfirstlane(tl[t])&63)
  const unsigned kdst=lds0+LDS_K+wid*1024, vdst=lds0+LDS_V+wid*1024;
  #define DMA_K(t,slot) glds16s((const char*)Kb+(size_t)TLJ(t)*8192,koff,(unsigned)__builtin_amdgcn_readfirstlane(kdst+(slot)))
  #define DMA_V(t,slot) glds16s((const char*)Vb+(size_t)TLJ(t)*8192,voff,(unsigned)__builtin_amdgcn_readfirstlane(vdst+(slot)))
  const int vb0=(int)(lds0+LDS_V)+((lane>>4)&1)*32+(lane&3)*8+(4*hi+((lane&15)>>2))*64;
  const char*Kbase=shm+LDS_K; bf16x8 kf[8];
  const lds_cptr shm3=(lds_cptr)shm; const lds_cptr kp0=shm3+LDS_K+hi*1024+r32*16; const lds_cptr vp0=shm3+LDS_V+((lane>>4)&1)*32+(lane&3)*8+(4*hi+((lane&15)>>2))*64;
  DMA_K(0,0);DMA_V(0,0);DMA_K(1,SLOTB);
  const int qi=(wid&1)*QBLK+r32;
  float mhat=0.f,l_reg=0.f;o[0]=f32x16{};o[1]=f32x16{};const f32x16 negm=f32x16{};
  unsigned amA=0xffffffffu,amB=0xffffffffu;
  #define NSAHOOK(C0,C1,t,AM) do{ const int e_=__builtin_amdgcn_readfirstlane(tl[t]); const int j_=e_&63, dq_=qc-j_; \
    { const float nm_=-mhat; _Pragma("unroll") for(int r_=0;r_<16;++r_){ C0[r_]+=nm_; C1[r_]+=nm_; } } \
    if(dq_<=2){ const volatile __attribute__((address_space(3))) float*lp_=luth+(64*dq_+qi+1-4*hi);     \
      _Pragma("unroll") for(int r_=0;r_<16;++r_){ const int ko_=(r_&3)+8*(r_>>2); C0[r_]+=lp_[63-ko_]; C1[r_]+=lp_[31-ko_]; } } \
    if(dq_==0){ _Pragma("unroll") for(int r_=0;r_<16;++r_){ const int kid_=4*hi+(r_&3)+8*(r_>>2); if(kid_>qi)C0[r_]=-1e30f; if(kid_+32>qi)C1[r_]=-1e30f; } } \
    if(WIN&&dq_==8){ _Pragma("unroll") for(int r_=0;r_<16;++r_){ const int kid_=4*hi+(r_&3)+8*(r_>>2); if(kid_<=qi)C0[r_]=-1e30f; if(kid_+32<=qi)C1[r_]=-1e30f; } } \
    AM=((e_>=0)&&(WIN||((selbits>>j_)&1u)))?0xffffffffu:0u; }while(0)
  bool resc=false;
  #define START(P0,P1) do{ const float rm=rowmax(P0,P1); resc=false; \
    { const float dl=__builtin_fmaxf(rm,-100.f); mhat=fadd_s(mhat,dl);     \
      _Pragma("unroll") for(int r=0;r<16;++r){P0[r]=fsub_s(P0[r],dl);P1[r]=fsub_s(P1[r],dl);} \
      } \
    _Pragma("unroll") for(int r=0;r<16;++r)P0[r]=__builtin_amdgcn_exp2f(P0[r]); }while(0)
  #define RESC() do{ if(resc){ asm volatile("s_waitcnt lgkmcnt(0)":::"memory"); \
      _Pragma("unroll") for(int d_=0;d_<2;++d_) _Pragma("unroll") for(int r=0;r<16;++r)o[d_][r]*=wsf[crow(r,hi)]; } }while(0)
  f32x16 pA0,pA1,pB0,pB1;
  int sl_prev=0,sl_cur=0,sl_next=SLOTB;
  #define ROT() do{sl_prev=sl_cur;sl_cur=sl_next;sl_next=(sl_next==(NSLOT-1)*SLOTB)?0:sl_next+SLOTB;}while(0)
  DMA_K(2,2*SLOTB);
  WAIT_BAR(3);
  qkt(pA0,pA1,Kbase,qr,negm,r32,hi);asm volatile("s_nop 15\n\ts_nop 7":"+v"(pA0),"+v"(pA1));NSAHOOK(pA0,pA1,0,amA);
  START(pA0,pA1);
  _Pragma("unroll") for(int r=0;r<16;++r)pA1[r]=__builtin_amdgcn_exp2f(pA1[r]);
  WAIT_BAR(0);
  DMA_K(3,0);DMA_V(1,SLOTB);
  ROT();
  kload8(kf,kp0+sl_cur);
  WAIT_BAR(2);
  s16x4 vlo[8],vhi[8]; u32x4 pw0,pw1,pw2,pw3;
  #define PKW(P,B) cvtpk_s(P[B],P[B+1])
  #define PAF(k) __builtin_bit_cast(bf16x8,pw##k)
  #define VFR(i) (bf16x8){vlo[i][0],vlo[i][1],vlo[i][2],vlo[i][3],vhi[i][0],vhi[i][1],vhi[i][2],vhi[i][3]}
  #define PIN(x) asm volatile("":"+v"(x))
  #define MX3(a,b,c) __builtin_fmaxf(__builtin_fmaxf((a),(b)),(c))
  #define GAPA(MF,A0,A1,A2,A3,W0,W1,PW) do{ MF; sacc+=A0; sacc+=A1; sacc+=A2; sacc+=A3; PIN(sacc); W0; W1; PIN(PW); SBAR(); }while(0)
  #define EX(v) __builtin_amdgcn_exp2f(v)
  #define GAPB(MF,X,B) do{ MF; X[B]=EX(X[B]); X[B+1]=EX(X[B+1]); X[B+2]=EX(X[B+2]); X[B+3]=EX(X[B+3]); PIN(X); SBAR(); }while(0)
  #define VRD(i) do{ vlo[i]=vtr(vp_+(((i)>>2)*4096+((i)&3)*1024)); vhi[i]=vtr(vp_+(((i)>>2)*4096+((i)&3)*1024+512)); }while(0)
  #define KRD(G,j) do{ if(G){ kload2(kf,kp0+sl_next,j); SBAR(); } }while(0)
  #define STEP(C0,C1,P0,P1,t,GK,GV,GL,AMC,AMP) do{ SBAR(); \
    const lds_cptr vp_=vp0+sl_prev; \
    VRD(0); SBAR(); float sacc=(P0[0]+P0[1]); \
    GAPA(C0=__builtin_amdgcn_mfma_f32_32x32x16_bf16(kf[0],qr[0],negm,0,0,0), P0[2],P0[3],P0[4],P0[5],     pw0[0]=PKW(P0,0)&AMP, pw0[1]=PKW(P0,2)&AMP, pw0); \
    VRD(4); SBAR(); GAPA(C1=__builtin_amdgcn_mfma_f32_32x32x16_bf16(kf[1],qr[0],negm,0,0,0), P0[6],P0[7],P0[8],P0[9],     pw0[2]=PKW(P0,4)&AMP, pw0[3]=PKW(P0,6)&AMP, pw0); \
    VRD(1); SBAR(); GAPA(C0=__builtin_amdgcn_mfma_f32_32x32x16_bf16(kf[2],qr[1],C0,0,0,0),   P0[10],P0[11],P0[12],P0[13], pw1[0]=PKW(P0,8)&AMP, pw1[1]=PKW(P0,10)&AMP, pw1); \
    VRD(5); SBAR(); GAPA(C1=__builtin_amdgcn_mfma_f32_32x32x16_bf16(kf[3],qr[1],C1,0,0,0),   P0[14],P0[15],P1[0],P1[1],   pw1[2]=PKW(P0,12)&AMP,pw1[3]=PKW(P0,14)&AMP, pw1); \
    VRD(2); SBAR(); GAPA(C0=__builtin_amdgcn_mfma_f32_32x32x16_bf16(kf[4],qr[2],C0,0,0,0),   P1[2],P1[3],P1[4],P1[5],     pw2[0]=PKW(P1,0)&AMP, pw2[1]=PKW(P1,2)&AMP, pw2); \
    VRD(6); SBAR(); GAPA(C1=__builtin_amdgcn_mfma_f32_32x32x16_bf16(kf[5],qr[2],C1,0,0,0),   P1[6],P1[7],P1[8],P1[9],     pw2[2]=PKW(P1,4)&AMP, pw2[3]=PKW(P1,6)&AMP, pw2); \
    VRD(3); SBAR(); GAPA(C0=__builtin_amdgcn_mfma_f32_32x32x16_bf16(kf[6],qr[3],C0,0,0,0),   P1[10],P1[11],P1[12],P1[13], pw3[0]=PKW(P1,8)&AMP, pw3[1]=PKW(P1,10)&AMP, pw3); \
    VRD(7); SBAR(); GAPA(C1=__builtin_amdgcn_mfma_f32_32x32x16_bf16(kf[7],qr[3],C1,0,0,0),   P1[14],P1[15],0.f,0.f,       pw3[2]=PKW(P1,12)&AMP,pw3[3]=PKW(P1,14)&AMP, pw3); \
    l_reg+=(AMP?sacc:0.f); \
    if(GK){DMA_K((t)+3,sl_cur);} if(GV){DMA_V((t)+1,sl_next);} \
    NSAHOOK(C0,C1,t,AMC); \
    { float a=MX3(C0[0],C0[1],C1[0]),b=MX3(C0[2],C0[3],C1[1]); a=MX3(a,C1[2],C1[3]); \
      _Pragma("unroll") for(int r=4;r<16;r+=4){a=MX3(a,C0[r],C0[r+1]);b=MX3(b,C0[r+2],C0[r+3]);a=MX3(a,C1[r],C1[r+1]);b=MX3(b,C1[r+2],C1[r+3]);} \
      float rm=__builtin_fmaxf(a,b); { auto rr=__builtin_amdgcn_permlane32_swap(__float_as_uint(rm),__float_as_uint(rm),false,false); rm=__builtin_fmaxf(__uint_as_float(rr[0]),__uint_as_float(rr[1])); } \
      rm=AMC?rm:-1e30f; resc=false; \
      if(__builtin_expect(__any(rm>(float)THRL),0)){ const float dl=__builtin_fmaxf(rm,0.f); mhat+=dl; \
        _Pragma("unroll") for(int r=0;r<16;++r){C0[r]-=dl;C1[r]-=dl;} \
        const float f=__builtin_amdgcn_exp2f(-dl); l_reg*=f; if(hi==0)wsf[r32]=f; resc=true; } } \
    SBAR(); \
    GAPB(o[0]=__builtin_amdgcn_mfma_f32_32x32x16_bf16(PAF(0),VFR(0),o[0],0,0,0), C0,0); \
    GAPB(o[1]=__builtin_amdgcn_mfma_f32_32x32x16_bf16(PAF(0),VFR(4),o[1],0,0,0), C0,4); \
    KRD(GL,0); GAPB(o[0]=__builtin_amdgcn_mfma_f32_32x32x16_bf16(PAF(1),VFR(1),o[0],0,0,0), C0,8); \
    KRD(GL,1); GAPB(o[1]=__builtin_amdgcn_mfma_f32_32x32x16_bf16(PAF(1),VFR(5),o[1],0,0,0), C0,12); \
    KRD(GL,2); GAPB(o[0]=__builtin_amdgcn_mfma_f32_32x32x16_bf16(PAF(2),VFR(2),o[0],0,0,0), C1,0); \
    KRD(GL,3); GAPB(o[1]=__builtin_amdgcn_mfma_f32_32x32x16_bf16(PAF(2),VFR(6),o[1],0,0,0), C1,4); \
    GAPB(o[0]=__builtin_amdgcn_mfma_f32_32x32x16_bf16(PAF(3),VFR(3),o[0],0,0,0), C1,8); \
    GAPB(o[1]=__builtin_amdgcn_mfma_f32_32x32x16_bf16(PAF(3),VFR(7),o[1],0,0,0), C1,12); \
    }while(0)
  int t=1;
  for(;t+5<NT;t+=2){
    STEP(pB0,pB1,pA0,pA1,t,true,true,true,amB,amA);     WAIT_BAR(2); RESC(); ROT();
    STEP(pA0,pA1,pB0,pB1,t+1,true,true,true,amA,amB);   WAIT_BAR(2); RESC(); ROT();
  }
  #define ENDW(tt) do{ if((tt)+3<NT){WAIT_BAR(2);} else if((tt)+2<NT){WAIT_BAR(1);} else {WAIT_BAR(0);} }while(0)
  for(;t+1<NT;t+=2){
    STEP(pB0,pB1,pA0,pA1,t,(t+3<NT),(t+1<NT),(t+1<NT),amB,amA);       ENDW(t);   RESC(); ROT();
    STEP(pA0,pA1,pB0,pB1,t+1,(t+4<NT),(t+2<NT),(t+2<NT),amA,amB);     ENDW(t+1); RESC(); ROT();
  }
  STEP(pB0,pB1,pA0,pA1,NT-1,false,false,false,amB,amA); RESC();
  { float sacc=pB0[0]+pB0[1]; _Pragma("unroll") for(int r=2;r<16;++r)sacc+=pB0[r]; _Pragma("unroll") for(int r=0;r<16;++r)sacc+=pB1[r]; l_reg+=(amB?sacc:0.f);
    pw0=(u32x4){PKW(pB0,0)&amB,PKW(pB0,2)&amB,PKW(pB0,4)&amB,PKW(pB0,6)&amB};pw1=(u32x4){PKW(pB0,8)&amB,PKW(pB0,10)&amB,PKW(pB0,12)&amB,PKW(pB0,14)&amB};pw2=(u32x4){PKW(pB1,0)&amB,PKW(pB1,2)&amB,PKW(pB1,4)&amB,PKW(pB1,6)&amB};pw3=(u32x4){PKW(pB1,8)&amB,PKW(pB1,10)&amB,PKW(pB1,12)&amB,PKW(pB1,14)&amB};
    SBAR(); pv(o,vb0+sl_cur,PAF(0),PAF(1),PAF(2),PAF(3)); }
  #undef PKW
  #undef PAF
  #undef VFR
  #undef PIN
  #undef MX3
  #undef GAPA
  #undef GAPB
  #undef EX
  #undef VRD
  #undef KRD
  #undef STEP
  #undef ENDW
  {auto rr=__builtin_amdgcn_permlane32_swap(__float_as_uint(l_reg),__float_as_uint(l_reg),false,false);l_out=__uint_as_float(rr[0])+__uint_as_float(rr[1]);}
  asm volatile("s_waitcnt lgkmcnt(0)\n\ts_barrier":::"memory");
  #undef NSAHOOK
  #undef TLJ
  #undef DMA_K
  #undef DMA_V
  #undef START
  #undef RESC
  #undef ROT
}
constexpr int ATTN_LDS_BYTES=LDS_BYTES;
struct AttnTensors { const bf16* Q; const bf16* K; const bf16* V; bf16* O; };
struct AttnUnit { int bh; int qb; };
#undef SBAR
#undef WAIT_BAR
}
namespace nsa {
using namespace attn_body;
typedef __attribute__((address_space(3))) char* lds_ptr;
typedef __attribute__((address_space(3))) float* lds_fptr;
typedef float f32x4_t __attribute__((ext_vector_type(4)));
constexpr int L_K = LDS_K, L_V = LDS_V, L_WS = LDS_WS, L_OST = LDS_WS + 2048;
constexpr int L_IMP = L_OST;
constexpr int L_IMPT = L_K + 2 * 8192;
constexpr int L_LUTPAD = L_OST + 65536, L_LUT = L_LUTPAD + 64;
constexpr int L_MASK = L_LUT + 4096 + 192;
constexpr int L_TL = L_MASK + 256;
constexpr int L_GATE = L_TL + 384;
constexpr int NSA_LDS_END = L_GATE + 8 * 3 * 64 * 4;
#define NSA_WAIT_BAR(N) asm volatile("s_waitcnt vmcnt(" #N ") lgkmcnt(0)\n\ts_barrier" ::: "memory")
#define NSA_SBAR() __builtin_amdgcn_sched_barrier(0)

__device__ __forceinline__ float rowmax_cv(const f32x16& p0, const f32x16& p1) {
    float a = __builtin_fmaxf(p0[0], p1[0]), b = __builtin_fmaxf(p0[1], p1[1]);
#pragma unroll
    for (int r = 2; r < 16; r += 2) { a = __builtin_fmaxf(a, __builtin_fmaxf(p0[r], p1[r])); b = __builtin_fmaxf(b, __builtin_fmaxf(p0[r + 1], p1[r + 1])); }
    const float m = __builtin_fmaxf(a, b);
    return __builtin_fmaxf(m, __shfl_xor(m, 32));
}
__device__ __forceinline__ bf16x8 pack8f(const f32x16& p, int base, unsigned amask) {
    u32x4 w; w[0] = cvtpk_s(p[base], p[base + 1]) & amask; w[1] = cvtpk_s(p[base + 2], p[base + 3]) & amask; w[2] = cvtpk_s(p[base + 4], p[base + 5]) & amask; w[3] = cvtpk_s(p[base + 6], p[base + 7]) & amask;
    return __builtin_bit_cast(bf16x8, w);
}
__device__ __forceinline__ void pv2(f32x16 (&o)[2], int vb, bf16x8 pa0, bf16x8 pa1, bf16x8 pa2, bf16x8 pa3) {
    s16x4 lo[2][4], hi[2][4];
#pragma unroll
    for (int d0 = 0; d0 < 2; ++d0)
#pragma unroll
        for (int ks = 0; ks < 4; ++ks) {
            asm volatile("ds_read_b64_tr_b16 %0,%1 offset:%c2" : "=&v"(lo[d0][ks]) : "v"(vb), "i"(d0 * 4096 + ks * 1024) : "memory");
            asm volatile("ds_read_b64_tr_b16 %0,%1 offset:%c2" : "=&v"(hi[d0][ks]) : "v"(vb), "i"(d0 * 4096 + ks * 1024 + 512) : "memory"); }
    asm volatile("s_waitcnt lgkmcnt(0)" ::: "memory"); NSA_SBAR();
#define NSA_PK(d, k) (bf16x8){lo[d][k][0], lo[d][k][1], lo[d][k][2], lo[d][k][3], hi[d][k][0], hi[d][k][1], hi[d][k][2], hi[d][k][3]}
    o[0] = __builtin_amdgcn_mfma_f32_32x32x16_bf16(pa0, NSA_PK(0, 0), o[0], 0, 0, 0); o[1] = __builtin_amdgcn_mfma_f32_32x32x16_bf16(pa0, NSA_PK(1, 0), o[1], 0, 0, 0);
    o[0] = __builtin_amdgcn_mfma_f32_32x32x16_bf16(pa1, NSA_PK(0, 1), o[0], 0, 0, 0); o[1] = __builtin_amdgcn_mfma_f32_32x32x16_bf16(pa1, NSA_PK(1, 1), o[1], 0, 0, 0);
    o[0] = __builtin_amdgcn_mfma_f32_32x32x16_bf16(pa2, NSA_PK(0, 2), o[0], 0, 0, 0); o[1] = __builtin_amdgcn_mfma_f32_32x32x16_bf16(pa2, NSA_PK(1, 2), o[1], 0, 0, 0);
    o[0] = __builtin_amdgcn_mfma_f32_32x32x16_bf16(pa3, NSA_PK(0, 3), o[0], 0, 0, 0); o[1] = __builtin_amdgcn_mfma_f32_32x32x16_bf16(pa3, NSA_PK(1, 3), o[1], 0, 0, 0);
#undef NSA_PK
}
__device__ __forceinline__ void stash_acc(lds_fptr stash, const f32x16 (&ob)[2], float f, lds_fptr wsf, int lane, int r32, int hi, bool first) {
    if (hi == 0) wsf[r32] = f;
    asm volatile("s_waitcnt lgkmcnt(0)" ::: "memory");
#pragma unroll
    for (int g = 0; g < 4; ++g) { const f32x4_t fv = *(const __attribute__((address_space(3))) f32x4_t*)(wsf + 8 * g + 4 * hi);
#pragma unroll
        for (int e = 0; e < 4; ++e) { const int r = 4 * g + e;
#pragma unroll
            for (int d0 = 0; d0 < 2; ++d0) { const lds_fptr p = stash + (d0 * 16 + r) * 64 + lane; float v = ob[d0][r] * fv[e]; if (!first) v += *p; *p = v; } } }
    asm volatile("s_waitcnt lgkmcnt(0)" ::: "memory");
}

__device__ __forceinline__ void nsa_unit(int b, int g, int qc, const bf16* Q, const bf16* KV, const bf16* KC2, size_t kvstride, size_t kc2stride, const float* gates, const float* lutg, bf16* O, char* shm) {
    int tid = threadIdx.x; asm volatile("" : "+v"(tid));
    const int lane = tid & 63, r32 = lane & 31, hi = lane >> 5; const int wid = __builtin_amdgcn_readfirstlane(tid >> 6);
    const int hr = wid >> 1, qh = wid & 1, hh = g * 4 + hr, bg = b * 4 + g;
    const int qi = 32 * qh + r32, t = 64 * qc + qi;
    const size_t tok = (size_t)b * SEQ + t;
    const lds_ptr shm3 = (lds_ptr)shm; const unsigned lds0 = (unsigned)(uintptr_t)shm;
    const lds_fptr lutN = (lds_fptr)(shm3 + L_LUT); const lds_fptr wsf = (lds_fptr)(shm3 + L_WS) + wid * 64;
    const bf16* Qw = Q + ((size_t)b * SEQ + 64 * qc + 32 * qh) * 1024 + hh * 64;
    bf16x8 qr[4];
#pragma unroll
    for (int d0 = 0; d0 < 4; ++d0) qr[d0] = *reinterpret_cast<const bf16x8*>(&Qw[(size_t)r32 * 1024 + d0 * 16 + hi * 8]);
    const lds_fptr gl = (lds_fptr)(shm3 + L_GATE) + wid * 192;
    { const float* gt = gates + tok * 48; const float g0 = gt[hh], g1 = gt[16 + hh], g2 = gt[32 + hh];
      const bf16* kcm = KC2 + (size_t)bg * 128 * 64; const bf16* vcm = KC2 + kc2stride + (size_t)bg * 128 * 64;
      const bf16* ksrc = kcm + (size_t)lane * 64 + wid * 8;
      const bf16* vsrc = vcm + (size_t)(16 * (wid & 3) + (lane >> 2)) * 64 + (wid >> 2) * 32 + (lane & 3) * 8;
      glds16(ksrc, (unsigned)__builtin_amdgcn_readfirstlane(lds0 + L_K + wid * 1024)); glds16(vsrc, (unsigned)__builtin_amdgcn_readfirstlane(lds0 + L_V + wid * 1024));
      glds16(ksrc + 4096, (unsigned)__builtin_amdgcn_readfirstlane(lds0 + L_K + 8192 + wid * 1024)); glds16(vsrc + 4096, (unsigned)__builtin_amdgcn_readfirstlane(lds0 + L_V + 8192 + wid * 1024));
      for (int e = tid; e < 1024; e += 512) { const int hd = e >> 8, rel = (e & 255) - 64; const float* lg = lutg + (g * 4 + hd) * 132; const float lv = lg[rel < 0 ? 0 : (rel > 128 ? 128 : rel)] - lg[128]; lutN[e] = rel < 0 ? 0.f : lv; }
      if (tid < 16) ((lds_fptr)(shm3 + L_LUTPAD))[tid] = 0.f;
      gl[lane] = g0; gl[64 + lane] = g1; gl[128 + lane] = g2; }
    NSA_WAIT_BAR(0);
    const lds_fptr stash = (lds_fptr)(shm3 + L_OST) + wid * 2048;
    f32x16 obc[2]; obc[0] = f32x16{}; obc[1] = f32x16{};
    {
        const f32x16 zero = f32x16{};
        f32x16 pc[2][2];
        qkt(pc[0][0], pc[0][1], shm + L_K, qr, zero, r32, hi);
        qkt(pc[1][0], pc[1][1], shm + L_K + 8192, qr, zero, r32, hi);
        const lds_fptr lh = lutN + hr * 256 + 64;
        float mx = -1e30f;
        {
            const volatile __attribute__((address_space(3))) float* lhv = lh;
            f32x16 lv[2][2];
#pragma unroll
            for (int T = 0; T < 2; ++T)
#pragma unroll
                for (int v = 0; v < 2; ++v)
#pragma unroll
                    for (int r = 0; r < 16; ++r) { const int c = 64 * T + 32 * v + 4 * hi + (r & 3) + 8 * (r >> 2); const int rel = t - 31 - 16 * c; lv[T][v][r] = lhv[rel < 0 ? 0 : (rel > 128 ? 128 : rel)]; }
#pragma unroll
            for (int T = 0; T < 2; ++T)
#pragma unroll
                for (int v = 0; v < 2; ++v)
#pragma unroll
                    for (int r = 0; r < 16; ++r) { const int c = 64 * T + 32 * v + 4 * hi + (r & 3) + 8 * (r >> 2); const int rel = t - 31 - 16 * c; const bool ok = (rel >= 0) && (c <= 126);
                        const float x = ok ? pc[T][v][r] + lv[T][v][r] : -1e30f; pc[T][v][r] = x; mx = __builtin_fmaxf(mx, x); }
        }
        mx = __builtin_fmaxf(mx, __shfl_xor(mx, 32));
        float ls = 0.f;
#pragma unroll
        for (int T = 0; T < 2; ++T)
#pragma unroll
            for (int v = 0; v < 2; ++v)
#pragma unroll
                for (int r = 0; r < 16; ++r) { const float x = pc[T][v][r]; const float p = (x > -1e29f) ? __builtin_amdgcn_exp2f(x - mx) : 0.f; pc[T][v][r] = p; ls += p; }
        ls += __shfl_xor(ls, 32);
        const float inv = ls > 0.f ? 1.0f / ls : 0.f;
#pragma unroll
        for (int T = 0; T < 2; ++T)
#pragma unroll
            for (int v = 0; v < 2; ++v)
#pragma unroll
                for (int r = 0; r < 16; ++r) pc[T][v][r] *= inv;
        {
            float Gv[16], Ev[16], Er[16];
#pragma unroll
            for (int n = 0; n < 16; ++n) { const int T = n >> 3, v = (n >> 2) & 1, gI = n & 3; const f32x16& pp = pc[T][v];
                Gv[n] = (pp[4 * gI] + pp[4 * gI + 1]) + (pp[4 * gI + 2] + pp[4 * gI + 3]); Ev[n] = pp[4 * gI + 3]; }
#pragma unroll
            for (int n = 0; n < 16; ++n) Er[n] = __shfl_xor(Ev[n], 32);
            const lds_fptr impw = (lds_fptr)(shm3 + L_IMP) + (hr * 64 + qi) * 32 + hi;
#pragma unroll
            for (int n = 0; n < 16; ++n) { const float prev = hi ? Er[n] : (n > 0 ? Er[n > 0 ? n - 1 : 0] : 0.f); impw[2 * n] = Gv[n] + prev; }
        }
        const int vb0 = (int)(lds0 + L_V) + ((lane >> 4) & 1) * 32 + (lane & 3) * 8 + (4 * hi + ((lane & 15) >> 2)) * 64;
#pragma unroll
        for (int T = 0; T < 2; ++T) {
            const bf16x8 pa0 = pack8f(pc[T][0], 0, 0xffffffffu), pa1 = pack8f(pc[T][0], 8, 0xffffffffu), pa2 = pack8f(pc[T][1], 0, 0xffffffffu), pa3 = pack8f(pc[T][1], 8, 0xffffffffu);
            NSA_SBAR();
            pv2(obc, vb0 + T * 8192, pa0, pa1, pa2, pa3);
        }
    }
    asm volatile("s_waitcnt lgkmcnt(0)\n\ts_barrier" ::: "memory");
    unsigned selm, uni;
    if (qc >= 16) {
        const lds_fptr ip = (lds_fptr)(shm3 + L_IMP); const lds_fptr it = (lds_fptr)(shm3 + L_IMPT);
        const int q = tid >> 3, jj = tid & 7;
        {
            f32x4_t s = *(const __attribute__((address_space(3))) f32x4_t*)(ip + (0 * 64 + q) * 32 + 4 * jj);
            s += *(const __attribute__((address_space(3))) f32x4_t*)(ip + (1 * 64 + q) * 32 + 4 * jj);
            s += *(const __attribute__((address_space(3))) f32x4_t*)(ip + (2 * 64 + q) * 32 + 4 * jj);
            s += *(const __attribute__((address_space(3))) f32x4_t*)(ip + (3 * 64 + q) * 32 + 4 * jj);
            *(__attribute__((address_space(3))) f32x4_t*)(it + q * 32 + 4 * jj) = s;
        }
        asm volatile("s_waitcnt lgkmcnt(0)\n\ts_barrier" ::: "memory");
        {
            const f32x4_t v = *(const __attribute__((address_space(3))) f32x4_t*)(it + q * 32 + 4 * jj);
            int rk0 = 0, rk1 = 0, rk2 = 0, rk3 = 0;
#pragma unroll
            for (int ii = 0; ii < 8; ++ii) { const f32x4_t w = *(const __attribute__((address_space(3))) f32x4_t*)(it + q * 32 + 4 * ii);
#pragma unroll
                for (int e = 0; e < 4; ++e) { const int i = 4 * ii + e; const bool in = (i >= 1) & (i <= qc - 2); const float vi = w[e];
                    rk0 += (int)(in & ((vi > v[0]) | ((vi == v[0]) & (i < 4 * jj + 0)))); rk1 += (int)(in & ((vi > v[1]) | ((vi == v[1]) & (i < 4 * jj + 1))));
                    rk2 += (int)(in & ((vi > v[2]) | ((vi == v[2]) & (i < 4 * jj + 2)))); rk3 += (int)(in & ((vi > v[3]) | ((vi == v[3]) & (i < 4 * jj + 3)))); } }
            unsigned bits = 0u;
            { const int j = 4 * jj + 0; const bool forced = (j == 0) || (j == qc) || (j == qc - 1), cand = (j >= 1) && (j <= qc - 2); if (forced || (cand && rk0 < 13)) bits |= 1u << j; }
            { const int j = 4 * jj + 1; const bool forced = (j == 0) || (j == qc) || (j == qc - 1), cand = (j >= 1) && (j <= qc - 2); if (forced || (cand && rk1 < 13)) bits |= 1u << j; }
            { const int j = 4 * jj + 2; const bool forced = (j == 0) || (j == qc) || (j == qc - 1), cand = (j >= 1) && (j <= qc - 2); if (forced || (cand && rk2 < 13)) bits |= 1u << j; }
            { const int j = 4 * jj + 3; const bool forced = (j == 0) || (j == qc) || (j == qc - 1), cand = (j >= 1) && (j <= qc - 2); if (forced || (cand && rk3 < 13)) bits |= 1u << j; }
            bits |= (unsigned)__shfl_xor((int)bits, 1); bits |= (unsigned)__shfl_xor((int)bits, 2); bits |= (unsigned)__shfl_xor((int)bits, 4);
            if (jj == 0) ((__attribute__((address_space(3))) unsigned*)(shm3 + L_MASK))[q] = bits;
        }
        asm volatile("s_waitcnt lgkmcnt(0)\n\ts_barrier" ::: "memory");
        const __attribute__((address_space(3))) unsigned* mk = (const __attribute__((address_space(3))) unsigned*)(shm3 + L_MASK);
        selm = mk[qi];
        unsigned u = mk[lane];
#pragma unroll
        for (int o = 1; o < 64; o <<= 1) u |= (unsigned)__shfl_xor((int)u, o);
        uni = (unsigned)__builtin_amdgcn_readfirstlane((int)u);
    } else { selm = (2u << qc) - 1u; uni = selm; }
    stash_acc(stash, obc, gl[lane], wsf, lane, r32, hi, true);
    const int j0w = qc >= 8 ? qc - 8 : 0; const unsigned wt = ((2u << qc) - 1u) & ~((1u << j0w) - 1u);
    const int ns = __builtin_popcount(uni), nw = __builtin_popcount(wt);
    const int NTs = ns < 4 ? 4 : ns + (ns & 1), NTw = nw < 4 ? 4 : nw + (nw & 1);
    { __attribute__((address_space(3))) int* tls = (__attribute__((address_space(3))) int*)(shm3 + L_TL); int dmk = (int)0x80000000u; asm volatile("" : "+v"(dmk));
      if (tid < 32) { if ((uni >> tid) & 1u) tls[__builtin_popcount(uni & ((1u << tid) - 1u))] = tid; if (tid >= ns && tid < NTs) tls[tid] = dmk; if (tid == 0 && NTs > 32) tls[32] = dmk, tls[33] = dmk; }
      else if (tid < 64) { const int i = tid - 32; if ((wt >> i) & 1u) tls[48 + __builtin_popcount(wt & ((1u << i) - 1u))] = i; if (i >= nw && i < NTw) tls[48 + i] = dmk; } }
    asm volatile("s_waitcnt lgkmcnt(0)\n\ts_barrier" ::: "memory");
    const lds_fptr luth = lutN + hr * 256;
    const bf16* kvb = KV + (size_t)bg * SEQ * 64;
    { f32x16 ob[2]; float lt;
      nsa_branch_pipe<false, 32>(kvb + 2 * kvstride, kvb + 3 * kvstride, (const __attribute__((address_space(3))) int*)(shm3 + L_TL), NTs, qc, qr, selm, luth, shm, lt, ob);
      const float gs = gl[64 + lane]; stash_acc(stash, ob, lt > 0.f ? gs * __builtin_amdgcn_rcpf(lt) : 0.f, wsf, lane, r32, hi, false); }
    { f32x16 ob[2]; float lt;
      nsa_branch_pipe<true, 32>(kvb + 4 * kvstride, kvb + 5 * kvstride, (const __attribute__((address_space(3))) int*)(shm3 + L_TL) + 48, NTw, qc, qr, 0xffffffffu, luth, shm, lt, ob);
      const float gw = gl[128 + lane]; stash_acc(stash, ob, lt > 0.f ? gw * __builtin_amdgcn_rcpf(lt) : 0.f, wsf, lane, r32, hi, false); }
    bf16* Ow = O + ((size_t)b * SEQ + 64 * qc + 32 * qh) * 1024 + hh * 64;
    { f32x16 ot[2];
#pragma unroll
      for (int d0 = 0; d0 < 2; ++d0)
#pragma unroll
          for (int r = 0; r < 16; ++r) ot[d0][r] = stash[(d0 * 16 + r) * 64 + lane];
      asm volatile("s_waitcnt lgkmcnt(0)" ::: "memory");
      bf16* stg = (bf16*)(shm + L_OST) + wid * 4096;
#pragma unroll
      for (int r = 0; r < 16; ++r) { const int orow = crow(r, hi);
#pragma unroll
          for (int d0 = 0; d0 < 2; ++d0) stg[orow * 64 + d0 * 32 + r32] = __float2bfloat16(ot[d0][r]); }
      asm volatile("s_waitcnt lgkmcnt(0)" ::: "memory");
#pragma unroll
      for (int i = 0; i < 4; ++i) { const int row = i * 8 + (lane >> 3), ch = lane & 7; const u32x4 v = *(const u32x4*)(stg + row * 64 + ch * 8); *(u32x4*)(Ow + (size_t)row * 1024 + ch * 8) = v; } }
    asm volatile("s_waitcnt lgkmcnt(0)\n\ts_barrier" ::: "memory");
}
#undef NSA_WAIT_BAR
#undef NSA_SBAR
}

namespace pg8 {
__device__ __forceinline__ float sigm(float x) { return __builtin_amdgcn_rcpf(1.0f + __builtin_amdgcn_exp2f(-1.4426950408889634f * x)); }
__device__ __forceinline__ u32x4 pack8(const f32x4 a, const f32x4 b) { u32x4 w; w.x = cvt_pk_bf16(a[0], a[1]); w.y = cvt_pk_bf16(a[2], a[3]); w.z = cvt_pk_bf16(b[0], b[1]); w.w = cvt_pk_bf16(b[2], b[3]); return w; }
__device__ __forceinline__ float gelu_tanh(float x) { const float t = 0.7978845608028654f * (x + 0.044715f * x * x * x); return x * sigm(2.0f * t); }

struct EpiSwiglu {
    static constexpr bool PERM = true, AFTER_DRAIN = false;
    bf16_t* O; int ldc;
    __device__ __forceinline__ void operator()(const f32x4 (&acc)[2][2][4][2], const Unit& u, int wr, int wc, int fr, int fq) const {
        const int row0 = u.pm * BM + wr * 64 + fr, col0 = u.pn * HALF + wc * 32 + 8 * fq;
#pragma unroll
        for (int ai = 0; ai < 2; ++ai)
#pragma unroll
            for (int m = 0; m < 4; ++m) {
                bf16_t* rowp = O + (size_t)(row0 + ai * HALF + m * 16) * ldc + col0;
                f32x4 h[2];
#pragma unroll
                for (int n = 0; n < 2; ++n) { const f32x4 gt = acc[ai][0][m][n], up = acc[ai][1][m][n];
#pragma unroll
                    for (int e = 0; e < 4; ++e) h[n][e] = gt[e] * sigm(gt[e]) * up[e]; }
                *(u32x4*)rowp = pack8(h[0], h[1]);
            }
    }
};
struct EpiPlain {
    static constexpr bool PERM = true, AFTER_DRAIN = false;
    bf16_t* O; int ldc;
    __device__ __forceinline__ void operator()(const f32x4 (&acc)[2][2][4][2], const Unit& u, int wr, int wc, int fr, int fq) const {
        const int row0 = u.pm * BM + wr * 64 + fr, col0 = u.pn * BM + wc * 32 + 8 * fq;
#pragma unroll
        for (int ai = 0; ai < 2; ++ai)
#pragma unroll
            for (int m = 0; m < 4; ++m) {
                bf16_t* rowp = O + (size_t)(row0 + ai * HALF + m * 16) * ldc + col0;
#pragma unroll
                for (int bj = 0; bj < 2; ++bj) *(u32x4*)(rowp + bj * HALF) = pack8(acc[ai][bj][m][0], acc[ai][bj][m][1]);
            }
    }
};
struct EpiNsaIn {
    static constexpr bool PERM = true, AFTER_DRAIN = false;
    bf16_t* Q; bf16_t* KV; float* gates; float qscale; size_t kvstride;
    __device__ __forceinline__ void operator()(const f32x4 (&acc)[2][2][4][2], const Unit& u, int wr, int wc, int fr, int fq) const {
        const int row0 = u.pm * BM + wr * 64 + fr, ct0 = wc * 32 + 8 * fq;
        if (u.pn < 4) {
#pragma unroll
            for (int ai = 0; ai < 2; ++ai)
#pragma unroll
                for (int m = 0; m < 4; ++m) { bf16_t* rowp = Q + (size_t)(row0 + ai * HALF + m * 16) * 1024 + u.pn * BM + ct0;
#pragma unroll
                    for (int bj = 0; bj < 2; ++bj) *(u32x4*)(rowp + bj * HALF) = pack8(acc[ai][bj][m][0] * qscale, acc[ai][bj][m][1] * qscale); }
        } else if (u.pn < 10) {
            bf16_t* base = KV + (size_t)(u.pn - 4) * kvstride;
#pragma unroll
            for (int ai = 0; ai < 2; ++ai)
#pragma unroll
                for (int m = 0; m < 4; ++m) { const int row = row0 + ai * HALF + m * 16, b = row >> 11, s = row & 2047;
#pragma unroll
                    for (int bj = 0; bj < 2; ++bj) { const int ct = bj * HALF + ct0, g = ct >> 6, d = ct & 63;
                        *(u32x4*)(base + ((size_t)((b * 4 + g) * 2048 + s)) * 64 + d) = pack8(acc[ai][bj][m][0], acc[ai][bj][m][1]); } }
        } else {
            if (ct0 < 48) {
#pragma unroll
                for (int ai = 0; ai < 2; ++ai)
#pragma unroll
                    for (int m = 0; m < 4; ++m) { float* gp = gates + (size_t)(row0 + ai * HALF + m * 16) * 48 + ct0;
#pragma unroll
                        for (int n = 0; n < 2; ++n) { const f32x4 v = acc[ai][0][m][n]; *(f32x4*)(gp + 4 * n) = (f32x4){sigm(v[0]), sigm(v[1]), sigm(v[2]), sigm(v[3])}; } }
            }
        }
    }
};
struct EpiFoxIn {
    static constexpr bool PERM = true, AFTER_DRAIN = false;
    bf16_t* QKV; float* flog; float qscale; size_t tstride;
    __device__ __forceinline__ void operator()(const f32x4 (&acc)[2][2][4][2], const Unit& u, int wr, int wc, int fr, int fq) const {
        const int row0 = u.pm * BM + wr * 64 + fr, ct0 = wc * 32 + 8 * fq;
        if (u.pn < 12) {
            const int t = u.pn >> 2; const float sc = (t == 0) ? qscale : 1.0f;
            bf16_t* base = QKV + (size_t)t * tstride + (u.pn & 3) * BM + ct0;
#pragma unroll
            for (int ai = 0; ai < 2; ++ai)
#pragma unroll
                for (int m = 0; m < 4; ++m) { bf16_t* rowp = base + (size_t)(row0 + ai * HALF + m * 16) * 1024;
#pragma unroll
                    for (int bj = 0; bj < 2; ++bj) *(u32x4*)(rowp + bj * HALF) = pack8(acc[ai][bj][m][0] * sc, acc[ai][bj][m][1] * sc); }
        } else {
            if (ct0 < 16) {
#pragma unroll
                for (int ai = 0; ai < 2; ++ai)
#pragma unroll
                    for (int m = 0; m < 4; ++m) { float* fp = flog + (size_t)(row0 + ai * HALF + m * 16) * 16 + ct0;
#pragma unroll
                        for (int n = 0; n < 2; ++n) *(f32x4*)(fp + 4 * n) = acc[ai][0][m][n]; }
            }
        }
    }
};
struct EpiCmp {
    static constexpr bool PERM = true, AFTER_DRAIN = false;
    bf16_t* Hc; const float* b1f;
    __device__ __forceinline__ void operator()(const f32x4 (&acc)[2][2][4][2], const Unit& u, int wr, int wc, int fr, int fq) const {
        const int row0 = u.pm * BM + wr * 64 + fr, ct0 = wc * 32 + 8 * fq;
        f32x4 bv[2][2];
#pragma unroll
        for (int bj = 0; bj < 2; ++bj)
#pragma unroll
            for (int n = 0; n < 2; ++n) bv[bj][n] = *(const f32x4*)(b1f + u.pn * BM + bj * HALF + ct0 + 4 * n);
#pragma unroll
        for (int ai = 0; ai < 2; ++ai)
#pragma unroll
            for (int m = 0; m < 4; ++m) { bf16_t* rowp = Hc + (size_t)(row0 + ai * HALF + m * 16) * 256 + ct0;
#pragma unroll
                for (int bj = 0; bj < 2; ++bj) { f32x4 v0 = acc[ai][bj][m][0] + bv[bj][0], v1 = acc[ai][bj][m][1] + bv[bj][1];
#pragma unroll
                    for (int e = 0; e < 4; ++e) { v0[e] = gelu_tanh(v0[e]); v1[e] = gelu_tanh(v1[e]); }
                    *(u32x4*)(rowp + bj * HALF) = pack8(v0, v1); } }
    }
};
struct CmpOrder {
    int G, c;
    __device__ __forceinline__ bool next(int i, Unit& u) const { const int L = i * G + c; if (L >= 32) return false; u.pm = L; u.pn = L >> 4; return true; }
    __device__ __forceinline__ void a_ready(const Unit&) const {}
    __device__ __forceinline__ void done(const Unit&) const {}
};
struct EpiSlab {
    static constexpr bool PERM = true, AFTER_DRAIN = false;
    float* S;
    __device__ __forceinline__ void operator()(const f32x4 (&acc)[2][2][4][2], const Unit& u, int wr, int wc, int fr, int fq) const {
        const int row0 = u.pm * BM + wr * 64 + fr, ct0 = wc * 32 + 8 * fq;
#pragma unroll
        for (int ai = 0; ai < 2; ++ai)
#pragma unroll
            for (int m = 0; m < 4; ++m) { float* rowp = S + (size_t)(row0 + ai * HALF + m * 16) * 256 + ct0;
#pragma unroll
                for (int bj = 0; bj < 2; ++bj)
#pragma unroll
                    for (int n = 0; n < 2; ++n) *(f32x4*)(rowp + bj * HALF + 4 * n) = acc[ai][bj][m][n]; }
    }
};
struct OneUnit {
    int pm, pn;
    __device__ __forceinline__ bool next(int i, Unit& u) const { if (i != 0) return false; u.pm = pm; u.pn = pn; return true; }
    __device__ __forceinline__ void a_ready(const Unit&) const {}
    __device__ __forceinline__ void done(const Unit&) const {}
};
}

constexpr int NWAVES = 8;
constexpr int BATCH = 8, SEQ = 2048, D = 1024, H = 16, HD = 64, FF = 2816, NGU = 2 * FF;
constexpr int M = BATCH * SEQ;
constexpr int NSA_IN = 2608, NSA_IN_PAD = 2816, FOX_IN = 3088, FOX_IN_PAD = 3328;
constexpr float RMS_EPS = 1e-6f;
constexpr float LOG2E = 1.4426950408889634f;
constexpr float QSCALE = 0.125f * LOG2E;
#ifndef MK_PER_PHASE
#define MK_PER_PHASE 0
#endif
#ifndef FOX_NAIVE
#define FOX_NAIVE 0
#endif
#ifndef NSA_NAIVE
#define NSA_NAIVE 0
#endif
constexpr int N_PHASES = 47 - (FOX_NAIVE ? 0 : 2);

constexpr size_t MiB = 1u << 20;
constexpr size_t WS_CTL = 0, CTL_ZERO_BYTES = 1 * MiB;
constexpr size_t WS_LUT = 1 * MiB;
constexpr size_t WS_B1F = 1 * MiB + 16384;
constexpr size_t WS_W2T = 1 * MiB + 32768;
constexpr size_t WS_CUM = 2 * MiB;
constexpr size_t WS_FLOG = 3 * MiB;
constexpr size_t WS_GATES = 4 * MiB;
constexpr size_t WS_WGU = 8 * MiB;
constexpr size_t WS_WD = 96 * MiB;
constexpr size_t WS_WNIN = 140 * MiB;
constexpr size_t WS_WNOUT = 151 * MiB;
constexpr size_t WS_WFIN = 155 * MiB;
constexpr size_t WS_WFOUT = 168 * MiB;
constexpr size_t WS_W1T = 172 * MiB;
constexpr size_t WS_U = 176 * MiB;
constexpr size_t WS_Y = 208 * MiB;
constexpr size_t WS_O = 240 * MiB;
constexpr size_t WS_R1 = 272 * MiB;
constexpr size_t WS_END = 368 * MiB;
constexpr size_t R1_KV = 32 * MiB, KV_STRIDE_E = (size_t)32 * 2048 * 64  , R1_HC = 80 * MiB, R1_KC2 = 84 * MiB, KC2_STRIDE_E = (size_t)32 * 128 * 64;
constexpr int CW_BAR = 4096;

constexpr int RING_OFF = 0, RING_BYTES = 131072;
constexpr int LDSCTL_OFF = 139264, MISC_OFF = LDSCTL_OFF + 320;
constexpr int LDS_BYTES = 147456;

#define GAS __attribute__((address_space(1)))
#define LAS __attribute__((address_space(3)))
typedef unsigned short bf16;
typedef unsigned v4u __attribute__((ext_vector_type(4)));
typedef float f32x4 __attribute__((ext_vector_type(4)));
typedef GAS unsigned gu32;
#define RLX_AGENT __ATOMIC_RELAXED, __HIP_MEMORY_SCOPE_AGENT
#define LDS_WAIT() asm volatile("s_waitcnt lgkmcnt(0)" ::: "memory")
__device__ __forceinline__ unsigned f2bf(float f) { unsigned u = __builtin_bit_cast(unsigned, f); return (u + 0x7fffu + ((u >> 16) & 1u)) >> 16; }
__device__ __forceinline__ unsigned pk2(float lo, float hi) { return f2bf(lo) | (f2bf(hi) << 16); }
__device__ __forceinline__ float bf_lo(unsigned u) { return __builtin_bit_cast(float, u << 16); }
__device__ __forceinline__ float bf_hi(unsigned u) { return __builtin_bit_cast(float, u & 0xffff0000u); }
__device__ __forceinline__ float bf2f(bf16 h) { return __builtin_bit_cast(float, (unsigned)h << 16); }
#define DPP_F(v, ctrl) __builtin_bit_cast(float, __builtin_amdgcn_update_dpp(0, __builtin_bit_cast(int, (v)), (ctrl), 0xF, 0xF, true))
__device__ __forceinline__ float sum8(float v) { v += DPP_F(v, 0xB1); v += DPP_F(v, 0x4E); v += DPP_F(v, 0x141); return v; }
__device__ __forceinline__ float lane_f(float v, int l) { return __builtin_bit_cast(float, __builtin_amdgcn_readlane(__builtin_bit_cast(int, v), l)); }
__device__ __forceinline__ float wave_sum(float v) {
    v = sum8(v); v += DPP_F(v, 0x140);
    return (lane_f(v, 0) + lane_f(v, 16)) + (lane_f(v, 32) + lane_f(v, 48));
}
__device__ __forceinline__ float wave_max(float v) {
    v = fmaxf(v, DPP_F(v, 0xB1)); v = fmaxf(v, DPP_F(v, 0x4E)); v = fmaxf(v, DPP_F(v, 0x141)); v = fmaxf(v, DPP_F(v, 0x140));
    return fmaxf(fmaxf(lane_f(v, 0), lane_f(v, 16)), fmaxf(lane_f(v, 32), lane_f(v, 48)));
}
__device__ __forceinline__ float ex2(float x) { return __builtin_amdgcn_exp2f(x); }

#define XB_TMO      128
#define XB_XCNT(j)  (256  + 64 * (j))
#define XB_XSUB(j)  (1280 + 64 * (j))
#define XB_XGEN(j)  (2304 + 64 * (j))
#define XB_TOP      3328
#define XB_TOPGEN   3392
#define XCD_BAR_WORDS 3456
#define XB_SPIN_CAP (1u << 18)

__device__ __forceinline__ unsigned xb_ld(unsigned* p)              { return __hip_atomic_load(p, __ATOMIC_RELAXED, __HIP_MEMORY_SCOPE_AGENT); }
__device__ __forceinline__ unsigned xb_add(unsigned* p, unsigned v) { return __hip_atomic_fetch_add(p, v, __ATOMIC_RELAXED, __HIP_MEMORY_SCOPE_AGENT); }
__device__ __forceinline__ unsigned xb_xcc_id() { return (unsigned)__builtin_amdgcn_s_getreg((3 << 11) | 20) & 0xFu; }
#define XB_SPIN(cond, bar) do { unsigned _sp = 0; while (cond) { __builtin_amdgcn_s_sleep(1); \
    if ((++_sp & 255u) == 0u) { if (xb_ld(&(bar)[XB_TMO])) break; if (_sp > XB_SPIN_CAP) { atomicAdd(&(bar)[XB_TMO], 1u); break; } } } } while (0)

struct XcdBarrier {
    unsigned* bar; unsigned x;
    volatile LAS unsigned* st;
};
__device__ __forceinline__ XcdBarrier xcd_barrier_post(unsigned* bar, volatile LAS unsigned* st) {
    XcdBarrier b; b.bar = bar; b.x = xb_xcc_id(); b.st = st;
    if (threadIdx.x == 0) (void)xb_add(&bar[XB_XCNT(b.x)], 1u);
    return b;
}
__device__ __forceinline__ void xcd_barrier_complete(unsigned* bar, unsigned x, unsigned& nloc, unsigned& nx) {
    const unsigned G = gridDim.x * gridDim.y * gridDim.z;
    unsigned sum, cnt, mine, sp = 0u;
    for (;;) {
        sum = 0u; cnt = 0u; mine = 0u;
#pragma unroll
        for (unsigned j = 0; j < 16; ++j) { const unsigned c = xb_ld(&bar[XB_XCNT(j)]); sum += c; cnt += (c > 0u) ? 1u : 0u; mine = (j == x) ? c : mine; }
        if (sum == G) break;
        __builtin_amdgcn_s_sleep(1);
        if ((++sp & 255u) == 0u) { if (xb_ld(&bar[XB_TMO])) break; if (sp > XB_SPIN_CAP) { atomicAdd(&bar[XB_TMO], 1u); break; } }
    }
    nloc = mine > 0u ? mine : 1u; nx = cnt > 0u ? cnt : 1u;
}
__device__ __forceinline__ void xcd_barrier(const XcdBarrier& b) {
    asm volatile("s_waitcnt vmcnt(0)" ::: "memory");
    __syncthreads();
    if (threadIdx.x == 0) {
        unsigned* bar = b.bar;
        __builtin_amdgcn_s_waitcnt(0);
        unsigned nloc = b.st[0], nx = b.st[1];
        if (nloc == 0u) { xcd_barrier_complete(bar, b.x, nloc, nx); b.st[0] = nloc; b.st[1] = nx; }
        const unsigned old = xb_add(&bar[XB_XSUB(b.x)], 1u);
        const unsigned gen = old / nloc;
        if (old + 1u == (gen + 1u) * nloc) {
            __builtin_amdgcn_fence(__ATOMIC_RELEASE, "agent");
            asm volatile("s_waitcnt vmcnt(0)" ::: "memory");
            const unsigned og = xb_add(&bar[XB_TOP], 1u);
            const unsigned tg = og / nx;
            if (og + 1u == (tg + 1u) * nx) xb_add(&bar[XB_TOPGEN], 1u);
            else XB_SPIN(xb_ld(&bar[XB_TOPGEN]) == tg, bar);
            __builtin_amdgcn_fence(__ATOMIC_ACQUIRE, "agent");
            xb_add(&bar[XB_XGEN(b.x)], 1u);
            asm volatile("s_waitcnt vmcnt(0)" ::: "memory");
        } else {
            XB_SPIN(xb_ld(&bar[XB_XGEN(b.x)]) == gen, bar);
            __builtin_amdgcn_fence(__ATOMIC_ACQUIRE, "agent");
            asm volatile("s_waitcnt vmcnt(0)" ::: "memory");
        }
    }
    __syncthreads();
}

struct Ctx { LAS unsigned char* lds; int tid, lane, wave, vcu, G, gw, ngw, bx; };

__device__ __forceinline__ void transpose_item(const float* W, int K, int N, bf16* WT, int drow0, int kb, int n0, LAS float* scr, int lane) {
    const int k0 = 64 * kb; const int c4 = 4 * (lane & 7); const bool ok = (n0 + c4) < N;
    f32x4 v[8];
#pragma unroll
    for (int i = 0; i < 8; ++i) { const int kk = 8 * i + (lane >> 3); v[i] = ok ? *(const f32x4*)(W + (size_t)(k0 + kk) * N + n0 + c4) : (f32x4){0.f, 0.f, 0.f, 0.f}; }
#pragma unroll
    for (int i = 0; i < 8; ++i) { const int kk = 8 * i + (lane >> 3); LAS float* d = scr + kk * 33 + c4; d[0] = v[i][0]; d[1] = v[i][1]; d[2] = v[i][2]; d[3] = v[i][3]; }
    LDS_WAIT(); asm volatile("" ::: "memory");
    const int c = lane & 7;
#pragma unroll
    for (int j = 0; j < 4; ++j) { const int n = (lane >> 3) + 8 * j; const LAS float* s = scr + (8 * c) * 33 + n;
        v4u o; o.x = pk2(s[0 * 33], s[1 * 33]); o.y = pk2(s[2 * 33], s[3 * 33]); o.z = pk2(s[4 * 33], s[5 * 33]); o.w = pk2(s[6 * 33], s[7 * 33]);
        *(GAS v4u*)(WT + (size_t)(drow0 + n) * K + k0 + 8 * c) = o; }
    LDS_WAIT(); asm volatile("" ::: "memory");
}
__device__ __forceinline__ int t5_bucket(int n) {
    if (n < 16) return n;
    int b = 16;
    b += (n >= 19); b += (n >= 21); b += (n >= 24); b += (n >= 27); b += (n >= 31); b += (n >= 35); b += (n >= 40); b += (n >= 46);
    b += (n >= 52); b += (n >= 59); b += (n >= 67); b += (n >= 77); b += (n >= 87); b += (n >= 99); b += (n >= 113);
    return b;
}
struct In {
    const float *x, *norm_g, *w_gate, *w_up, *w_down, *rel_bias, *nsa_w_in, *nsa_pe, *nsa_w1, *nsa_b1, *nsa_w2, *nsa_w_out, *fox_w_in, *fox_b_f, *fox_w_out;
};
__device__ __forceinline__ void first_norm_row(const float* xrow, const float* g, bf16* urow, bf16* hrow, int lane) {
    const f32x4* xp = (const f32x4*)xrow; const f32x4* gp = (const f32x4*)g;
    f32x4 v[4] = {xp[2 * lane], xp[2 * lane + 1], xp[128 + 2 * lane], xp[128 + 2 * lane + 1]};
    float ss = 0.f;
#pragma unroll
    for (int i = 0; i < 4; ++i) ss += (v[i][0] * v[i][0] + v[i][1] * v[i][1]) + (v[i][2] * v[i][2] + v[i][3] * v[i][3]);
    const float r = 1.0f / sqrtf(wave_sum(ss) * (1.0f / D) + RMS_EPS);
    { v4u h0, h1; h0.x = pk2(v[0][0], v[0][1]); h0.y = pk2(v[0][2], v[0][3]); h0.z = pk2(v[1][0], v[1][1]); h0.w = pk2(v[1][2], v[1][3]);
      h1.x = pk2(v[2][0], v[2][1]); h1.y = pk2(v[2][2], v[2][3]); h1.z = pk2(v[3][0], v[3][1]); h1.w = pk2(v[3][2], v[3][3]);
      ((v4u*)hrow)[lane] = h0; ((v4u*)hrow)[64 + lane] = h1; }
    const f32x4 g4[4] = {gp[2 * lane], gp[2 * lane + 1], gp[128 + 2 * lane], gp[128 + 2 * lane + 1]};
#pragma unroll
    for (int i = 0; i < 4; ++i) v[i] = v[i] * r * g4[i];
    v4u o0, o1; o0.x = pk2(v[0][0], v[0][1]); o0.y = pk2(v[0][2], v[0][3]); o0.z = pk2(v[1][0], v[1][1]); o0.w = pk2(v[1][2], v[1][3]);
    o1.x = pk2(v[2][0], v[2][1]); o1.y = pk2(v[2][2], v[2][3]); o1.z = pk2(v[3][0], v[3][1]); o1.w = pk2(v[3][2], v[3][3]);
    ((v4u*)urow)[lane] = o0; ((v4u*)urow)[64 + lane] = o1;
}
namespace cv {
constexpr int I_G = 16 * 88, I_D = 44 * 32, I_FFN = 2 * I_G + I_D;
constexpr int I_NIN = 16 * 88, I_SQ = 16 * 32, I_FIN = 16 * 104, I_W1 = 32 * 8, I_W2 = 8;
constexpr int T0 = 8 * I_FFN, T1 = T0 + 2 * I_NIN, T2 = T1 + 2 * I_SQ, T3 = T2 + 2 * I_FIN, T4 = T3 + 2 * I_SQ, T5 = T4 + 4 * I_W1, T6 = T5 + 4 * I_W2;
}
__device__ __forceinline__ void convert_item(const In& I, unsigned char* ws, int it, LAS float* scr, int lane) {
    using namespace cv;
    bf16* Wgu = (bf16*)(ws + WS_WGU); bf16* Wd = (bf16*)(ws + WS_WD); bf16* Wnin = (bf16*)(ws + WS_WNIN); bf16* Wnout = (bf16*)(ws + WS_WNOUT);
    bf16* Wfin = (bf16*)(ws + WS_WFIN); bf16* Wfout = (bf16*)(ws + WS_WFOUT); bf16* W1t = (bf16*)(ws + WS_W1T); bf16* W2t = (bf16*)(ws + WS_W2T);
    int r = it;
    if (r < T0) { const int f = r / I_FFN; r -= f * I_FFN;
        if (r < 2 * I_G) { const int up = r >= I_G; r -= up * I_G; const int kb = r / 88, nb = r % 88;
            transpose_item((up ? I.w_up : I.w_gate) + (size_t)f * D * FF, D, FF, Wgu + (size_t)f * NGU * D, 256 * (nb >> 2) + 32 * (nb & 3) + 128 * up, kb, 32 * nb, scr, lane); }
        else { r -= 2 * I_G; const int kb = r / 32, nb = r % 32; transpose_item(I.w_down + (size_t)f * FF * D, FF, D, Wd + (size_t)f * D * FF, 32 * nb, kb, 32 * nb, scr, lane); }
        return; }
    r -= T0;
    if (r < 2 * I_NIN) { const int j = r / I_NIN; r -= j * I_NIN; const int kb = r / 88, nb = r % 88;
        transpose_item(I.nsa_w_in + (size_t)j * D * NSA_IN, D, NSA_IN, Wnin + (size_t)j * NSA_IN_PAD * D, 32 * nb, kb, 32 * nb, scr, lane); return; }
    r -= 2 * I_NIN;
    if (r < 2 * I_SQ) { const int j = r / I_SQ; r -= j * I_SQ; const int kb = r / 32, nb = r % 32;
        transpose_item(I.nsa_w_out + (size_t)j * D * D, D, D, Wnout + (size_t)j * D * D, 32 * nb, kb, 32 * nb, scr, lane); return; }
    r -= 2 * I_SQ;
    if (r < 2 * I_FIN) { const int j = r / I_FIN; r -= j * I_FIN; const int kb = r / 104, nb = r % 104;
        transpose_item(I.fox_w_in + (size_t)j * D * FOX_IN, D, FOX_IN, Wfin + (size_t)j * FOX_IN_PAD * D, 32 * nb, kb, 32 * nb, scr, lane); return; }
    r -= 2 * I_FIN;
    if (r < 2 * I_SQ) { const int j = r / I_SQ; r -= j * I_SQ; const int kb = r / 32, nb = r % 32;
        transpose_item(I.fox_w_out + (size_t)j * D * D, D, D, Wfout + (size_t)j * D * D, 32 * nb, kb, 32 * nb, scr, lane); return; }
    r -= 2 * I_SQ;
    if (r < 4 * I_W1) { const int jk = r / I_W1; r -= jk * I_W1; const int kb = r / 8, nb = r % 8;
        transpose_item(I.nsa_w1 + (size_t)jk * 2048 * 256, 2048, 256, W1t + (size_t)jk * 256 * 2048, 32 * nb, kb, 32 * nb, scr, lane); return; }
    r -= 4 * I_W1;
    { const int jk = r >> 3; r &= 7; const int kb = r >> 1, nb = r & 1;
        transpose_item(I.nsa_w2 + (size_t)jk * 256 * 64, 256, 64, W2t + (size_t)jk * 64 * 256, 32 * nb, kb, 32 * nb, scr, lane); }
}
__device__ __forceinline__ void convert_range(const In& I, unsigned char* ws, int start, int count, int widx, int nw, LAS float* scr, int lane) {
    for (int it = start + widx; it < start + count; it += nw) convert_item(I, ws, it, scr, lane);
}
__device__ __forceinline__ void convert_for_next(const In& I, unsigned char* ws, int s, int widx, int nw, LAS float* scr, int lane) {
    using namespace cv;
    if (s >= 7) return;
    if ((s & 1) == 0) { const int L = s >> 1, j = L >> 1;
        if ((L & 1) == 0) { convert_range(I, ws, T0 + j * I_NIN, I_NIN, widx, nw, scr, lane); convert_range(I, ws, T1 + j * I_SQ, I_SQ, widx, nw, scr, lane);
                            convert_range(I, ws, T4 + j * 2 * I_W1, 2 * I_W1, widx, nw, scr, lane); convert_range(I, ws, T5 + j * 2 * I_W2, 2 * I_W2, widx, nw, scr, lane); }
        else { convert_range(I, ws, T2 + j * I_FIN, I_FIN, widx, nw, scr, lane); convert_range(I, ws, T3 + j * I_SQ, I_SQ, widx, nw, scr, lane); } }
    convert_range(I, ws, (s + 1) * I_FFN, I_FFN, widx, nw, scr, lane);
}
__device__ __forceinline__ void prologue(const Ctx& C, const In& I, unsigned char* ws, bf16* hs0) {
    LAS float* scr = (LAS float*)(C.lds + RING_OFF + C.wave * 16384);
    convert_range(I, ws, 0, (C.G == 256) ? cv::I_FFN : cv::T6, C.gw, C.ngw, scr, C.lane);
    float* lut = (float*)(ws + WS_LUT);
    for (int e = C.gw * 64 + C.lane; e < 16 * 132; e += C.ngw * 64) { const int h = e / 132, rel = e % 132; lut[e] = I.rel_bias[t5_bucket(rel > 128 ? 128 : rel) * 16 + h] * LOG2E; }
    float* b1f = (float*)(ws + WS_B1F);
    for (int w = C.ngw - 1 - C.gw; w < 256; w += C.ngw) {
        const int e0 = 4 * w, jk = e0 >> 8, col = (e0 & 255) + (C.lane & 3), ks = C.lane >> 2;
        const float* pe = I.nsa_pe + (size_t)jk * 2048 + 128 * ks; const float* w1 = I.nsa_w1 + (size_t)jk * 2048 * 256 + (size_t)(128 * ks) * 256 + col; float sacc = 0.f;
#pragma unroll 8
        for (int i = 0; i < 128; ++i) sacc += pe[i] * w1[(size_t)i * 256];
        sacc += __shfl_xor(sacc, 4); sacc += __shfl_xor(sacc, 8); sacc += __shfl_xor(sacc, 16); sacc += __shfl_xor(sacc, 32);
        if (C.lane < 4) b1f[e0 + C.lane] = sacc + I.nsa_b1[e0 + C.lane];
    }
    bf16* U = (bf16*)(ws + WS_U);
    if (C.G == 256) { const int mb = 2048 * (C.bx & 7) + 64 * (C.bx >> 3) + 8 * C.wave;
        for (int m = mb; m < mb + 8; ++m) first_norm_row(I.x + (size_t)m * D, I.norm_g, U + (size_t)m * D, hs0 + (size_t)m * D, C.lane); }
    else for (int m = C.gw; m < M; m += C.ngw) first_norm_row(I.x + (size_t)m * D, I.norm_g, U + (size_t)m * D, hs0 + (size_t)m * D, C.lane);
}

__device__ __forceinline__ void thin_pass(const Ctx& C, const bf16* hin, bf16* hout, bf16* u, float* out, const bf16* y, const float* gpost, float cmul, const float* gpre, bool last) {
    constexpr int RB = 4;
    const int lane = C.lane;
    const f32x4* gp = (const f32x4*)gpost; const f32x4 g4[4] = {gp[2 * lane], gp[2 * lane + 1], gp[128 + 2 * lane], gp[128 + 2 * lane + 1]};
    const f32x4* qp = (const f32x4*)(last ? gpost : gpre); const f32x4 q4[4] = {qp[2 * lane], qp[2 * lane + 1], qp[128 + 2 * lane], qp[128 + 2 * lane + 1]};
    const bool xl = (C.G == 256);
    const int mstart = xl ? 2048 * (C.bx & 7) + 64 * (C.bx >> 3) + 8 * C.wave : C.gw * RB, mstep = xl ? RB : C.ngw * RB, mend = xl ? mstart + 8 : M;
    for (int m0 = mstart; m0 < mend; m0 += mstep) {
        v4u yr[RB][2], hr[RB][2];
#pragma unroll
        for (int b = 0; b < RB; ++b) { const v4u* yp = (const v4u*)(y + (size_t)(m0 + b) * D); const v4u* hp = (const v4u*)(hin + (size_t)(m0 + b) * D);
            yr[b][0] = yp[lane]; yr[b][1] = yp[64 + lane]; hr[b][0] = hp[lane]; hr[b][1] = hp[64 + lane]; }
#pragma unroll
        for (int b = 0; b < RB; ++b) {
            const int m = m0 + b; const v4u y0 = yr[b][0], y1 = yr[b][1], h0 = hr[b][0], h1 = hr[b][1];
            f32x4 yv[4], h[4];
            yv[0] = (f32x4){bf_lo(y0.x), bf_hi(y0.x), bf_lo(y0.y), bf_hi(y0.y)}; yv[1] = (f32x4){bf_lo(y0.z), bf_hi(y0.z), bf_lo(y0.w), bf_hi(y0.w)};
            yv[2] = (f32x4){bf_lo(y1.x), bf_hi(y1.x), bf_lo(y1.y), bf_hi(y1.y)}; yv[3] = (f32x4){bf_lo(y1.z), bf_hi(y1.z), bf_lo(y1.w), bf_hi(y1.w)};
            h[0] = (f32x4){bf_lo(h0.x), bf_hi(h0.x), bf_lo(h0.y), bf_hi(h0.y)}; h[1] = (f32x4){bf_lo(h0.z), bf_hi(h0.z), bf_lo(h0.w), bf_hi(h0.w)};
            h[2] = (f32x4){bf_lo(h1.x), bf_hi(h1.x), bf_lo(h1.y), bf_hi(h1.y)}; h[3] = (f32x4){bf_lo(h1.z), bf_hi(h1.z), bf_lo(h1.w), bf_hi(h1.w)};
            float ss = 0.f;
#pragma unroll
            for (int i = 0; i < 4; ++i) ss += (yv[i][0] * yv[i][0] + yv[i][1] * yv[i][1]) + (yv[i][2] * yv[i][2] + yv[i][3] * yv[i][3]);
            const float ry = cmul / sqrtf(wave_sum(ss) * (1.0f / D) + RMS_EPS);
#pragma unroll
            for (int i = 0; i < 4; ++i) h[i] = h[i] + yv[i] * ry * g4[i];
            if (last) { f32x4* op = (f32x4*)(out + (size_t)m * D); op[2 * lane] = h[0]; op[2 * lane + 1] = h[1]; op[128 + 2 * lane] = h[2]; op[128 + 2 * lane + 1] = h[3]; }
            else {
                float s2 = 0.f;
#pragma unroll
                for (int i = 0; i < 4; ++i) s2 += (h[i][0] * h[i][0] + h[i][1] * h[i][1]) + (h[i][2] * h[i][2] + h[i][3] * h[i][3]);
                const float rh = 1.0f / sqrtf(wave_sum(s2) * (1.0f / D) + RMS_EPS);
                v4u o0, o1; o0.x = pk2(h[0][0], h[0][1]); o0.y = pk2(h[0][2], h[0][3]); o0.z = pk2(h[1][0], h[1][1]); o0.w = pk2(h[1][2], h[1][3]);
                o1.x = pk2(h[2][0], h[2][1]); o1.y = pk2(h[2][2], h[2][3]); o1.z = pk2(h[3][0], h[3][1]); o1.w = pk2(h[3][2], h[3][3]);
                v4u* hp = (v4u*)(hout + (size_t)m * D); hp[lane] = o0; hp[64 + lane] = o1;
#pragma unroll
                for (int i = 0; i < 4; ++i) h[i] = h[i] * rh * q4[i];
                o0.x = pk2(h[0][0], h[0][1]); o0.y = pk2(h[0][2], h[0][3]); o0.z = pk2(h[1][0], h[1][1]); o0.w = pk2(h[1][2], h[1][3]);
                o1.x = pk2(h[2][0], h[2][1]); o1.y = pk2(h[2][2], h[2][3]); o1.z = pk2(h[3][0], h[3][1]); o1.w = pk2(h[3][2], h[3][3]);
                v4u* up = (v4u*)(u + (size_t)m * D); up[lane] = o0; up[64 + lane] = o1;
            }
        }
    }
}

__device__ __forceinline__ void load_row64(const bf16* p, v4u (&r)[8]) { const v4u* q = (const v4u*)p;
#pragma unroll
    for (int i = 0; i < 8; ++i) r[i] = q[i]; }
__device__ __forceinline__ float dot64(const v4u (&a)[8], const v4u (&b)[8]) {
    float s0 = 0.f, s1 = 0.f;
#pragma unroll
    for (int i = 0; i < 8; ++i) {
        s0 += bf_lo(a[i].x) * bf_lo(b[i].x); s1 += bf_hi(a[i].x) * bf_hi(b[i].x);
        s0 += bf_lo(a[i].y) * bf_lo(b[i].y); s1 += bf_hi(a[i].y) * bf_hi(b[i].y);
        s0 += bf_lo(a[i].z) * bf_lo(b[i].z); s1 += bf_hi(a[i].z) * bf_hi(b[i].z);
        s0 += bf_lo(a[i].w) * bf_lo(b[i].w); s1 += bf_hi(a[i].w) * bf_hi(b[i].w);
    }
    return s0 + s1;
}
__device__ __forceinline__ int clampi(int v, int lo, int hi) { return v < lo ? lo : (v > hi ? hi : v); }

__device__ __forceinline__ void cmp2_naive(const Ctx& C, const bf16* Hc, const float* w2, bf16* KC2) {
    const int nth = C.ngw * 64;
    for (int e = C.gw * 64 + C.lane; e < 2 * 4096 * 64; e += nth) {
        const int d = e & 63, m = (e >> 6) & 4095, kv = e >> 18;
        float s = 0.f;
        if ((m & 127) != 127) { const bf16* hr = Hc + (size_t)(kv * 4096 + m) * 256; const float* w = w2 + (size_t)kv * 256 * 64 + d;
            for (int k = 0; k < 256; ++k) s += bf2f(hr[k]) * w[(size_t)k * 64]; }
        KC2[(size_t)kv * KC2_STRIDE_E + (size_t)m * 64 + d] = (bf16)f2bf(s);
    }
}

__device__ __forceinline__ void nsa_naive_token(int b, int g, int t, const bf16* Q, const bf16* KV, const bf16* KC2, const float* gates, const float* lut, bf16* O, int lane) {
    const int bg = b * 4 + g, cur = t >> 6;
    const size_t tok = (size_t)b * SEQ + t;
    const bf16* ks = KV + 2 * KV_STRIDE_E + (size_t)bg * SEQ * 64; const bf16* vs = KV + 3 * KV_STRIDE_E + (size_t)bg * SEQ * 64;
    const bf16* kw = KV + 4 * KV_STRIDE_E + (size_t)bg * SEQ * 64; const bf16* vw = KV + 5 * KV_STRIDE_E + (size_t)bg * SEQ * 64;
    const bf16* kcm = KC2 + (size_t)bg * 128 * 64; const bf16* vcm = KC2 + KC2_STRIDE_E + (size_t)bg * 128 * 64;
    float P0 = 0.f, P1 = 0.f; float oc[4];
    const int c0 = lane, c1 = lane + 64;
    const int rel0 = t - (16 * c0 + 31), rel1 = t - (16 * c1 + 31);
    const bool v0 = rel0 >= 0, v1 = (c1 <= 126) && (rel1 >= 0);
    const int cmax = (t >= 31) ? (((t - 31) >> 4) > 126 ? 126 : ((t - 31) >> 4)) : -1;
    {
        v4u k0[8], k1[8]; load_row64(kcm + (size_t)c0 * 64, k0); load_row64(kcm + (size_t)c1 * 64, k1);
#pragma unroll
        for (int r = 0; r < 4; ++r) {
            asm volatile("" ::: "memory");
            const int hh = g * 4 + r; v4u q[8]; load_row64(Q + tok * 1024 + hh * 64, q);
            const float* lh = lut + hh * 132;
            const float x0 = v0 ? dot64(q, k0) + lh[clampi(rel0, 0, 128)] : -1e30f;
            const float x1 = v1 ? dot64(q, k1) + lh[clampi(rel1, 0, 128)] : -1e30f;
            const float mx = wave_max(fmaxf(x0, x1));
            float p0 = v0 ? ex2(x0 - mx) : 0.f, p1 = v1 ? ex2(x1 - mx) : 0.f;
            const float sum = wave_sum(p0 + p1); const float inv = sum > 0.f ? 1.0f / sum : 0.f;
            p0 *= inv; p1 *= inv; P0 += p0; P1 += p1;
            float acc = 0.f;
#pragma unroll 4
            for (int c = 0; c <= cmax; ++c) { const float pc = __shfl(c < 64 ? p0 : p1, c & 63); acc += pc * bf2f(vcm[(size_t)c * 64 + lane]); }
            oc[r] = acc;
        }
    }
    unsigned mask;
    {
        const int j = lane & 31; float imp = 0.f;
#pragma unroll
        for (int dc = -1; dc <= 3; ++dc) { const int c = 4 * j + dc; const bool ok = (c >= 0) && (c <= 126); const int cc = ok ? c : 0;
            const float a0 = __shfl(P0, cc & 63), a1 = __shfl(P1, cc & 63); imp += ok ? (cc < 64 ? a0 : a1) : 0.f; }
        const bool forced = (j == 0) || (j == cur) || (j == cur - 1);
        const float sc = forced ? 1e9f : (j <= cur ? imp : -1e30f);
        int rank = 0;
#pragma unroll
        for (int i = 0; i < 32; ++i) { const float si = __shfl(sc, i); rank += ((si > sc) || (si == sc && i < j)) ? 1 : 0; }
        const unsigned long long bal = __ballot((rank < 16) && (lane < 32));
        mask = (unsigned)__builtin_amdgcn_readfirstlane((int)(unsigned)(bal & 0xffffffffull));
    }
#pragma unroll 1
    for (int r = 0; r < 4; ++r) {
        const int hh = g * 4 + r; v4u q[8]; load_row64(Q + tok * 1024 + hh * 64, q);
        const float* lh = lut + hh * 132;
        float osel, owin;
        {
            float mrun = -1e30f, l = 0.f, acc = 0.f;
            for (int jb = 0; jb <= cur; ++jb) {
                if (!((mask >> jb) & 1u)) continue;
                const int pos = jb * 64 + lane, rel = t - pos; const bool val = rel >= 0;
                v4u kr[8]; load_row64(ks + (size_t)pos * 64, kr);
                const float x = val ? dot64(q, kr) + lh[clampi(rel, 0, 128)] : -1e30f;
                const float mn = fmaxf(mrun, wave_max(x)), alpha = ex2(mrun - mn);
                const float p = val ? ex2(x - mn) : 0.f;
                l = l * alpha + wave_sum(p); acc *= alpha; mrun = mn;
#pragma unroll 8
                for (int k = 0; k < 64; ++k) acc += __shfl(p, k) * bf2f(vs[(size_t)(jb * 64 + k) * 64 + lane]);
            }
            osel = l > 0.f ? acc / l : 0.f;
        }
        {
            float mrun = -1e30f, l = 0.f, acc = 0.f;
            for (int i = 0; i < 8; ++i) {
                const int p0 = t - 511 + 64 * i; if (p0 + 63 < 0) continue;
                const int pos = p0 + lane, rel = t - pos; const bool val = pos >= 0;
                v4u kr[8]; load_row64(kw + (size_t)(val ? pos : 0) * 64, kr);
                const float x = val ? dot64(q, kr) + lh[clampi(rel, 0, 128)] : -1e30f;
                const float mn = fmaxf(mrun, wave_max(x)), alpha = ex2(mrun - mn);
                const float p = val ? ex2(x - mn) : 0.f;
                l = l * alpha + wave_sum(p); acc *= alpha; mrun = mn;
#pragma unroll 8
                for (int k = 0; k < 64; ++k) { const int pk = p0 + k; if (pk >= 0) acc += __shfl(p, k) * bf2f(vw[(size_t)pk * 64 + lane]); }
            }
            owin = l > 0.f ? acc / l : 0.f;
        }
        const float* gt = gates + tok * 48;
        const float o = gt[hh] * oc[r] + gt[16 + hh] * osel + gt[32 + hh] * owin;
        O[tok * 1024 + hh * 64 + lane] = (bf16)f2bf(o);
    }
}
__device__ __forceinline__ void nsa_naive_phase(const Ctx& C, const bf16* Q, const bf16* KV, const bf16* KC2, const float* gates, const float* lut, bf16* O) {
    for (int task = C.gw; task < BATCH * 4 * SEQ; task += C.ngw) { const int bg = task & 31, t = task >> 5; nsa_naive_token(bg >> 2, bg & 3, t, Q, KV, KC2, gates, lut, O, C.lane); }
}

__device__ __forceinline__ void fox_cum_phase(const Ctx& C, const float* flog, const float* bfp, float* cum) {
    for (int bh = C.gw; bh < BATCH * H; bh += C.ngw) {
        const int b = bh >> 4, h = bh & 15; const float bias = bfp[h]; float carry = 0.f;
        for (int i = 0; i < SEQ / 64; ++i) { const int s = 64 * i + C.lane;
            const float x = flog[((size_t)b * SEQ + s) * 16 + h] + bias;
            float v = (fminf(x, 0.f) - log1pf(expf(-fabsf(x)))) * LOG2E;
#pragma unroll
            for (int o = 1; o < 64; o <<= 1) { const float n = __shfl_up(v, o); if (C.lane >= o) v += n; }
            cum[(size_t)bh * SEQ + s] = carry + v;
            carry += __shfl(v, 63);
        }
    }
}
__device__ __forceinline__ void fox_naive_phase(const Ctx& C, const bf16* Q, const bf16* K, const bf16* V, const float* cum, bf16* O) {
    const int lane = C.lane;
    for (int task = C.gw; task < BATCH * H * SEQ; task += C.ngw) {
        const int bh = task & 127, t = task >> 7, b = bh >> 4, h = bh & 15;
        const size_t tok = (size_t)b * SEQ + t;
        v4u q[8]; load_row64(Q + tok * 1024 + h * 64, q);
        const float* cb = cum + (size_t)bh * SEQ; const float ct = cb[t];
        float mrun = -1e30f, l = 0.f, acc = 0.f;
        for (int i = 0; i <= (t >> 6); ++i) {
            const int pos = 64 * i + lane; const bool val = pos <= t; const int pc = val ? pos : t;
            v4u kr[8]; load_row64(K + ((size_t)b * SEQ + pc) * 1024 + h * 64, kr);
            const float x = val ? dot64(q, kr) + (ct - cb[pc]) : -1e30f;
            const float mn = fmaxf(mrun, wave_max(x)), alpha = ex2(mrun - mn);
            const float p = val ? ex2(x - mn) : 0.f;
            l = l * alpha + wave_sum(p); acc *= alpha; mrun = mn;
#pragma unroll 8
            for (int k = 0; k < 64; ++k) { const int pk = 64 * i + k; if (pk <= t) acc += __shfl(p, k) * bf2f(V[((size_t)b * SEQ + pk) * 1024 + h * 64 + lane]); }
        }
        O[tok * 1024 + h * 64 + lane] = (bf16)f2bf(acc / l);
    }
}

typedef short bf16x8_t __attribute__((ext_vector_type(8)));
__device__ __forceinline__ void cmp_tail_phase(const Ctx& C, const float* slabs, const float* b1f, const bf16* w2t, bf16* KC2) {
    LAS float* red = (LAS float*)(C.lds + RING_OFF);
    const int fr = C.lane & 15, fq = C.lane >> 4, tsel = C.wave >> 2, kq = C.wave & 3;
    for (int cu = C.vcu; cu < 256; cu += C.G) {
        const int tile = tsel * 256 + cu, row = tile * 16 + fr, kv = row >> 12;
        f32x4 acc[4];
#pragma unroll
        for (int nt = 0; nt < 4; ++nt) acc[nt] = (f32x4){0.f, 0.f, 0.f, 0.f};
#pragma unroll
        for (int kk = 0; kk < 2; ++kk) {
            const int k0 = 32 * (2 * kq + kk) + 8 * fq;
            f32x4 p0[8], p1[8];
#pragma unroll
            for (int kc = 0; kc < 8; ++kc) { const GAS f32x4* sp = (const GAS f32x4*)(slabs + ((size_t)kc * 8192 + row) * 256 + k0); p0[kc] = sp[0]; p1[kc] = sp[1]; }
            const GAS f32x4* bp = (const GAS f32x4*)(b1f + kv * 256 + k0); f32x4 s0 = bp[0], s1 = bp[1];
#pragma unroll
            for (int kc = 0; kc < 8; ++kc) { s0 += p0[kc]; s1 += p1[kc]; }
#pragma unroll
            for (int e = 0; e < 4; ++e) { s0[e] = pg8::gelu_tanh(s0[e]); s1[e] = pg8::gelu_tanh(s1[e]); }
            const pg8::u32x4 bw = pg8::pack8(s0, s1); const bf16x8_t bfrag = __builtin_bit_cast(bf16x8_t, bw);
            bf16x8_t afrag[4];
#pragma unroll
            for (int nt = 0; nt < 4; ++nt) afrag[nt] = *(const GAS bf16x8_t*)(w2t + ((size_t)kv * 64 + 16 * nt + fr) * 256 + k0);
#pragma unroll
            for (int nt = 0; nt < 4; ++nt) acc[nt] = __builtin_amdgcn_mfma_f32_16x16x32_bf16(afrag[nt], bfrag, acc[nt], 0, 0, 0);
        }
        LAS f32x4* rp = (LAS f32x4*)(red + (C.wave * 64 + C.lane) * 16);
#pragma unroll
        for (int nt = 0; nt < 4; ++nt) rp[nt] = acc[nt];
        __syncthreads();
        if (kq == 0) {
#pragma unroll
            for (int w = 1; w < 4; ++w) { const LAS f32x4* op = (const LAS f32x4*)(red + ((C.wave + w) * 64 + C.lane) * 16);
#pragma unroll
                for (int nt = 0; nt < 4; ++nt) acc[nt] += op[nt]; }
            const int m = row & 4095; const bool pad = (m & 127) == 127;
#pragma unroll
            for (int nt = 0; nt < 4; ++nt) { unsigned lo = pk2(acc[nt][0], acc[nt][1]), hi2 = pk2(acc[nt][2], acc[nt][3]); if (pad) { lo = 0u; hi2 = 0u; }
                *(unsigned long long*)(KC2 + (size_t)kv * KC2_STRIDE_E + (size_t)m * 64 + 16 * nt + 4 * fq) = (unsigned long long)lo | ((unsigned long long)hi2 << 32); }
        }
        __syncthreads();
    }
}

__device__ __forceinline__ void fox_flog_tasks(const Ctx& C, const bf16* U, const bf16* WfT, float* flog) {
    if (C.wave >= 4) return;
    const int fr = C.lane & 15, fq = C.lane >> 4;
    for (int task = C.vcu * 4 + C.wave; task < M / 16; task += C.G * 4) {
        const GAS bf16x8_t* ap = (const GAS bf16x8_t*)(U + (size_t)(task * 16 + fr) * D + 8 * fq); const GAS bf16x8_t* bp = (const GAS bf16x8_t*)(WfT + (size_t)fr * D + 8 * fq);
        f32x4 acc = (f32x4){0.f, 0.f, 0.f, 0.f};
#pragma unroll
        for (int kb = 0; kb < D / 32; kb += 16) {
            bf16x8_t a[16], b[16];
#pragma unroll
            for (int j = 0; j < 16; ++j) { a[j] = ap[4 * (kb + j)]; b[j] = bp[4 * (kb + j)]; }
#pragma unroll
            for (int j = 0; j < 16; ++j) acc = __builtin_amdgcn_mfma_f32_16x16x32_bf16(a[j], b[j], acc, 0, 0, 0);
        }
#pragma unroll
        for (int e = 0; e < 4; ++e) flog[(size_t)(task * 16 + 4 * fq + e) * 16 + fr] = acc[e];
    }
}

constexpr int FOX_CUM_OFF = 86016, FOX_WTOT_OFF = 94208, FOX_ROWQ_OFF = 95232;
static_assert(FOX_ROWQ_OFF + 2 * 2048 * 4 <= 139264, "FoX LDS map");
__device__ __forceinline__ void fox_fast_phase(const Ctx& C, char* ldsg, const bf16* Q, const bf16* K, const bf16* V, bf16* O, const float* flog, const float* bfp, bf16* Odummy) {
    LAS float* cumL = (LAS float*)(C.lds + FOX_CUM_OFF); LAS float* wtot = (LAS float*)(C.lds + FOX_WTOT_OFF);
    LAS float* rowq = (LAS float*)(C.lds + FOX_ROWQ_OFF); LAS float* rowd = rowq + SEQ;
    for (int cu = C.vcu; cu < 256; cu += C.G) {
        const int bh = cu >> 1, b = bh >> 4, h = bh & 15;
        int tid_ = C.tid; asm volatile("" : "+v"(tid_));
        const int lane_ = tid_ & 63, wave_ = __builtin_amdgcn_readfirstlane(tid_ >> 6);
#if defined(PROBE_FOXPRE)
#pragma unroll 1
        for (int prep_ = 0; prep_ < 1 + PROBE_FOXPRE; ++prep_) {
#endif
        {
            const int s0 = 4 * tid_; const float bias = bfp[h]; float a[4];
#pragma unroll
            for (int i = 0; i < 4; ++i) { const float x = flog[((size_t)b * SEQ + s0 + i) * 16 + h] + bias; a[i] = (fminf(x, 0.f) - log1pf(expf(-fabsf(x)))) * LOG2E; }
            a[1] += a[0]; a[2] += a[1]; a[3] += a[2];
            const float tot = a[3]; float v = tot;
#pragma unroll
            for (int o = 1; o < 64; o <<= 1) { const float n = __shfl_up(v, o); if (lane_ >= o) v += n; }
            if (lane_ == 63) wtot[wave_] = v;
            __syncthreads();
            float off = 0.f;
            for (int w = 0; w < wave_; ++w) off += wtot[w];
            const float ex = off + v - tot;
            *(LAS f32x4*)(cumL + s0) = (f32x4){ex + a[0], ex + a[1], ex + a[2], ex + a[3]};
            __syncthreads();
        }
        {
            float qm = 0.f, km = 0.f;
            const int sub = tid_ & 7, r8 = tid_ >> 3;
            const GAS v4u* Qg = (const GAS v4u*)(Q + ((size_t)b * SEQ) * 1024 + h * 64 + sub * 8); const GAS v4u* Kg = (const GAS v4u*)(K + ((size_t)b * SEQ) * 1024 + h * 64 + sub * 8);
            const int par = cu & 1;
#pragma unroll
            for (int hb = 0; hb < 2; ++hb) {
                v4u qa_[8], ka_[8];
#pragma unroll
                for (int j = 0; j < 8; ++j) { const int u = 2 * hb + (j >> 2), qbu = 2 * u + ((u >> 1) ^ par), row = 256 * qbu + 64 * (j & 3) + r8; qa_[j] = Qg[(size_t)row * 128]; ka_[j] = Kg[(size_t)row * 128]; }
#pragma unroll
                for (int j = 0; j < 8; ++j) { const int u = 2 * hb + (j >> 2), qbu = 2 * u + ((u >> 1) ^ par), row = 256 * qbu + 64 * (j & 3) + r8; const v4u a = qa_[j], c = ka_[j];
                    float sq = bf_lo(a.x) * bf_lo(a.x) + bf_hi(a.x) * bf_hi(a.x) + bf_lo(a.y) * bf_lo(a.y) + bf_hi(a.y) * bf_hi(a.y) + bf_lo(a.z) * bf_lo(a.z) + bf_hi(a.z) * bf_hi(a.z) + bf_lo(a.w) * bf_lo(a.w) + bf_hi(a.w) * bf_hi(a.w);
                    float sk = bf_lo(c.x) * bf_lo(c.x) + bf_hi(c.x) * bf_hi(c.x) + bf_lo(c.y) * bf_lo(c.y) + bf_hi(c.y) * bf_hi(c.y) + bf_lo(c.z) * bf_lo(c.z) + bf_hi(c.z) * bf_hi(c.z) + bf_lo(c.w) * bf_lo(c.w) + bf_hi(c.w) * bf_hi(c.w);
                    float dq = bf_lo(a.x) * bf_lo(c.x) + bf_hi(a.x) * bf_hi(c.x) + bf_lo(a.y) * bf_lo(c.y) + bf_hi(a.y) * bf_hi(c.y) + bf_lo(a.z) * bf_lo(c.z) + bf_hi(a.z) * bf_hi(c.z) + bf_lo(a.w) * bf_lo(c.w) + bf_hi(a.w) * bf_hi(c.w);
                    sq = sum8(sq); sk = sum8(sk); dq = sum8(dq);
                    qm = fmaxf(qm, sq); km = fmaxf(km, sk);
                    if (sub == 0) { rowq[row] = sq; rowd[row] = dq; } }
            }
            {
                v4u ka_[16];
#pragma unroll
                for (int j = 0; j < 16; ++j) { const int u = j >> 2, qbu = 2 * u + ((u >> 1) ^ par ^ 1), row = 256 * qbu + 64 * (j & 3) + r8; ka_[j] = Kg[(size_t)row * 128]; }
#pragma unroll
                for (int j = 0; j < 16; ++j) { const v4u c = ka_[j];
                    float sk = bf_lo(c.x) * bf_lo(c.x) + bf_hi(c.x) * bf_hi(c.x) + bf_lo(c.y) * bf_lo(c.y) + bf_hi(c.y) * bf_hi(c.y) + bf_lo(c.z) * bf_lo(c.z) + bf_hi(c.z) * bf_hi(c.z) + bf_lo(c.w) * bf_lo(c.w) + bf_hi(c.w) * bf_hi(c.w);
                    sk = sum8(sk); km = fmaxf(km, sk); }
            }
            qm = wave_max(qm); km = wave_max(km);
            if (lane_ == 0) { wtot[8 + wave_] = qm; wtot[16 + wave_] = km; }
            __syncthreads();
            float qa = 0.f, ka = 0.f;
#pragma unroll
            for (int w = 0; w < 8; ++w) { qa = fmaxf(qa, wtot[8 + w]); ka = fmaxf(ka, wtot[16 + w]); }
            const float Kmax = sqrtf(ka); if (tid_ == 0) wtot[48] = 0.02f * sqrtf(qa * ka) + 32.0f;
#pragma unroll
            for (int uu = 0; uu < 2; ++uu) { const int u = 2 * uu + (tid_ >> 8), qbu = 2 * u + ((u >> 1) ^ par), row = 256 * qbu + (tid_ & 255);
                const float t = wave_max(sqrtf(rowq[row]) * Kmax - rowd[row]); if (lane_ == 0) wtot[32 + 4 * u + (wave_ & 3)] = t; }
            __syncthreads();
        }
#if defined(PROBE_FOXPRE)
        }
#endif
#pragma unroll 1
        for (int i = 0; i < 4; ++i) {
            const int qb = (cu & 1) ? (i == 0 ? 6 : i == 1 ? 1 : i == 2 ? 4 : 3) : (i == 0 ? 7 : i == 1 ? 0 : i == 2 ? 5 : 2);
            const int uo = qb >> 1; const float Tskip = fmaxf(fmaxf(wtot[32 + 4 * uo], wtot[33 + 4 * uo]), fmaxf(wtot[34 + 4 * uo], wtot[35 + 4 * uo])) + wtot[48];
            int tskip = 0; { const float c0 = cumL[qb * 256]; for (int t = 0; t + 4 < 4 * qb + 4; ++t) { if (c0 - cumL[64 * t + 63] < -Tskip) tskip = t + 1; else break; } }
            tskip = __builtin_amdgcn_readfirstlane(tskip) & ~1;
#if defined(PROBE_FOXDIAG)
            attn_body::attn_unit<64>(b, h, qb, (const attn_body::bf16*)Q, (const attn_body::bf16*)K, (const attn_body::bf16*)V, (attn_body::bf16*)Odummy, ldsg + RING_OFF, cumL, (PROBE_FOXDIAG == 2 && qb >= 1) ? 4 * qb - 4 : 4 * qb);
#endif
#if defined(PROBE_FOX)
            attn_body::attn_unit<64, PROBE_FOX>(b, h, qb, (const attn_body::bf16*)Q, (const attn_body::bf16*)K, (const attn_body::bf16*)V, (attn_body::bf16*)Odummy, ldsg + RING_OFF, cumL, tskip);
#endif
            attn_body::attn_unit<64>(b, h, qb, (const attn_body::bf16*)Q, (const attn_body::bf16*)K, (const attn_body::bf16*)V, (attn_body::bf16*)O, ldsg + RING_OFF, cumL, tskip);
        }
        __syncthreads();
    }
}

__device__ __forceinline__ void nsa_fast_phase(const Ctx& C, char* ldsg, const bf16* Q, const bf16* KV, const bf16* KC2, const float* gates, const float* lutg, bf16* O) {
    static_assert(nsa::NSA_LDS_END <= LDSCTL_OFF, "NSA LDS map");
    for (int cu = C.vcu; cu < 256; cu += C.G) {
        const int bg = cu >> 3, s = cu & 7;
#pragma unroll 1
        for (int i = 0; i < 4; ++i) {
            const int qc = (i == 0) ? 31 - s : (i == 1) ? s : (i == 2) ? 16 + s : 15 - s;
            nsa::nsa_unit(bg >> 2, bg & 3, qc, (const attn_body::bf16*)Q, (const attn_body::bf16*)KV, (const attn_body::bf16*)KC2, KV_STRIDE_E, KC2_STRIDE_E, gates, lutg, (attn_body::bf16*)O, ldsg + RING_OFF);
        }
    }
}

struct Args { const float* in[15]; float* out; unsigned char* ws; int ph_lo, ph_hi; };
__device__ __forceinline__ Ctx make_ctx(unsigned char* lds) {
    Ctx C; int tid = threadIdx.x; asm volatile("" : "+v"(tid));
    C.lds = (LAS unsigned char*)lds; C.tid = tid; C.lane = tid & 63; C.wave = __builtin_amdgcn_readfirstlane(tid >> 6);
    int bx = blockIdx.x, G = gridDim.x; asm volatile("" : "+s"(bx), "+s"(G));
    C.G = G; C.bx = bx; C.vcu = (C.G % 8 == 0) ? (bx % 8) * (C.G / 8) + bx / 8 : bx;
    C.gw = C.vcu * NWAVES + C.wave; C.ngw = C.G * NWAVES;
    return C;
}
__device__ __forceinline__ unsigned char* opaque_ptr(unsigned char* p) { asm volatile("" : "+s"(p)); return p; }
__global__ void __launch_bounds__(NWAVES * 64, 2) fwd_kernel(Args args) {
    extern __shared__ __attribute__((aligned(16))) unsigned char lds[];
#ifndef CODE_SHIFT
#define CODE_SHIFT 0
#endif
#define CS_STR2(x) #x
#define CS_STR(x) CS_STR2(x)
#if CODE_SHIFT > 0
    asm volatile(".rept " CS_STR(CODE_SHIFT) "\n\ts_nop 0\n\t.endr");
#endif
    volatile LAS unsigned* MISC = (volatile LAS unsigned*)((LAS unsigned char*)lds + MISC_OFF);
    for (int u = threadIdx.x; u < LDS_BYTES / 4; u += NWAVES * 64) ((LAS unsigned*)((LAS unsigned char*)lds))[u] = 0u;
    __syncthreads();
    const int lo = args.ph_lo, hi = args.ph_hi;
    XcdBarrier bar; bar.bar = (unsigned*)(args.ws + WS_CTL) + CW_BAR; bar.x = 0; bar.st = nullptr;
    if (hi - lo > 1) bar = xcd_barrier_post((unsigned*)(args.ws + WS_CTL) + CW_BAR, MISC + 8);
    int ph = 0;
#ifndef PROBE_DUP
#define PROBE_DUP 0
#endif
#define PH_BEGIN_K(kind) if (ph >= lo && ph < hi) { for (int rep_ = (PROBE_DUP >> (kind)) & 1; rep_ >= 0; --rep_) { unsigned char* const ws = opaque_ptr(args.ws); const Ctx C = make_ctx(lds); (void)ws; (void)C;
#define PH_BEGIN PH_BEGIN_K(0)
#define PH_END   } if (ph + 1 < hi) { XcdBarrier b2 = bar; b2.bar = (unsigned*)opaque_ptr((unsigned char*)bar.bar); asm volatile("" : "+s"(b2.x)); xcd_barrier(b2); } } ++ph;
#define WSP(T, off) ((T*)(ws + (off)))

    PH_BEGIN_K(9) {
        In I; I.x = args.in[0]; I.norm_g = args.in[1]; I.w_gate = args.in[2]; I.w_up = args.in[3]; I.w_down = args.in[4]; I.rel_bias = args.in[5]; I.nsa_w_in = args.in[6]; I.nsa_pe = args.in[7];
        I.nsa_w1 = args.in[8]; I.nsa_b1 = args.in[9]; I.nsa_w2 = args.in[10]; I.nsa_w_out = args.in[11]; I.fox_w_in = args.in[12]; I.fox_b_f = args.in[13]; I.fox_w_out = args.in[14];
        prologue(C, I, ws, (bf16*)((unsigned char*)args.out + 32 * MiB)); } PH_END

#pragma unroll 1
    for (int s = 0; s < 8; ++s) {
        const int L = s >> 1, half = s & 1;
        PH_BEGIN_K(0) { pg8::Gemm g{WSP(bf16, WS_U), WSP(bf16, WS_WGU) + (size_t)s * NGU * D, D, D, D}; pg8::StaticOrder S; S.init(M, NGU, C.G, C.bx);
            pg8::EpiSwiglu E{WSP(bf16, WS_R1), FF}; pg8::gemm_phase<pg8::EpiSwiglu, pg8::StaticOrder, true, true>(C.lds + RING_OFF, g, S, E);
            if (C.G == 256 && C.bx >= 128 && rep_ == 0) {
                In I; I.x = args.in[0]; I.norm_g = args.in[1]; I.w_gate = args.in[2]; I.w_up = args.in[3]; I.w_down = args.in[4]; I.rel_bias = args.in[5]; I.nsa_w_in = args.in[6]; I.nsa_pe = args.in[7];
                I.nsa_w1 = args.in[8]; I.nsa_b1 = args.in[9]; I.nsa_w2 = args.in[10]; I.nsa_w_out = args.in[11]; I.fox_w_in = args.in[12]; I.fox_b_f = args.in[13]; I.fox_w_out = args.in[14];
                convert_for_next(I, ws, s, (C.bx - 128) * NWAVES + C.wave, 128 * NWAVES, (LAS float*)(C.lds + RING_OFF + C.wave * 16384), C.lane); } } PH_END
        PH_BEGIN_K(1) { pg8::Gemm g{WSP(bf16, WS_R1), WSP(bf16, WS_WD) + (size_t)s * D * FF, FF, FF, FF}; pg8::StaticOrder S; S.init(M, D, C.G, C.bx);
            pg8::EpiPlain E{WSP(bf16, WS_Y), D}; pg8::gemm_phase<pg8::EpiPlain, pg8::StaticOrder, true, true>(C.lds + RING_OFF, g, S, E); } PH_END
        PH_BEGIN_K(8) { const float* gL = args.in[1] + (size_t)L * 6 * D; const float* gpost = gL + (half ? 5 : 1) * D; const float* gpre = half ? (L < 3 ? gL + 6 * D : nullptr) : gL + 2 * D;
            bf16* hsd = (bf16*)((unsigned char*)args.out + 32 * MiB); const bool last = (s == 7);
            thin_pass(C, last ? WSP(bf16, WS_O) : hsd, rep_ ? WSP(bf16, WS_R1) : hsd, rep_ ? WSP(bf16, WS_R1 + 32 * MiB) : WSP(bf16, WS_U), rep_ ? WSP(float, WS_R1) : args.out, WSP(bf16, WS_Y), gpost, 0.5f, gpre, last); } PH_END
        if (half == 0) {
            const int j = L >> 1;
            if ((L & 1) == 0) {
                PH_BEGIN_K(2) { pg8::Gemm g{WSP(bf16, WS_U), WSP(bf16, WS_WNIN) + (size_t)j * NSA_IN_PAD * D, D, D, D}; pg8::StaticOrder S; S.init(M, NSA_IN_PAD, C.G, C.bx);
                    pg8::EpiNsaIn E{WSP(bf16, WS_R1), WSP(bf16, WS_R1 + R1_KV), WSP(float, WS_GATES), QSCALE, KV_STRIDE_E};
                    pg8::gemm_phase<pg8::EpiNsaIn, pg8::StaticOrder, true, true>(C.lds + RING_OFF, g, S, E); } PH_END
                PH_BEGIN_K(3) { const int kc = C.bx & 7, Lu = (C.bx >> 3) & 31;
                    if (C.bx < 256) { int kch = 256; asm volatile("" : "+s"(kch));
                        pg8::Gemm g{WSP(bf16, WS_R1 + R1_KV) + kc * 256, WSP(bf16, WS_W1T) + (size_t)j * 512 * 2048 + kc * 256, 1024, 2048, kch}; pg8::OneUnit S{Lu, Lu >> 4};
                        pg8::EpiSlab E{WSP(float, WS_Y) + (size_t)kc * 8192 * 256}; pg8::gemm_phase<pg8::EpiSlab, pg8::OneUnit, true, true>(C.lds + RING_OFF, g, S, E); } } PH_END
                PH_BEGIN_K(5) cmp_tail_phase(C, WSP(float, WS_Y), WSP(float, WS_B1F) + j * 512, WSP(bf16, WS_W2T) + (size_t)j * 2 * 64 * 256, WSP(bf16, WS_R1 + R1_KC2)); PH_END
#if NSA_NAIVE
                PH_BEGIN_K(6) nsa_naive_phase(C, WSP(bf16, WS_R1), WSP(bf16, WS_R1 + R1_KV), WSP(bf16, WS_R1 + R1_KC2), WSP(float, WS_GATES), WSP(float, WS_LUT), WSP(bf16, WS_O)); PH_END
#else
                PH_BEGIN_K(6) nsa_fast_phase(C, (char*)lds, WSP(bf16, WS_R1), WSP(bf16, WS_R1 + R1_KV), WSP(bf16, WS_R1 + R1_KC2), WSP(float, WS_GATES), WSP(float, WS_LUT), WSP(bf16, WS_O)); PH_END
#endif
                PH_BEGIN_K(4) { pg8::Gemm g{WSP(bf16, WS_O), WSP(bf16, WS_WNOUT) + (size_t)j * D * D, D, D, D}; pg8::StaticOrder S; S.init(M, D, C.G, C.bx);
                    pg8::EpiPlain E{WSP(bf16, WS_Y), D}; pg8::gemm_phase<pg8::EpiPlain, pg8::StaticOrder, true, true>(C.lds + RING_OFF, g, S, E); } PH_END
            } else {
                PH_BEGIN_K(2) { fox_flog_tasks(C, WSP(bf16, WS_U), WSP(bf16, WS_WFIN) + ((size_t)j * FOX_IN_PAD + 3 * D) * D, WSP(float, WS_FLOG));
                    pg8::Gemm g{WSP(bf16, WS_U), WSP(bf16, WS_WFIN) + (size_t)j * FOX_IN_PAD * D, D, D, D}; pg8::StaticOrder S; S.init(M, 3 * D, C.G, C.bx);
                    pg8::EpiFoxIn E{WSP(bf16, WS_R1), WSP(float, WS_FLOG), QSCALE, (size_t)M * D}; pg8::gemm_phase<pg8::EpiFoxIn, pg8::StaticOrder, true, true>(C.lds + RING_OFF, g, S, E); } PH_END
#if FOX_NAIVE
                PH_BEGIN_K(7) fox_cum_phase(C, WSP(float, WS_FLOG), args.in[13] + j * 16, WSP(float, WS_CUM)); PH_END
                PH_BEGIN_K(7) fox_naive_phase(C, WSP(bf16, WS_R1), WSP(bf16, WS_R1) + (size_t)M * D, WSP(bf16, WS_R1) + (size_t)2 * M * D, WSP(float, WS_CUM), WSP(bf16, WS_O)); PH_END
#else
                PH_BEGIN_K(7) fox_fast_phase(C, (char*)lds, WSP(bf16, WS_R1), WSP(bf16, WS_R1) + (size_t)M * D, WSP(bf16, WS_R1) + (size_t)2 * M * D, WSP(bf16, WS_O), WSP(float, WS_FLOG), args.in[13] + j * 16, WSP(bf16, WS_Y)); PH_END
#endif
                PH_BEGIN_K(4) { pg8::Gemm g{WSP(bf16, WS_O), WSP(bf16, WS_WFOUT) + (size_t)j * D * D, D, D, D}; pg8::StaticOrder S; S.init(M, D, C.G, C.bx);
                    pg8::EpiPlain E{WSP(bf16, WS_Y), D}; pg8::gemm_phase<pg8::EpiPlain, pg8::StaticOrder, true, true>(C.lds + RING_OFF, g, S, E); } PH_END
            }
            PH_BEGIN_K(8) { const float* gL = args.in[1] + (size_t)L * 6 * D; bf16* hsd = (bf16*)((unsigned char*)args.out + 32 * MiB);
                thin_pass(C, hsd, rep_ ? WSP(bf16, WS_R1) : (L == 3 ? WSP(bf16, WS_O) : hsd), rep_ ? WSP(bf16, WS_R1 + 32 * MiB) : WSP(bf16, WS_U), args.out, WSP(bf16, WS_Y), gL + 3 * D, 1.0f, gL + 4 * D, false); } PH_END
        }
    }
#undef PH_BEGIN
#undef PH_END
#undef WSP
}

extern "C" void kernel_launch(void* const* d_in, const int* in_sizes, int n_in, void* d_out, int out_size, void* d_ws, size_t ws_size, hipStream_t stream) {
    static int grid = 0;
    if (grid == 0) {
        if (n_in != 15 || in_sizes[0] != M * D || out_size != M * D || ws_size < WS_END) { fprintf(stderr, "kernel_launch: unexpected shapes (n_in %d, in0 %d, out %d, ws %zu < %zu); nothing launched\n", n_in, n_in > 0 ? in_sizes[0] : -1, out_size, ws_size, (size_t)WS_END); grid = -1; return; }
        int dev = 0, cus = 0, per_cu = 0;
        if (hipGetDevice(&dev) != hipSuccess || hipDeviceGetAttribute(&cus, hipDeviceAttributeMultiprocessorCount, dev) != hipSuccess) { grid = -1; return; }
        if (hipFuncSetAttribute((const void*)fwd_kernel, hipFuncAttributeMaxDynamicSharedMemorySize, LDS_BYTES) != hipSuccess) { fprintf(stderr, "kernel_launch: hipFuncSetAttribute failed\n"); grid = -1; return; }
        if (hipOccupancyMaxActiveBlocksPerMultiprocessor(&per_cu, (const void*)fwd_kernel, NWAVES * 64, LDS_BYTES) != hipSuccess || per_cu < 1)
            fprintf(stderr, "kernel_launch: note: occupancy query reports %d workgroups per CU\n", per_cu);
        (void)hipGetLastError();
        grid = cus;
    }
    if (grid < 0) return;
    if (hipMemsetAsync((char*)d_ws + WS_CTL, 0, CTL_ZERO_BYTES, stream) != hipSuccess) { fprintf(stderr, "kernel_launch: hipMemsetAsync failed\n"); return; }
    Args a{};
    for (int i = 0; i < 15; ++i) a.in[i] = (const float*)d_in[i];
    a.out = (float*)d_out; a.ws = (unsigned char*)d_ws;
#if MK_PER_PHASE
    for (int p = 0; p < N_PHASES; ++p) { a.ph_lo = p; a.ph_hi = p + 1; hipLaunchKernelGGL(fwd_kernel, dim3(grid), dim3(NWAVES * 64), LDS_BYTES, stream, a); }
#else
    a.ph_lo = 0; a.ph_hi = N_PHASES;
    hipLaunchKernelGGL(fwd_kernel, dim3(grid), dim3(NWAVES * 64), LDS_BYTES, stream, a);
#endif
    const hipError_t le = hipPeekAtLastError();
    if (le != hipSuccess) fprintf(stderr, "kernel_launch: launch failed: %s\n", hipGetErrorName(le));
}
```

```cpp
#include <hip/hip_runtime.h>
#include <cstdio>
#include <cstdint>
#define PG8_STR2(x) #x
#define PG8_STR(x) PG8_STR2(x)
namespace pg8 {
#define PG8_LAS __attribute__((address_space(3)))
typedef unsigned short bf16_t;
typedef short bf16x8 __attribute__((ext_vector_type(8)));
typedef float f32x4 __attribute__((ext_vector_type(4)));
typedef unsigned u32x4 __attribute__((ext_vector_type(4)));
constexpr int BM = 256, BK = 64, HALF = 128, HTB = HALF * BK * 2  , STAGE_BYTES = 8 * HTB, NXCD = 8, WGM = 8;

__host__ __device__ __forceinline__ int lds_byte(int r, int c) { const int st = (r >> 4) * 2 + (c >> 5), rr = r & 15, cc = c & 31, ob = rr * 64 + cc * 2; return st * 1024 + (ob ^ (((ob >> 9) & 1) << 5)); }
__host__ __device__ __forceinline__ void stage_rc(int b, int& R, int& C) { const int st = b / 1024, sb = b % 1024, swz = sb ^ (((sb >> 9) & 1) << 5); R = (st >> 1) * 16 + swz / 64; C = (st & 1) * 32 + (swz % 64) / 2; }
__host__ __device__ __forceinline__ int perm32(int rho) { const int n = rho >> 4, i = rho & 15; return 8 * (i >> 2) + 4 * n + (i & 3); }

struct Unit { int pm, pn; };
struct Gemm { const bf16_t* A; const bf16_t* Bt; int lda, ldb, K; };

struct StaticOrder {
    int nM, nN, nwg, G, c;
    __host__ __device__ void init(int M, int N, int G_, int c_) { nM = M / BM; nN = N / BM; nwg = nM * nN; G = G_; c = c_; }
    __host__ __device__ bool next(int i, Unit& u) const {
        const long L = (long)i * G + c; if (L >= nwg) return false;
        int wgid = (int)L; { const int q = nwg / NXCD, r = nwg % NXCD, xcd = wgid % NXCD, off = wgid / NXCD; wgid = (xcd < r ? xcd * (q + 1) : r * (q + 1) + (xcd - r) * q) + off; }
        const int nig = WGM * nN, gid = wgid / nig, fm = gid * WGM, gsz = (nM - fm) < WGM ? (nM - fm) : WGM;
        u.pm = fm + ((wgid % nig) % gsz); u.pn = (wgid % nig) / gsz; return true;
    }
    __device__ __forceinline__ void a_ready(const Unit&) const {}
    __device__ __forceinline__ void done(const Unit&) const {}
};

__device__ __forceinline__ unsigned cvt_pk_bf16(float lo, float hi) { unsigned r; asm volatile("v_cvt_pk_bf16_f32 %0, %1, %2" : "=v"(r) : "v"(lo), "v"(hi)); return r; }
typedef float f32x2 __attribute__((ext_vector_type(2)));
__device__ __forceinline__ f32x2 gelu_pk(f32x2 v) {
    const f32x2 av = __builtin_elementwise_abs(v), d = av * 0.2316418882f + 1.0f;
    f32x2 t; t.x = __builtin_amdgcn_rcpf(d.x); t.y = __builtin_amdgcn_rcpf(d.y);
    f32x2 q = t * 0.5307027145f + (-0.7265760135f); q = q * t + 0.7107068705f; q = q * t + (-0.142248368f); q = q * t + 0.127414796f; q = q * t;
    const f32x2 s = (v * v) * (-0.72134752044f);
    f32x2 e; e.x = __builtin_amdgcn_exp2f(s.x); e.y = __builtin_amdgcn_exp2f(s.y);
    const f32x2 m = v * (q * e), r = v - m;
    f32x2 o; o.x = v.x < 0.f ? m.x : r.x; o.y = v.y < 0.f ? m.y : r.y; return o;
}

template <class Epi, class Sched, bool ALIGN_EPI = false, bool SP2 = false>
__device__ __forceinline__ void gemm_phase(PG8_LAS unsigned char* lds, const Gemm g, const Sched& S, const Epi& E) {
    int tid = threadIdx.x; asm volatile("" : "+v"(tid));
    const int wid = __builtin_amdgcn_readfirstlane(tid >> 6), lane = tid & 63, wr = wid >> 2, wc = wid & 3, fr = lane & 15, fq = lane >> 4;
    const int K = g.K, nt = K / BK;
    unsigned voffA[2], voffB[2];
#pragma unroll
    for (int i = 0; i < 2; ++i) { int R, C; stage_rc(tid * 16 + i * 8192, R, C); const int Rb = Epi::PERM ? ((R & ~31) + perm32(R & 31)) : R;
        voffA[i] = (unsigned)(R * g.lda + C) * 2u; voffB[i] = (unsigned)(Rb * g.ldb + C) * 2u; }
    const size_t kstep = (size_t)(BK * 2);
    const size_t hstepA = (size_t)HALF * g.lda * 2, hstepB = (size_t)HALF * g.ldb * 2;
    const size_t tstepA = 2 * hstepA, tstepB = 2 * hstepB;
    const unsigned ldsw = (unsigned)wid * 1024u;
    const int aoff = lds_byte(wr * 64 + fr, fq * 8), boff = lds_byte(wc * 32 + fr, fq * 8);
#define PG8_SA(b, h) (((b) * 2 + (h)) * HTB)
#define PG8_SB(b, h) ((4 + (b) * 2 + (h)) * HTB)
#define PG8_STAGE(bufoff, gbase, voff) do { _Pragma("unroll") for (int _i = 0; _i < 2; ++_i) \
        __builtin_amdgcn_global_load_lds((const unsigned*)((const char*)(gbase) + (voff)[_i]), (PG8_LAS unsigned*)(lds + (bufoff) + ldsw + _i * 8192), 16, 0, 0); } while (0)
#define PG8_LDA(dst, b, h) do { _Pragma("unroll") for (int m = 0; m < 4; ++m) _Pragma("unroll") for (int k = 0; k < 2; ++k) dst[m][k] = *(const PG8_LAS bf16x8*)(lds + PG8_SA(b, h) + aoff + m * 2048 + k * 1024); } while (0)
#define PG8_LDB(dst, b, h) do { _Pragma("unroll") for (int n = 0; n < 2; ++n) _Pragma("unroll") for (int k = 0; k < 2; ++k) dst[n][k] = *(const PG8_LAS bf16x8*)(lds + PG8_SB(b, h) + boff + n * 2048 + k * 1024); } while (0)
#define PG8_MMA(ai, bj, At, Bt) do { __builtin_amdgcn_s_setprio(1); _Pragma("unroll") for (int m = 0; m < 4; ++m) _Pragma("unroll") for (int n = 0; n < 2; ++n) _Pragma("unroll") for (int k = 0; k < 2; ++k) \
        acc[ai][bj][m][n] = __builtin_amdgcn_mfma_f32_16x16x32_bf16(Bt[n][k], At[m][k], acc[ai][bj][m][n], 0, 0, 0); __builtin_amdgcn_s_setprio(0); } while (0)
#define PG8_WAIT_V(n) asm volatile("s_waitcnt vmcnt(" #n ")" ::: "memory")
#define PG8_WAIT_L(n) asm volatile("s_waitcnt lgkmcnt(" #n ")" ::: "memory")
#define PG8_BAR __builtin_amdgcn_s_barrier()
#define PG8_SCHED __builtin_amdgcn_sched_barrier(0)
    Unit cur, nxt; int ui = 0;
    if (!S.next(0, cur)) return;
    f32x4 acc[2][2][4][2];
#pragma unroll
    for (int a = 0; a < 2; ++a)
#pragma unroll
        for (int b = 0; b < 2; ++b)
#pragma unroll
            for (int m = 0; m < 4; ++m)
#pragma unroll
                for (int n = 0; n < 2; ++n) acc[a][b][m][n] = (f32x4){0.f, 0.f, 0.f, 0.f};
    bf16x8 At[4][2], B0[2][2], B1[2][2];
    const char* cA = (const char*)g.A + (size_t)cur.pm * tstepA; const char* cB = (const char*)g.Bt + (size_t)cur.pn * tstepB;
    S.a_ready(cur);
    if constexpr (SP2) {
        PG8_STAGE(PG8_SB(0, 0), cB, voffB); PG8_STAGE(PG8_SB(0, 1), cB + hstepB, voffB); PG8_STAGE(PG8_SA(0, 0), cA, voffA); PG8_STAGE(PG8_SA(0, 1), cA + hstepA, voffA);
        if (wr == 1) PG8_BAR;
        PG8_WAIT_V(2); PG8_BAR;
        PG8_STAGE(PG8_SB(1, 0), cB + kstep, voffB); PG8_STAGE(PG8_SA(1, 0), cA + kstep, voffA); PG8_STAGE(PG8_SB(1, 1), cB + hstepB + kstep, voffB);
        PG8_WAIT_V(6); PG8_BAR;
    } else {
        PG8_STAGE(PG8_SB(0, 0), cB, voffB); PG8_STAGE(PG8_SA(0, 0), cA, voffA); PG8_STAGE(PG8_SB(0, 1), cB + hstepB, voffB); PG8_STAGE(PG8_SA(0, 1), cA + hstepA, voffA);
        if (wr == 1) PG8_BAR;
        PG8_WAIT_V(4); PG8_BAR;
        PG8_STAGE(PG8_SB(1, 0), cB + kstep, voffB); PG8_STAGE(PG8_SA(1, 0), cA + kstep, voffA); PG8_STAGE(PG8_SB(1, 1), cB + hstepB + kstep, voffB);
        PG8_WAIT_V(6); PG8_BAR;
    }
    for (;;) {
        const bool has_next = S.next(ui + 1, nxt);
        const char* nA = has_next ? (const char*)g.A + (size_t)nxt.pm * tstepA : cA; const char* nB = has_next ? (const char*)g.Bt + (size_t)nxt.pn * tstepB : cB;
        for (int t = 0; t < nt; t += 2) {
#if defined(KLOOP_ALIGN)
            asm volatile(".p2align 6\n\t.rept " PG8_STR(KLOOP_ALIGN) "\n\ts_nop 0\n\t.endr");
#endif
            const bool last = (t == nt - 2);
            const char* a1 = cA + (size_t)(t + 1) * kstep;
            const char* a2 = last ? nA : cA + (size_t)(t + 2) * kstep; const char* b2 = last ? nB : cB + (size_t)(t + 2) * kstep;
            const char* a3 = a2 + kstep; const char* b3 = b2 + kstep;
            if (last && has_next) S.a_ready(nxt);
            if constexpr (SP2) {
            PG8_LDB(B0, 0, 0); PG8_LDB(B1, 0, 1); PG8_SCHED; PG8_LDA(At, 0, 0); PG8_STAGE(PG8_SA(1, 1), a1 + hstepA, voffA);
            PG8_WAIT_V(8); PG8_WAIT_L(0); PG8_BAR; PG8_MMA(0, 0, At, B0); PG8_MMA(0, 1, At, B1); PG8_BAR; PG8_SCHED;
            PG8_LDA(At, 0, 1); PG8_STAGE(PG8_SB(0, 0), b2, voffB); PG8_STAGE(PG8_SB(0, 1), b2 + hstepB, voffB); PG8_STAGE(PG8_SA(0, 0), a2, voffA);
            PG8_WAIT_V(8); PG8_WAIT_L(0); PG8_BAR; PG8_MMA(1, 0, At, B0); PG8_MMA(1, 1, At, B1); PG8_BAR; PG8_SCHED;
            PG8_LDB(B0, 1, 0); PG8_LDB(B1, 1, 1); PG8_SCHED; PG8_LDA(At, 1, 0); PG8_STAGE(PG8_SA(0, 1), a2 + hstepA, voffA);
            PG8_WAIT_V(8); PG8_WAIT_L(0); PG8_BAR; PG8_MMA(0, 0, At, B0); PG8_MMA(0, 1, At, B1); PG8_BAR; PG8_SCHED;
            PG8_LDA(At, 1, 1); PG8_STAGE(PG8_SB(1, 0), b3, voffB); PG8_STAGE(PG8_SB(1, 1), b3 + hstepB, voffB); PG8_STAGE(PG8_SA(1, 0), a3, voffA);
            PG8_WAIT_V(8); PG8_WAIT_L(0); PG8_BAR; PG8_MMA(1, 0, At, B0); PG8_MMA(1, 1, At, B1); PG8_BAR; PG8_SCHED;
            } else {
            PG8_LDB(B0, 0, 0); PG8_SCHED; PG8_LDA(At, 0, 0); PG8_STAGE(PG8_SA(1, 1), a1 + hstepA, voffA);
            PG8_WAIT_L(8); PG8_BAR; PG8_WAIT_L(0); PG8_MMA(0, 0, At, B0); PG8_BAR; PG8_SCHED;
            PG8_LDB(B1, 0, 1); PG8_STAGE(PG8_SB(0, 0), b2, voffB);
            PG8_BAR; PG8_WAIT_L(0); PG8_MMA(0, 1, At, B1); PG8_BAR;
            PG8_LDA(At, 0, 1); PG8_STAGE(PG8_SA(0, 0), a2, voffA);
            PG8_BAR; PG8_WAIT_L(0); PG8_MMA(1, 0, At, B0); PG8_BAR; PG8_SCHED;
            PG8_STAGE(PG8_SB(0, 1), b2 + hstepB, voffB);
            PG8_WAIT_V(6); PG8_BAR; PG8_MMA(1, 1, At, B1); PG8_BAR;
            PG8_LDB(B0, 1, 0); PG8_SCHED; PG8_LDA(At, 1, 0); PG8_STAGE(PG8_SA(0, 1), a2 + hstepA, voffA);
            PG8_WAIT_L(8); PG8_BAR; PG8_WAIT_L(0); PG8_MMA(0, 0, At, B0); PG8_BAR; PG8_SCHED;
            PG8_LDB(B1, 1, 1); PG8_STAGE(PG8_SB(1, 0), b3, voffB);
            PG8_BAR; PG8_WAIT_L(0); PG8_MMA(0, 1, At, B1); PG8_BAR;
            PG8_LDA(At, 1, 1); PG8_STAGE(PG8_SA(1, 0), a3, voffA);
            PG8_BAR; PG8_WAIT_L(0); PG8_MMA(1, 0, At, B0); PG8_BAR; PG8_SCHED;
            PG8_STAGE(PG8_SB(1, 1), b3 + hstepB, voffB);
            PG8_WAIT_V(6); PG8_BAR; PG8_MMA(1, 1, At, B1); PG8_BAR;
            }
        }
        if constexpr (ALIGN_EPI) { if (wr == 0) PG8_BAR; }
        if constexpr (!Epi::AFTER_DRAIN) { E(acc, cur, wr, wc, fr, fq); S.done(cur); }
        if (!has_next) break;
#pragma unroll
        for (int a = 0; a < 2; ++a)
#pragma unroll
            for (int b = 0; b < 2; ++b)
#pragma unroll
                for (int m = 0; m < 4; ++m)
#pragma unroll
                    for (int n = 0; n < 2; ++n) acc[a][b][m][n] = (f32x4){0.f, 0.f, 0.f, 0.f};
        cur = nxt; cA = nA; cB = nB; ++ui;
        if constexpr (ALIGN_EPI) { if (wr == 1) PG8_BAR; }
    }
    PG8_WAIT_V(0);
    if constexpr (!ALIGN_EPI) { if (wr == 0) PG8_BAR; }
    PG8_BAR;
    if constexpr (Epi::AFTER_DRAIN) { E.fused(acc, cur, wr, wc, fr, fq, lds, wid, lane); S.done(cur); }
#undef PG8_SA
#undef PG8_SB
#undef PG8_STAGE
#undef PG8_LDA
#undef PG8_LDB
#undef PG8_MMA
#undef PG8_WAIT_V
#undef PG8_WAIT_L
#undef PG8_BAR
#undef PG8_SCHED
}
}
#include <hip/hip_bf16.h>
#include <cmath>
namespace attn_body {
using bf16=__hip_bfloat16;
using bf16x8=__attribute__((ext_vector_type(8)))short;
using s16x4=__attribute__((ext_vector_type(4)))short;
using f32x16=__attribute__((ext_vector_type(16)))float;
using u32x4=__attribute__((ext_vector_type(4)))unsigned;
constexpr int BATCH=8,NHEAD=16,SEQ=2048,D=64,DM=NHEAD*D;
constexpr int NW=8,QBLK=32,QB=QBLK*NW,KVBLK=64,NQB=SEQ/QB;
constexpr int ATTN_PITCH=DM, ATTN_UNIT_ROWS=QB;
__device__ __forceinline__ int crow(int r,int hi){return (r&3)+8*(r>>2)+4*hi;}
#define SBAR() __builtin_amdgcn_sched_barrier(0)
__device__ __forceinline__ void cmask(f32x16&p0,f32x16&p1,int jb,int qrel,int hi){
  const float NEG=-INFINITY; int kb=64*jb+4*hi;
  #pragma unroll
  for(int r=0;r<16;++r){int kv=kb+(r&3)+8*(r>>2); if(kv>qrel)p0[r]=NEG; if(kv+32>qrel)p1[r]=NEG;}
}

constexpr int NSLOT=3, SLOTB=8192;
constexpr int LDS_K=0, LDS_V=NSLOT*SLOTB, LDS_WS=2*NSLOT*SLOTB, LDS_OST=LDS_WS+NW*64*4, LDS_BYTES=LDS_OST+NW*4096;
constexpr float C2=0.125f*1.4426950408889634f;
__device__ __forceinline__ void glds16(const void*gsrc,unsigned lds_dst){unsigned keep;
  asm volatile("s_mov_b32 %0, m0\n\ts_mov_b32 m0, %2\n\ts_nop 0\n\tglobal_load_lds_dwordx4 %1, off\n\ts_mov_b32 m0, %0":"=&s"(keep):"v"(gsrc),"s"(lds_dst):"memory");}
__device__ __forceinline__ void glds16s(const void*sbase,unsigned voff,unsigned lds_dst){unsigned keep;
  asm volatile("s_mov_b32 %0, m0\n\ts_mov_b32 m0, %2\n\ts_nop 0\n\tglobal_load_lds_dwordx4 %1, %3\n\ts_mov_b32 m0, %0":"=&s"(keep):"v"(voff),"s"(lds_dst),"s"(sbase):"memory");}
__device__ __forceinline__ float max3f(float a,float b,float c){float r;asm("v_max3_f32 %0, %1, %2, %3":"=v"(r):"v"(a),"v"(b),"v"(c));return r;}
__device__ __forceinline__ float max2f(float a,float b){float r;asm("v_max_f32_e32 %0, %1, %2":"=v"(r):"v"(a),"v"(b));return r;}
__device__ __forceinline__ float fadd_s(float a,float b){float r;asm("v_add_f32_e32 %0, %1, %2":"=v"(r):"v"(a),"v"(b));return r;}
__device__ __forceinline__ float fsub_s(float a,float b){float r;asm("v_sub_f32_e32 %0, %1, %2":"=v"(r):"v"(a),"v"(b));return r;}
typedef float f32x2_t __attribute__((ext_vector_type(2))); typedef __bf16 bf16x2_t __attribute__((ext_vector_type(2)));
__device__ __forceinline__ unsigned cvtpk_s(float lo,float hi){f32x2_t v={lo,hi};bf16x2_t b=__builtin_convertvector(v,bf16x2_t);return __builtin_bit_cast(unsigned,b);}
#define WAIT_BAR(N) asm volatile("s_waitcnt vmcnt(" #N ") lgkmcnt(0)\n\ts_barrier":::"memory")

__device__ __forceinline__ void qkt(f32x16&p0,f32x16&p1,const char*Kslot,const bf16x8*qr,const f32x16&negm,int r32,int hi){
  const char*kb=Kslot+hi*1024+r32*16;
  #pragma unroll
  for(int d0=0;d0<4;++d0){
    const bf16x8 b0=*reinterpret_cast<const bf16x8*>(kb+d0*2048);
    const bf16x8 b1=*reinterpret_cast<const bf16x8*>(kb+d0*2048+512);
    if(d0==0){p0=__builtin_amdgcn_mfma_f32_32x32x16_bf16(b0,qr[0],negm,0,0,0);p1=__builtin_amdgcn_mfma_f32_32x32x16_bf16(b1,qr[0],negm,0,0,0);}
    else{p0=__builtin_amdgcn_mfma_f32_32x32x16_bf16(b0,qr[d0],p0,0,0,0);p1=__builtin_amdgcn_mfma_f32_32x32x16_bf16(b1,qr[d0],p1,0,0,0);}}
}
typedef __attribute__((address_space(3))) const char* lds_cptr;
typedef short v4i16_t __attribute__((ext_vector_type(4)));
__device__ __forceinline__ void kload8(bf16x8*kf,lds_cptr kp){
  kf[0]=*(const __attribute__((address_space(3))) bf16x8*)(kp);      kf[1]=*(const __attribute__((address_space(3))) bf16x8*)(kp+512);
  kf[2]=*(const __attribute__((address_space(3))) bf16x8*)(kp+2048); kf[3]=*(const __attribute__((address_space(3))) bf16x8*)(kp+2560);
  kf[4]=*(const __attribute__((address_space(3))) bf16x8*)(kp+4096); kf[5]=*(const __attribute__((address_space(3))) bf16x8*)(kp+4608);
  kf[6]=*(const __attribute__((address_space(3))) bf16x8*)(kp+6144); kf[7]=*(const __attribute__((address_space(3))) bf16x8*)(kp+6656);
}
__device__ __forceinline__ void kload2(bf16x8*kf,lds_cptr kp,int j){ kf[2*j]=*(const __attribute__((address_space(3))) bf16x8*)(kp+j*2048); kf[2*j+1]=*(const __attribute__((address_space(3))) bf16x8*)(kp+j*2048+512); }
__device__ __forceinline__ s16x4 vtr(lds_cptr p){ return __builtin_bit_cast(s16x4,__builtin_amdgcn_ds_read_tr16_b64_v4i16((__attribute__((address_space(3))) v4i16_t*)p)); }
__device__ __forceinline__ float rowmax(const f32x16&p0,const f32x16&p1){
  float a=max3f(p0[0],p0[1],p1[0]),b=max3f(p0[2],p0[3],p1[1]);a=max3f(a,p1[2],p1[3]);
  #pragma unroll
  for(int r=4;r<16;r+=4){a=max3f(a,p0[r],p0[r+1]);b=max3f(b,p0[r+2],p0[r+3]);a=max3f(a,p1[r],p1[r+1]);b=max3f(b,p1[r+2],p1[r+3]);}
  const float m=max2f(a,b);
  auto rr=__builtin_amdgcn_permlane32_swap(__float_as_uint(m),__float_as_uint(m),false,false);
  return max2f(__uint_as_float(rr[0]),__uint_as_float(rr[1]));
}
__device__ __forceinline__ void pv(f32x16*o,int vb,bf16x8 pa0,bf16x8 pa1,bf16x8 pa2,bf16x8 pa3){
  #pragma unroll
  for(int d0=0;d0<2;++d0){s16x4 lo[4],hi[4];
    #pragma unroll
    for(int ks=0;ks<4;++ks){
      asm volatile("ds_read_b64_tr_b16 %0,%1 offset:%c2":"=&v"(lo[ks]):"v"(vb),"i"(d0*4096+ks*1024):"memory");
      asm volatile("ds_read_b64_tr_b16 %0,%1 offset:%c2":"=&v"(hi[ks]):"v"(vb),"i"(d0*4096+ks*1024+512):"memory");}
    asm volatile("s_waitcnt lgkmcnt(0)":::"memory");SBAR();
    #define PK(k) (bf16x8){lo[k][0],lo[k][1],lo[k][2],lo[k][3],hi[k][0],hi[k][1],hi[k][2],hi[k][3]}
    o[d0]=__builtin_amdgcn_mfma_f32_32x32x16_bf16(pa0,PK(0),o[d0],0,0,0);
    o[d0]=__builtin_amdgcn_mfma_f32_32x32x16_bf16(pa1,PK(1),o[d0],0,0,0);
    o[d0]=__builtin_amdgcn_mfma_f32_32x32x16_bf16(pa2,PK(2),o[d0],0,0,0);
    o[d0]=__builtin_amdgcn_mfma_f32_32x32x16_bf16(pa3,PK(3),o[d0],0,0,0);
    #undef PK
  }
}

#ifndef ATTN_STORE16
#define ATTN_STORE16(p,v) (*(u32x4*)(p)=(v))
#endif
template<int THRL,int VAR=0> __device__ __forceinline__ void attn_unit(int b,int h,int qb,const bf16*Q,const bf16*__restrict__ K,const bf16*__restrict__ V,bf16*O,char*shm,const __attribute__((address_space(3))) float*cumL,int tskip){
  int tid=threadIdx.x; asm volatile("":"+v"(tid));
  const int lane=tid&63,r32=lane&31,hi=lane>>5; const int wid=__builtin_amdgcn_readfirstlane(tid>>6);
  const long rowbase=(long)b*SEQ; const int q0=qb*QB;
  const bf16*Qw=Q+(rowbase+q0+wid*QBLK)*DM+h*D;
  const bf16*Kh=K+(rowbase+(long)tskip*KVBLK)*DM+h*D,*Vh=V+(rowbase+(long)tskip*KVBLK)*DM+h*D;
  const unsigned lds0=(unsigned)(uintptr_t)shm;
  float*wsf=(float*)(shm+LDS_WS)+wid*64;
  const bf16*ksrc=Kh+(long)lane*DM+wid*8;
  const bf16*vsrc=Vh+(long)(16*(wid&3)+(lane>>2))*DM+(wid>>2)*32+(lane&3)*8;
  const unsigned kdst=lds0+LDS_K+wid*1024, vdst=lds0+LDS_V+wid*1024;
  #define DMA_K(t,slot) glds16(ksrc+(long)(t)*KVBLK*DM,(unsigned)__builtin_amdgcn_readfirstlane(kdst+(slot)))
  #define DMA_V(t,slot) glds16(vsrc+(long)(t)*KVBLK*DM,(unsigned)__builtin_amdgcn_readfirstlane(vdst+(slot)))
  const int vb0=(int)(lds0+LDS_V)+((lane>>4)&1)*32+(lane&3)*8+(4*hi+((lane&15)>>2))*64;
  const char*Kbase=shm+LDS_K; bf16x8 kf[8];
  const lds_cptr shm3=(lds_cptr)shm; const lds_cptr kp0=shm3+LDS_K+hi*1024+r32*16; const lds_cptr vp0=shm3+LDS_V+((lane>>4)&1)*32+(lane&3)*8+(4*hi+((lane&15)>>2))*64;
  const int NT=(q0+QB)/KVBLK-tskip;
  DMA_K(0,0);DMA_V(0,0);DMA_K(1,SLOTB);
  bf16x8 qr[4];
  #pragma unroll
  for(int d0=0;d0<4;++d0)qr[d0]=*reinterpret_cast<const bf16x8*>(&Qw[(long)r32*DM+d0*16+hi*8]);
  const float cq=cumL[qb*QB+wid*QBLK+r32];
  float mhat=0.f,l_reg=0.f;f32x16 o[2];o[0]=f32x16{};o[1]=f32x16{};const f32x16 negm=f32x16{};
  typedef float f32x4_t __attribute__((ext_vector_type(4)));
  #define KBIAS(P0,P1,t) do{ if(VAR&1){ const float nm1_=cq-mhat; _Pragma("unroll") for(int r_=0;r_<16;++r_){P0[r_]+=nm1_;P1[r_]+=nm1_;} break; } const float nm_=cq-mhat; const __attribute__((address_space(3))) float*cb_=cumL+64*((t)+tskip)+4*hi; \
    _Pragma("unroll") for(int g_=0;g_<4;++g_){ const f32x4_t k0_=*(const __attribute__((address_space(3))) f32x4_t*)(cb_+8*g_); const f32x4_t k1_=*(const __attribute__((address_space(3))) f32x4_t*)(cb_+32+8*g_); \
      _Pragma("unroll") for(int e_=0;e_<4;++e_){ P0[4*g_+e_]+=(nm_-k0_[e_]); P1[4*g_+e_]+=(nm_-k1_[e_]); } } }while(0)
  const int qrel=wid*QBLK+r32;
  #define CMASK(P0,P1,t) do{int jb_=(t)-(NT-4); if(jb_>=0)cmask(P0,P1,jb_,qrel,hi);}while(0)
  bool resc=false;
  #define START(P0,P1) do{ const float rm=rowmax(P0,P1); resc=false; \
    { const float dl=rm; mhat=fadd_s(mhat,dl); \
      _Pragma("unroll") for(int r=0;r<16;++r){P0[r]=fsub_s(P0[r],dl);P1[r]=fsub_s(P1[r],dl);} \
      } \
    _Pragma("unroll") for(int r=0;r<16;++r)P0[r]=__builtin_amdgcn_exp2f(P0[r]); }while(0)
  #define RESC() do{ if(resc){ asm volatile("s_waitcnt lgkmcnt(0)":::"memory"); \
      _Pragma("unroll") for(int d_=0;d_<2;++d_) _Pragma("unroll") for(int r=0;r<16;++r)o[d_][r]*=wsf[crow(r,hi)]; } }while(0)
  f32x16 pA0,pA1,pB0,pB1;
  int sl_prev=0,sl_cur=0,sl_next=SLOTB;
  #define ROT() do{sl_prev=sl_cur;sl_cur=sl_next;sl_next=(sl_next==(NSLOT-1)*SLOTB)?0:sl_next+SLOTB;}while(0)
  DMA_K(2,2*SLOTB);
  WAIT_BAR(3);
  qkt(pA0,pA1,Kbase,qr,negm,r32,hi);asm volatile("s_nop 15\n\ts_nop 7":"+v"(pA0),"+v"(pA1));KBIAS(pA0,pA1,0);CMASK(pA0,pA1,0);
  START(pA0,pA1);
  _Pragma("unroll") for(int r=0;r<16;++r)pA1[r]=__builtin_amdgcn_exp2f(pA1[r]);
  WAIT_BAR(0);
  DMA_K(3,0);DMA_V(1,SLOTB);
  ROT();
  kload8(kf,kp0+sl_cur);
  WAIT_BAR(2);
  s16x4 vlo[8],vhi[8]; u32x4 pw0,pw1,pw2,pw3;
  #define PKW(P,B) cvtpk_s(P[B],P[B+1])
  #define PAF(k) __builtin_bit_cast(bf16x8,pw##k)
  #define VFR(i) (bf16x8){vlo[i][0],vlo[i][1],vlo[i][2],vlo[i][3],vhi[i][0],vhi[i][1],vhi[i][2],vhi[i][3]}
  #define PIN(x) asm volatile("":"+v"(x))
  #define MX3(a,b,c) __builtin_fmaxf(__builtin_fmaxf((a),(b)),(c))
  #define GAPA(MF,A0,A1,A2,A3,W0,W1,PW) do{ MF; sacc+=A0; sacc+=A1; sacc+=A2; sacc+=A3; PIN(sacc); W0; W1; PIN(PW); SBAR(); }while(0)
  #define EX(v) __builtin_amdgcn_exp2f(v)
  #define GAPB(MF,X,B) do{ MF; X[B]=EX(X[B]); X[B+1]=EX(X[B+1]); X[B+2]=EX(X[B+2]); X[B+3]=EX(X[B+3]); PIN(X); SBAR(); }while(0)
  #define VRD(i) do{ vlo[i]=vtr(vp_+(((i)>>2)*4096+((i)&3)*1024)); vhi[i]=vtr(vp_+(((i)>>2)*4096+((i)&3)*1024+512)); }while(0)
  #define KRD(G,j) do{ if(G){ kload2(kf,kp0+sl_next,j); SBAR(); } }while(0)
  #define STEP(C0,C1,P0,P1,t,GK,GV,GL) do{ SBAR(); \
    const lds_cptr vp_=vp0+sl_prev; \
    VRD(0); SBAR(); float sacc=(P0[0]+P0[1]); \
    GAPA(C0=__builtin_amdgcn_mfma_f32_32x32x16_bf16(kf[0],qr[0],negm,0,0,0), P0[2],P0[3],P0[4],P0[5],     pw0[0]=PKW(P0,0), pw0[1]=PKW(P0,2), pw0); \
    VRD(4); SBAR(); GAPA(C1=__builtin_amdgcn_mfma_f32_32x32x16_bf16(kf[1],qr[0],negm,0,0,0), P0[6],P0[7],P0[8],P0[9],     pw0[2]=PKW(P0,4), pw0[3]=PKW(P0,6), pw0); \
    VRD(1); SBAR(); GAPA(C0=__builtin_amdgcn_mfma_f32_32x32x16_bf16(kf[2],qr[1],C0,0,0,0),   P0[10],P0[11],P0[12],P0[13], pw1[0]=PKW(P0,8), pw1[1]=PKW(P0,10), pw1); \
    VRD(5); SBAR(); GAPA(C1=__builtin_amdgcn_mfma_f32_32x32x16_bf16(kf[3],qr[1],C1,0,0,0),   P0[14],P0[15],P1[0],P1[1],   pw1[2]=PKW(P0,12),pw1[3]=PKW(P0,14), pw1); \
    VRD(2); SBAR(); GAPA(C0=__builtin_amdgcn_mfma_f32_32x32x16_bf16(kf[4],qr[2],C0,0,0,0),   P1[2],P1[3],P1[4],P1[5],     pw2[0]=PKW(P1,0), pw2[1]=PKW(P1,2), pw2); \
    VRD(6); SBAR(); GAPA(C1=__builtin_amdgcn_mfma_f32_32x32x16_bf16(kf[5],qr[2],C1,0,0,0),   P1[6],P1[7],P1[8],P1[9],     pw2[2]=PKW(P1,4), pw2[3]=PKW(P1,6), pw2); \
    VRD(3); SBAR(); GAPA(C0=__builtin_amdgcn_mfma_f32_32x32x16_bf16(kf[6],qr[3],C0,0,0,0),   P1[10],P1[11],P1[12],P1[13], pw3[0]=PKW(P1,8), pw3[1]=PKW(P1,10), pw3); \
    VRD(7); SBAR(); GAPA(C1=__builtin_amdgcn_mfma_f32_32x32x16_bf16(kf[7],qr[3],C1,0,0,0),   P1[14],P1[15],0.f,0.f,       pw3[2]=PKW(P1,12),pw3[3]=PKW(P1,14), pw3); \
    l_reg+=sacc; \
    if(GK){DMA_K((t)+3,sl_cur);} if(GV){DMA_V((t)+1,sl_next);} \
    KBIAS(C0,C1,t); CMASK(C0,C1,t); \
    { float a=MX3(C0[0],C0[1],C1[0]),b=MX3(C0[2],C0[3],C1[1]); a=MX3(a,C1[2],C1[3]); \
      _Pragma("unroll") for(int r=4;r<16;r+=4){a=MX3(a,C0[r],C0[r+1]);b=MX3(b,C0[r+2],C0[r+3]);a=MX3(a,C1[r],C1[r+1]);b=MX3(b,C1[r+2],C1[r+3]);} \
      float rm=__builtin_fmaxf(a,b); { auto rr=__builtin_amdgcn_permlane32_swap(__float_as_uint(rm),__float_as_uint(rm),false,false); rm=__builtin_fmaxf(__uint_as_float(rr[0]),__uint_as_float(rr[1])); } \
      resc=false; \
      if(__builtin_expect(__any(rm>(float)THRL),0)){ const float dl=__builtin_fmaxf(rm,0.f); mhat+=dl; \
        _Pragma("unroll") for(int r=0;r<16;++r){C0[r]-=dl;C1[r]-=dl;} \
        const float f=__builtin_amdgcn_exp2f(-dl); l_reg*=f; if(hi==0)wsf[r32]=f; resc=true; } } \
    SBAR(); \
    GAPB(o[0]=__builtin_amdgcn_mfma_f32_32x32x16_bf16(PAF(0),VFR(0),o[0],0,0,0), C0,0); \
    GAPB(o[1]=__builtin_amdgcn_mfma_f32_32x32x16_bf16(PAF(0),VFR(4),o[1],0,0,0), C0,4); \
    KRD(GL,0); GAPB(o[0]=__builtin_amdgcn_mfma_f32_32x32x16_bf16(PAF(1),VFR(1),o[0],0,0,0), C0,8); \
    KRD(GL,1); GAPB(o[1]=__builtin_amdgcn_mfma_f32_32x32x16_bf16(PAF(1),VFR(5),o[1],0,0,0), C0,12); \
    KRD(GL,2); GAPB(o[0]=__builtin_amdgcn_mfma_f32_32x32x16_bf16(PAF(2),VFR(2),o[0],0,0,0), C1,0); \
    KRD(GL,3); GAPB(o[1]=__builtin_amdgcn_mfma_f32_32x32x16_bf16(PAF(2),VFR(6),o[1],0,0,0), C1,4); \
    GAPB(o[0]=__builtin_amdgcn_mfma_f32_32x32x16_bf16(PAF(3),VFR(3),o[0],0,0,0), C1,8); \
    GAPB(o[1]=__builtin_amdgcn_mfma_f32_32x32x16_bf16(PAF(3),VFR(7),o[1],0,0,0), C1,12); \
    }while(0)
  int t=1;
  #undef CMASK
  #define CMASK(P0,P1,t) do{}while(0)
  for(;t+5<NT;t+=2){
    STEP(pB0,pB1,pA0,pA1,t,true,true,true);     WAIT_BAR(2); RESC(); ROT();
    STEP(pA0,pA1,pB0,pB1,t+1,true,true,true);   WAIT_BAR(2); RESC(); ROT();
  }
  #undef CMASK
  #define CMASK(P0,P1,t) do{int jb_=(t)-(NT-4); if(jb_>=0)cmask(P0,P1,jb_,qrel,hi);}while(0)
  #define ENDW(tt) do{ if((tt)+3<NT){WAIT_BAR(2);} else if((tt)+2<NT){WAIT_BAR(1);} else {WAIT_BAR(0);} }while(0)
  for(;t+1<NT;t+=2){
    STEP(pB0,pB1,pA0,pA1,t,(t+3<NT),(t+1<NT),(t+1<NT));       ENDW(t);   RESC(); ROT();
    STEP(pA0,pA1,pB0,pB1,t+1,(t+4<NT),(t+2<NT),(t+2<NT));     ENDW(t+1); RESC(); ROT();
  }
  STEP(pB0,pB1,pA0,pA1,NT-1,false,false,false); RESC();
  { float sacc=pB0[0]+pB0[1]; _Pragma("unroll") for(int r=2;r<16;++r)sacc+=pB0[r]; _Pragma("unroll") for(int r=0;r<16;++r)sacc+=pB1[r]; l_reg+=sacc;
    pw0=(u32x4){PKW(pB0,0),PKW(pB0,2),PKW(pB0,4),PKW(pB0,6)};pw1=(u32x4){PKW(pB0,8),PKW(pB0,10),PKW(pB0,12),PKW(pB0,14)};pw2=(u32x4){PKW(pB1,0),PKW(pB1,2),PKW(pB1,4),PKW(pB1,6)};pw3=(u32x4){PKW(pB1,8),PKW(pB1,10),PKW(pB1,12),PKW(pB1,14)};
    SBAR(); pv(o,vb0+sl_cur,PAF(0),PAF(1),PAF(2),PAF(3)); }
  #undef PKW
  #undef PAF
  #undef VFR
  #undef PIN
  #undef MX3
  #undef GAPA
  #undef GAPB
  #undef EX
  #undef VRD
  #undef KRD
  #undef STEP
  #undef ENDW
  {auto rr=__builtin_amdgcn_permlane32_swap(__float_as_uint(l_reg),__float_as_uint(l_reg),false,false);l_reg=__uint_as_float(rr[0])+__uint_as_float(rr[1]);}
  if(hi==0)wsf[32+r32]=l_reg;asm volatile("s_waitcnt lgkmcnt(0)":::"memory");
  float rli[16];
  #pragma unroll
  for(int r=0;r<16;++r)rli[r]=__builtin_amdgcn_rcpf(wsf[32+crow(r,hi)]);
  bf16*Ow=O+(rowbase+q0+wid*QBLK)*DM+h*D;
  { bf16*stg=(bf16*)(shm+LDS_OST)+wid*2048;
    #pragma unroll
    for(int r=0;r<16;++r){const int orow=crow(r,hi);
      #pragma unroll
      for(int d0=0;d0<2;++d0)stg[orow*64+d0*32+r32]=__float2bfloat16(o[d0][r]*rli[r]);}
    asm volatile("s_waitcnt lgkmcnt(0)":::"memory");
    #pragma unroll
    for(int i=0;i<4;++i){const int row=i*8+(lane>>3),ch=lane&7; const u32x4 v=*(const u32x4*)(stg+row*64+ch*8); ATTN_STORE16(Ow+(long)row*DM+ch*8,v);} }
  asm volatile("s_waitcnt lgkmcnt(0)\n\ts_barrier":::"memory");
  #undef KBIAS
  #undef DMA_K
  #undef DMA_V
  #undef CMASK
  #undef START
  #undef RESC
  #undef ROT
}
template<bool WIN,int THRL> __device__ __forceinline__ void nsa_branch_pipe(const bf16*__restrict__ Kb,const bf16*__restrict__ Vb,const __attribute__((address_space(3))) int*tl,int NT,int qc,const bf16x8*qr,unsigned selbits,
    const __attribute__((address_space(3))) float*luth,char*shm,float&l_out,f32x16(&o)[2]){
  int tid=threadIdx.x; asm volatile("":"+v"(tid));
  const int lane=tid&63,r32=lane&31,hi=lane>>5; const int wid=__builtin_amdgcn_readfirstlane(tid>>6);
  const unsigned lds0=(unsigned)(uintptr_t)shm;
  float*wsf=(float*)(shm+LDS_WS)+wid*64;
  const unsigned koff=(unsigned)(lane*64+wid*8)*2u, voff=(unsigned)((16*(wid&3)+(lane>>2))*64+(wid>>2)*32+(lane&3)*8)*2u;
  #define TLJ(t) (__builtin_amdgcn_readfirstlane(tl[t])&63)
  const unsigned kdst=lds0+LDS_K+wid*1024, vdst=lds0+LDS_V+wid*1024;
  #define DMA_K(t,slot) glds16s((const char*)Kb+(size_t)TLJ(t)*8192,koff,(unsigned)__builtin_amdgcn_readfirstlane(kdst+(slot)))
  #define DMA_V(t,slot) glds16s((const char*)Vb+(size_t)TLJ(t)*8192,voff,(unsigned)__builtin_amdgcn_readfirstlane(vdst+(slot)))
  const int vb0=(int)(lds0+LDS_V)+((lane>>4)&1)*32+(lane&3)*8+(4*hi+((lane&15)>>2))*64;
  const char*Kbase=shm+LDS_K; bf16x8 kf[8];
  const lds_cptr shm3=(lds_cptr)shm; const lds_cptr kp0=shm3+LDS_K+hi*1024+r32*16; const lds_cptr vp0=shm3+LDS_V+((lane>>4)&1)*32+(lane&3)*8+(4*hi+((lane&15)>>2))*64;
  DMA_K(0,0);DMA_V(0,0);DMA_K(1,SLOTB);
  const int qi=(wid&1)*QBLK+r32;
  float mhat=0.f,l_reg=0.f;o[0]=f32x16{};o[1]=f32x16{};const f32x16 negm=f32x16{};
  unsigned amA=0xffffffffu,amB=0xffffffffu;
  #define NSAHOOK(C0,C1,t,AM) do{ const int e_=__builtin_amdgcn_readfirstlane(tl[t]); const int j_=e_&63, dq_=qc-j_; \
    { const float nm_=-mhat; _Pragma("unroll") for(int r_=0;r_<16;++r_){ C0[r_]+=nm_; C1[r_]+=nm_; } } \
    if(dq_<=2){ const volatile __attribute__((address_space(3))) float*lp_=luth+(64*dq_+qi+1-4*hi);     \
      _Pragma("unroll") for(int r_=0;r_<16;++r_){ const int ko_=(r_&3)+8*(r_>>2); C0[r_]+=lp_[63-ko_]; C1[r_]+=lp_[31-ko_]; } } \
    if(dq_==0){ _Pragma("unroll") for(int r_=0;r_<16;++r_){ const int kid_=4*hi+(r_&3)+8*(r_>>2); if(kid_>qi)C0[r_]=-1e30f; if(kid_+32>qi)C1[r_]=-1e30f; } } \
    if(WIN&&dq_==8){ _Pragma("unroll") for(int r_=0;r_<16;++r_){ const int kid_=4*hi+(r_&3)+8*(r_>>2); if(kid_<=qi)C0[r_]=-1e30f; if(kid_+32<=qi)C1[r_]=-1e30f; } } \
    AM=((e_>=0)&&(WIN||((selbits>>j_)&1u)))?0xffffffffu:0u; }while(0)
  bool resc=false;
  #define START(P0,P1) do{ const float rm=rowmax(P0,P1); resc=false; \
    { const float dl=__builtin_fmaxf(rm,-100.f); mhat=fadd_s(mhat,dl);     \
      _Pragma("unroll") for(int r=0;r<16;++r){P0[r]=fsub_s(P0[r],dl);P1[r]=fsub_s(P1[r],dl);} \
      } \
    _Pragma("unroll") for(int r=0;r<16;++r)P0[r]=__builtin_amdgcn_exp2f(P0[r]); }while(0)
  #define RESC() do{ if(resc){ asm volatile("s_waitcnt lgkmcnt(0)":::"memory"); \
      _Pragma("unroll") for(int d_=0;d_<2;++d_) _Pragma("unroll") for(int r=0;r<16;++r)o[d_][r]*=wsf[crow(r,hi)]; } }while(0)
  f32x16 pA0,pA1,pB0,pB1;
  int sl_prev=0,sl_cur=0,sl_next=SLOTB;
  #define ROT() do{sl_prev=sl_cur;sl_cur=sl_next;sl_next=(sl_next==(NSLOT-1)*SLOTB)?0:sl_next+SLOTB;}while(0)
  DMA_K(2,2*SLOTB);
  WAIT_BAR(3);
  qkt(pA0,pA1,Kbase,qr,negm,r32,hi);asm volatile("s_nop 15\n\ts_nop 7":"+v"(pA0),"+v"(pA1));NSAHOOK(pA0,pA1,0,amA);
  START(pA0,pA1);
  _Pragma("unroll") for(int r=0;r<16;++r)pA1[r]=__builtin_amdgcn_exp2f(pA1[r]);
  WAIT_BAR(0);
  DMA_K(3,0);DMA_V(1,SLOTB);
  ROT();
  kload8(kf,kp0+sl_cur);
  WAIT_BAR(2);
  s16x4 vlo[8],vhi[8]; u32x4 pw0,pw1,pw2,pw3;
  #define PKW(P,B) cvtpk_s(P[B],P[B+1])
  #define PAF(k) __builtin_bit_cast(bf16x8,pw##k)
  #define VFR(i) (bf16x8){vlo[i][0],vlo[i][1],vlo[i][2],vlo[i][3],vhi[i][0],vhi[i][1],vhi[i][2],vhi[i][3]}
  #define PIN(x) asm volatile("":"+v"(x))
  #define MX3(a,b,c) __builtin_fmaxf(__builtin_fmaxf((a),(b)),(c))
  #define GAPA(MF,A0,A1,A2,A3,W0,W1,PW) do{ MF; sacc+=A0; sacc+=A1; sacc+=A2; sacc+=A3; PIN(sacc); W0; W1; PIN(PW); SBAR(); }while(0)
  #define EX(v) __builtin_amdgcn_exp2f(v)
  #define GAPB(MF,X,B) do{ MF; X[B]=EX(X[B]); X[B+1]=EX(X[B+1]); X[B+2]=EX(X[B+2]); X[B+3]=EX(X[B+3]); PIN(X); SBAR(); }while(0)
  #define VRD(i) do{ vlo[i]=vtr(vp_+(((i)>>2)*4096+((i)&3)*1024)); vhi[i]=vtr(vp_+(((i)>>2)*4096+((i)&3)*1024+512)); }while(0)
  #define KRD(G,j) do{ if(G){ kload2(kf,kp0+sl_next,j); SBAR(); } }while(0)
  #define STEP(C0,C1,P0,P1,t,GK,GV,GL,AMC,AMP) do{ SBAR(); \
    const lds_cptr vp_=vp0+sl_prev; \
    VRD(0); SBAR(); float sacc=(P0[0]+P0[1]); \
    GAPA(C0=__builtin_amdgcn_mfma_f32_32x32x16_bf16(kf[0],qr[0],negm,0,0,0), P0[2],P0[3],P0[4],P0[5],     pw0[0]=PKW(P0,0)&AMP, pw0[1]=PKW(P0,2)&AMP, pw0); \
    VRD(4); SBAR(); GAPA(C1=__builtin_amdgcn_mfma_f32_32x32x16_bf16(kf[1],qr[0],negm,0,0,0), P0[6],P0[7],P0[8],P0[9],     pw0[2]=PKW(P0,4)&AMP, pw0[3]=PKW(P0,6)&AMP, pw0); \
    VRD(1); SBAR(); GAPA(C0=__builtin_amdgcn_mfma_f32_32x32x16_bf16(kf[2],qr[1],C0,0,0,0),   P0[10],P0[11],P0[12],P0[13], pw1[0]=PKW(P0,8)&AMP, pw1[1]=PKW(P0,10)&AMP, pw1); \
    VRD(5); SBAR(); GAPA(C1=__builtin_amdgcn_mfma_f32_32x32x16_bf16(kf[3],qr[1],C1,0,0,0),   P0[14],P0[15],P1[0],P1[1],   pw1[2]=PKW(P0,12)&AMP,pw1[3]=PKW(P0,14)&AMP, pw1); \
    VRD(2); SBAR(); GAPA(C0=__builtin_amdgcn_mfma_f32_32x32x16_bf16(kf[4],qr[2],C0,0,0,0),   P1[2],P1[3],P1[4],P1[5],     pw2[0]=PKW(P1,0)&AMP, pw2[1]=PKW(P1,2)&AMP, pw2); \
    VRD(6); SBAR(); GAPA(C1=__builtin_amdgcn_mfma_f32_32x32x16_bf16(kf[5],qr[2],C1,0,0,0),   P1[6],P1[7],P1[8],P1[9],     pw2[2]=PKW(P1,4)&AMP, pw2[3]=PKW(P1,6)&AMP, pw2); \
    VRD(3); SBAR(); GAPA(C0=__builtin_amdgcn_mfma_f32_32x32x16_bf16(kf[6],qr[3],C0,0,0,0),   P1[10],P1[11],P1[12],P1[13], pw3[0]=PKW(P1,8)&AMP, pw3[1]=PKW(P1,10)&AMP, pw3); \
    VRD(7); SBAR(); GAPA(C1=__builtin_amdgcn_mfma_f32_32x32x16_bf16(kf[7],qr[3],C1,0,0,0),   P1[14],P1[15],0.f,0.f,       pw3[2]=PKW(P1,12)&AMP,pw3[3]=PKW(P1,14)&AMP, pw3); \
    l_reg+=(AMP?sacc:0.f); \
    if(GK){DMA_K((t)+3,sl_cur);} if(GV){DMA_V((t)+1,sl_next);} \
    NSAHOOK(C0,C1,t,AMC); \
    { float a=MX3(C0[0],C0[1],C1[0]),b=MX3(C0[2],C0[3],C1[1]); a=MX3(a,C1[2],C1[3]); \
      _Pragma("unroll") for(int r=4;r<16;r+=4){a=MX3(a,C0[r],C0[r+1]);b=MX3(b,C0[r+2],C0[r+3]);a=MX3(a,C1[r],C1[r+1]);b=MX3(b,C1[r+2],C1[r+3]);} \
      float rm=__builtin_fmaxf(a,b); { auto rr=__builtin_amdgcn_permlane32_swap(__float_as_uint(rm),__float_as_uint(rm),false,false); rm=__builtin_fmaxf(__uint_as_float(rr[0]),__uint_as_float(rr[1])); } \
      rm=AMC?rm:-1e30f; resc=false; \
      if(__builtin_expect(__any(rm>(float)THRL),0)){ const float dl=__builtin_fmaxf(rm,0.f); mhat+=dl; \
        _Pragma("unroll") for(int r=0;r<16;++r){C0[r]-=dl;C1[r]-=dl;} \
        const float f=__builtin_amdgcn_exp2f(-dl); l_reg*=f; if(hi==0)wsf[r32]=f; resc=true; } } \
    SBAR(); \
    GAPB(o[0]=__builtin_amdgcn_mfma_f32_32x32x16_bf16(PAF(0),VFR(0),o[0],0,0,0), C0,0); \
    GAPB(o[1]=__builtin_amdgcn_mfma_f32_32x32x16_bf16(PAF(0),VFR(4),o[1],0,0,0), C0,4); \
    KRD(GL,0); GAPB(o[0]=__builtin_amdgcn_mfma_f32_32x32x16_bf16(PAF(1),VFR(1),o[0],0,0,0), C0,8); \
    KRD(GL,1); GAPB(o[1]=__builtin_amdgcn_mfma_f32_32x32x16_bf16(PAF(1),VFR(5),o[1],0,0,0), C0,12); \
    KRD(GL,2); GAPB(o[0]=__builtin_amdgcn_mfma_f32_32x32x16_bf16(PAF(2),VFR(2),o[0],0,0,0), C1,0); \
    KRD(GL,3); GAPB(o[1]=__builtin_amdgcn_mfma_f32_32x32x16_bf16(PAF(2),VFR(6),o[1],0,0,0), C1,4); \
    GAPB(o[0]=__builtin_amdgcn_mfma_f32_32x32x16_bf16(PAF(3),VFR(3),o[0],0,0,0), C1,8); \
    GAPB(o[1]=__builtin_amdgcn_mfma_f32_32x32x16_bf16(PAF(3),VFR(7),o[1],0,0,0), C1,12); \
    }while(0)
  int t=1;
  for(;t+5<NT;t+=2){
    STEP(pB0,pB1,pA0,pA1,t,true,true,true,amB,amA);     WAIT_BAR(2); RESC(); ROT();
    STEP(pA0,pA1,pB0,pB1,t+1,true,true,true,amA,amB);   WAIT_BAR(2); RESC(); ROT();
  }
  #define ENDW(tt) do{ if((tt)+3<NT){WAIT_BAR(2);} else if((tt)+2<NT){WAIT_BAR(1);} else {WAIT_BAR(0);} }while(0)
  for(;t+1<NT;t+=2){
    STEP(pB0,pB1,pA0,pA1,t,(t+3<NT),(t+1<NT),(t+1<NT),amB,amA);       ENDW(t);   RESC(); ROT();
    STEP(pA0,pA1,pB0,pB1,t+1,(t+4<NT),(t+2<NT),(t+2<NT),amA,amB);     ENDW(t+1); RESC(); ROT();
  }
  STEP(pB0,pB1,pA0,pA1,NT-1,false,false,false,amB,amA); RESC();
  { float sacc=pB0[0]+pB0[1]; _Pragma("unroll") for(int r=2;r<16;++r)sacc+=pB0[r]; _Pragma("unroll") for(int r=0;r<16;++r)sacc+=pB1[r]; l_reg+=(amB?sacc:0.f);
    pw0=(u32x4){PKW(pB0,0)&amB,PKW(pB0,2)&amB,PKW(pB0,4)&amB,PKW(pB0,6)&amB};pw1=(u32x4){PKW(pB0,8)&amB,PKW(pB0,10)&amB,PKW(pB0,12)&amB,PKW(pB0,14)&amB};pw2=(u32x4){PKW(pB1,0)&amB,PKW(pB1,2)&amB,PKW(pB1,4)&amB,PKW(pB1,6)&amB};pw3=(u32x4){PKW(pB1,8)&amB,PKW(pB1,10)&amB,PKW(pB1,12)&amB,PKW(pB1,14)&amB};
    SBAR(); pv(o,vb0+sl_cur,PAF(0),PAF(1),PAF(2),PAF(3)); }
  #undef PKW
  #undef PAF
  #undef VFR
  #undef PIN
  #undef MX3
  #undef GAPA
  #undef GAPB
  #undef EX
  #undef VRD
  #undef KRD
  #undef STEP
  #undef ENDW
  {auto rr=__builtin_amdgcn_permlane32_swap(__float_as_uint(l_reg),__float_as_uint(l_reg),false,false);l_out=__uint_as_float(rr[0])+__uint_as_float(rr[1]);}
  asm volatile("s_waitcnt lgkmcnt(0)\n\ts_barrier":::"memory");
  #undef NSAHOOK
  #undef TLJ
  #undef DMA_K
  #undef DMA_V
  #undef START
  #undef RESC
  #undef ROT
}
constexpr int ATTN_LDS_BYTES=LDS_BYTES;
struct AttnTensors { const bf16* Q; const bf16* K; const bf16* V; bf16* O; };
struct AttnUnit { int bh; int qb; };
#undef SBAR
#undef WAIT_BAR
}
namespace nsa {
using namespace attn_body;
typedef __attribute__((address_space(3))) char* lds_ptr;
typedef __attribute__((address_space(3))) float* lds_fptr;
typedef float f32x4_t __attribute__((ext_vector_type(4)));
constexpr int L_K = LDS_K, L_V = LDS_V, L_WS = LDS_WS, L_OST = LDS_WS + 2048;
constexpr int L_IMP = L_OST;
constexpr int L_IMPT = L_K + 2 * 8192;
constexpr int L_LUTPAD = L_OST + 65536, L_LUT = L_LUTPAD + 64;
constexpr int L_MASK = L_LUT + 4096 + 192;
constexpr int L_TL = L_MASK + 256;
constexpr int L_GATE = L_TL + 384;
constexpr int NSA_LDS_END = L_GATE + 8 * 3 * 64 * 4;
#define NSA_WAIT_BAR(N) asm volatile("s_waitcnt vmcnt(" #N ") lgkmcnt(0)\n\ts_barrier" ::: "memory")
#define NSA_SBAR() __builtin_amdgcn_sched_barrier(0)

__device__ __forceinline__ float rowmax_cv(const f32x16& p0, const f32x16& p1) {
    float a = __builtin_fmaxf(p0[0], p1[0]), b = __builtin_fmaxf(p0[1], p1[1]);
#pragma unroll
    for (int r = 2; r < 16; r += 2) { a = __builtin_fmaxf(a, __builtin_fmaxf(p0[r], p1[r])); b = __builtin_fmaxf(b, __builtin_fmaxf(p0[r + 1], p1[r + 1])); }
    const float m = __builtin_fmaxf(a, b);
    return __builtin_fmaxf(m, __shfl_xor(m, 32));
}
__device__ __forceinline__ bf16x8 pack8f(const f32x16& p, int base, unsigned amask) {
    u32x4 w; w[0] = cvtpk_s(p[base], p[base + 1]) & amask; w[1] = cvtpk_s(p[base + 2], p[base + 3]) & amask; w[2] = cvtpk_s(p[base + 4], p[base + 5]) & amask; w[3] = cvtpk_s(p[base + 6], p[base + 7]) & amask;
    return __builtin_bit_cast(bf16x8, w);
}
__device__ __forceinline__ void pv2(f32x16 (&o)[2], int vb, bf16x8 pa0, bf16x8 pa1, bf16x8 pa2, bf16x8 pa3) {
    s16x4 lo[2][4], hi[2][4];
#pragma unroll
    for (int d0 = 0; d0 < 2; ++d0)
#pragma unroll
        for (int ks = 0; ks < 4; ++ks) {
            asm volatile("ds_read_b64_tr_b16 %0,%1 offset:%c2" : "=&v"(lo[d0][ks]) : "v"(vb), "i"(d0 * 4096 + ks * 1024) : "memory");
            asm volatile("ds_read_b64_tr_b16 %0,%1 offset:%c2" : "=&v"(hi[d0][ks]) : "v"(vb), "i"(d0 * 4096 + ks * 1024 + 512) : "memory"); }
    asm volatile("s_waitcnt lgkmcnt(0)" ::: "memory"); NSA_SBAR();
#define NSA_PK(d, k) (bf16x8){lo[d][k][0], lo[d][k][1], lo[d][k][2], lo[d][k][3], hi[d][k][0], hi[d][k][1], hi[d][k][2], hi[d][k][3]}
    o[0] = __builtin_amdgcn_mfma_f32_32x32x16_bf16(pa0, NSA_PK(0, 0), o[0], 0, 0, 0); o[1] = __builtin_amdgcn_mfma_f32_32x32x16_bf16(pa0, NSA_PK(1, 0), o[1], 0, 0, 0);
    o[0] = __builtin_amdgcn_mfma_f32_32x32x16_bf16(pa1, NSA_PK(0, 1), o[0], 0, 0, 0); o[1] = __builtin_amdgcn_mfma_f32_32x32x16_bf16(pa1, NSA_PK(1, 1), o[1], 0, 0, 0);
    o[0] = __builtin_amdgcn_mfma_f32_32x32x16_bf16(pa2, NSA_PK(0, 2), o[0], 0, 0, 0); o[1] = __builtin_amdgcn_mfma_f32_32x32x16_bf16(pa2, NSA_PK(1, 2), o[1], 0, 0, 0);
    o[0] = __builtin_amdgcn_mfma_f32_32x32x16_bf16(pa3, NSA_PK(0, 3), o[0], 0, 0, 0); o[1] = __builtin_amdgcn_mfma_f32_32x32x16_bf16(pa3, NSA_PK(1, 3), o[1], 0, 0, 0);
#undef NSA_PK
}
__device__ __forceinline__ void stash_acc(lds_fptr stash, const f32x16 (&ob)[2], float f, lds_fptr wsf, int lane, int r32, int hi, bool first) {
    if (hi == 0) wsf[r32] = f;
    asm volatile("s_waitcnt lgkmcnt(0)" ::: "memory");
#pragma unroll
    for (int g = 0; g < 4; ++g) { const f32x4_t fv = *(const __attribute__((address_space(3))) f32x4_t*)(wsf + 8 * g + 4 * hi);
#pragma unroll
        for (int e = 0; e < 4; ++e) { const int r = 4 * g + e;
#pragma unroll
            for (int d0 = 0; d0 < 2; ++d0) { const lds_fptr p = stash + (d0 * 16 + r) * 64 + lane; float v = ob[d0][r] * fv[e]; if (!first) v += *p; *p = v; } } }
    asm volatile("s_waitcnt lgkmcnt(0)" ::: "memory");
}

__device__ __forceinline__ void nsa_unit(int b, int g, int qc, const bf16* Q, const bf16* KV, const bf16* KC2, size_t kvstride, size_t kc2stride, const float* gates, const float* lutg, bf16* O, char* shm) {
    int tid = threadIdx.x; asm volatile("" : "+v"(tid));
    const int lane = tid & 63, r32 = lane & 31, hi = lane >> 5; const int wid = __builtin_amdgcn_readfirstlane(tid >> 6);
    const int hr = wid >> 1, qh = wid & 1, hh = g * 4 + hr, bg = b * 4 + g;
    const int qi = 32 * qh + r32, t = 64 * qc + qi;
    const size_t tok = (size_t)b * SEQ + t;
    const lds_ptr shm3 = (lds_ptr)shm; const unsigned lds0 = (unsigned)(uintptr_t)shm;
    const lds_fptr lutN = (lds_fptr)(shm3 + L_LUT); const lds_fptr wsf = (lds_fptr)(shm3 + L_WS) + wid * 64;
    const bf16* Qw = Q + ((size_t)b * SEQ + 64 * qc + 32 * qh) * 1024 + hh * 64;
    bf16x8 qr[4];
#pragma unroll
    for (int d0 = 0; d0 < 4; ++d0) qr[d0] = *reinterpret_cast<const bf16x8*>(&Qw[(size_t)r32 * 1024 + d0 * 16 + hi * 8]);
    const lds_fptr gl = (lds_fptr)(shm3 + L_GATE) + wid * 192;
    { const float* gt = gates + tok * 48; const float g0 = gt[hh], g1 = gt[16 + hh], g2 = gt[32 + hh];
      const bf16* kcm = KC2 + (size_t)bg * 128 * 64; const bf16* vcm = KC2 + kc2stride + (size_t)bg * 128 * 64;
      const bf16* ksrc = kcm + (size_t)lane * 64 + wid * 8;
      const bf16* vsrc = vcm + (size_t)(16 * (wid & 3) + (lane >> 2)) * 64 + (wid >> 2) * 32 + (lane & 3) * 8;
      glds16(ksrc, (unsigned)__builtin_amdgcn_readfirstlane(lds0 + L_K + wid * 1024)); glds16(vsrc, (unsigned)__builtin_amdgcn_readfirstlane(lds0 + L_V + wid * 1024));
      glds16(ksrc + 4096, (unsigned)__builtin_amdgcn_readfirstlane(lds0 + L_K + 8192 + wid * 1024)); glds16(vsrc + 4096, (unsigned)__builtin_amdgcn_readfirstlane(lds0 + L_V + 8192 + wid * 1024));
      for (int e = tid; e < 1024; e += 512) { const int hd = e >> 8, rel = (e & 255) - 64; const float* lg = lutg + (g * 4 + hd) * 132; const float lv = lg[rel < 0 ? 0 : (rel > 128 ? 128 : rel)] - lg[128]; lutN[e] = rel < 0 ? 0.f : lv; }
      if (tid < 16) ((lds_fptr)(shm3 + L_LUTPAD))[tid] = 0.f;
      gl[lane] = g0; gl[64 + lane] = g1; gl[128 + lane] = g2; }
    NSA_WAIT_BAR(0);
    const lds_fptr stash = (lds_fptr)(shm3 + L_OST) + wid * 2048;
    f32x16 obc[2]; obc[0] = f32x16{}; obc[1] = f32x16{};
    {
        const f32x16 zero = f32x16{};
        f32x16 pc[2][2];
        qkt(pc[0][0], pc[0][1], shm + L_K, qr, zero, r32, hi);
        qkt(pc[1][0], pc[1][1], shm + L_K + 8192, qr, zero, r32, hi);
        const lds_fptr lh = lutN + hr * 256 + 64;
        float mx = -1e30f;
        {
            const volatile __attribute__((address_space(3))) float* lhv = lh;
            f32x16 lv[2][2];
#pragma unroll
            for (int T = 0; T < 2; ++T)
#pragma unroll
                for (int v = 0; v < 2; ++v)
#pragma unroll
                    for (int r = 0; r < 16; ++r) { const int c = 64 * T + 32 * v + 4 * hi + (r & 3) + 8 * (r >> 2); const int rel = t - 31 - 16 * c; lv[T][v][r] = lhv[rel < 0 ? 0 : (rel > 128 ? 128 : rel)]; }
#pragma unroll
            for (int T = 0; T < 2; ++T)
#pragma unroll
                for (int v = 0; v < 2; ++v)
#pragma unroll
                    for (int r = 0; r < 16; ++r) { const int c = 64 * T + 32 * v + 4 * hi + (r & 3) + 8 * (r >> 2); const int rel = t - 31 - 16 * c; const bool ok = (rel >= 0) && (c <= 126);
                        const float x = ok ? pc[T][v][r] + lv[T][v][r] : -1e30f; pc[T][v][r] = x; mx = __builtin_fmaxf(mx, x); }
        }
        mx = __builtin_fmaxf(mx, __shfl_xor(mx, 32));
        float ls = 0.f;
#pragma unroll
        for (int T = 0; T < 2; ++T)
#pragma unroll
            for (int v = 0; v < 2; ++v)
#pragma unroll
                for (int r = 0; r < 16; ++r) { const float x = pc[T][v][r]; const float p = (x > -1e29f) ? __builtin_amdgcn_exp2f(x - mx) : 0.f; pc[T][v][r] = p; ls += p; }
        ls += __shfl_xor(ls, 32);
        const float inv = ls > 0.f ? 1.0f / ls : 0.f;
#pragma unroll
        for (int T = 0; T < 2; ++T)
#pragma unroll
            for (int v = 0; v < 2; ++v)
#pragma unroll
                for (int r = 0; r < 16; ++r) pc[T][v][r] *= inv;
        {
            float Gv[16], Ev[16], Er[16];
#pragma unroll
            for (int n = 0; n < 16; ++n) { const int T = n >> 3, v = (n >> 2) & 1, gI = n & 3; const f32x16& pp = pc[T][v];
                Gv[n] = (pp[4 * gI] + pp[4 * gI + 1]) + (pp[4 * gI + 2] + pp[4 * gI + 3]); Ev[n] = pp[4 * gI + 3]; }
#pragma unroll
            for (int n = 0; n < 16; ++n) Er[n] = __shfl_xor(Ev[n], 32);
            const lds_fptr impw = (lds_fptr)(shm3 + L_IMP) + (hr * 64 + qi) * 32 + hi;
#pragma unroll
            for (int n = 0; n < 16; ++n) { const float prev = hi ? Er[n] : (n > 0 ? Er[n > 0 ? n - 1 : 0] : 0.f); impw[2 * n] = Gv[n] + prev; }
        }
        const int vb0 = (int)(lds0 + L_V) + ((lane >> 4) & 1) * 32 + (lane & 3) * 8 + (4 * hi + ((lane & 15) >> 2)) * 64;
#pragma unroll
        for (int T = 0; T < 2; ++T) {
            const bf16x8 pa0 = pack8f(pc[T][0], 0, 0xffffffffu), pa1 = pack8f(pc[T][0], 8, 0xffffffffu), pa2 = pack8f(pc[T][1], 0, 0xffffffffu), pa3 = pack8f(pc[T][1], 8, 0xffffffffu);
            NSA_SBAR();
            pv2(obc, vb0 + T * 8192, pa0, pa1, pa2, pa3);
        }
    }
    asm volatile("s_waitcnt lgkmcnt(0)\n\ts_barrier" ::: "memory");
    unsigned selm, uni;
    if (qc >= 16) {
        const lds_fptr ip = (lds_fptr)(shm3 + L_IMP); const lds_fptr it = (lds_fptr)(shm3 + L_IMPT);
        const int q = tid >> 3, jj = tid & 7;
        {
            f32x4_t s = *(const __attribute__((address_space(3))) f32x4_t*)(ip + (0 * 64 + q) * 32 + 4 * jj);
            s += *(const __attribute__((address_space(3))) f32x4_t*)(ip + (1 * 64 + q) * 32 + 4 * jj);
            s += *(const __attribute__((address_space(3))) f32x4_t*)(ip + (2 * 64 + q) * 32 + 4 * jj);
            s += *(const __attribute__((address_space(3))) f32x4_t*)(ip + (3 * 64 + q) * 32 + 4 * jj);
            *(__attribute__((address_space(3))) f32x4_t*)(it + q * 32 + 4 * jj) = s;
        }
        asm volatile("s_waitcnt lgkmcnt(0)\n\ts_barrier" ::: "memory");
        {
            const f32x4_t v = *(const __attribute__((address_space(3))) f32x4_t*)(it + q * 32 + 4 * jj);
            int rk0 = 0, rk1 = 0, rk2 = 0, rk3 = 0;
#pragma unroll
            for (int ii = 0; ii < 8; ++ii) { const f32x4_t w = *(const __attribute__((address_space(3))) f32x4_t*)(it + q * 32 + 4 * ii);
#pragma unroll
                for (int e = 0; e < 4; ++e) { const int i = 4 * ii + e; const bool in = (i >= 1) & (i <= qc - 2); const float vi = w[e];
                    rk0 += (int)(in & ((vi > v[0]) | ((vi == v[0]) & (i < 4 * jj + 0)))); rk1 += (int)(in & ((vi > v[1]) | ((vi == v[1]) & (i < 4 * jj + 1))));
                    rk2 += (int)(in & ((vi > v[2]) | ((vi == v[2]) & (i < 4 * jj + 2)))); rk3 += (int)(in & ((vi > v[3]) | ((vi == v[3]) & (i < 4 * jj + 3)))); } }
            unsigned bits = 0u;
            { const int j = 4 * jj + 0; const bool forced = (j == 0) || (j == qc) || (j == qc - 1), cand = (j >= 1) && (j <= qc - 2); if (forced || (cand && rk0 < 13)) bits |= 1u << j; }
            { const int j = 4 * jj + 1; const bool forced = (j == 0) || (j == qc) || (j == qc - 1), cand = (j >= 1) && (j <= qc - 2); if (forced || (cand && rk1 < 13)) bits |= 1u << j; }
            { const int j = 4 * jj + 2; const bool forced = (j == 0) || (j == qc) || (j == qc - 1), cand = (j >= 1) && (j <= qc - 2); if (forced || (cand && rk2 < 13)) bits |= 1u << j; }
            { const int j = 4 * jj + 3; const bool forced = (j == 0) || (j == qc) || (j == qc - 1), cand = (j >= 1) && (j <= qc - 2); if (forced || (cand && rk3 < 13)) bits |= 1u << j; }
            bits |= (unsigned)__shfl_xor((int)bits, 1); bits |= (unsigned)__shfl_xor((int)bits, 2); bits |= (unsigned)__shfl_xor((int)bits, 4);
            if (jj == 0) ((__attribute__((address_space(3))) unsigned*)(shm3 + L_MASK))[q] = bits;
        }
        asm volatile("s_waitcnt lgkmcnt(0)\n\ts_barrier" ::: "memory");
        const __attribute__((address_space(3))) unsigned* mk = (const __attribute__((address_space(3))) unsigned*)(shm3 + L_MASK);
        selm = mk[qi];
        unsigned u = mk[lane];
#pragma unroll
        for (int o = 1; o < 64; o <<= 1) u |= (unsigned)__shfl_xor((int)u, o);
        uni = (unsigned)__builtin_amdgcn_readfirstlane((int)u);
    } else { selm = (2u << qc) - 1u; uni = selm; }
    stash_acc(stash, obc, gl[lane], wsf, lane, r32, hi, true);
    const int j0w = qc >= 8 ? qc - 8 : 0; const unsigned wt = ((2u << qc) - 1u) & ~((1u << j0w) - 1u);
    const int ns = __builtin_popcount(uni), nw = __builtin_popcount(wt);
    const int NTs = ns < 4 ? 4 : ns + (ns & 1), NTw = nw < 4 ? 4 : nw + (nw & 1);
    { __attribute__((address_space(3))) int* tls = (__attribute__((address_space(3))) int*)(shm3 + L_TL); int dmk = (int)0x80000000u; asm volatile("" : "+v"(dmk));
      if (tid < 32) { if ((uni >> tid) & 1u) tls[__builtin_popcount(uni & ((1u << tid) - 1u))] = tid; if (tid >= ns && tid < NTs) tls[tid] = dmk; if (tid == 0 && NTs > 32) tls[32] = dmk, tls[33] = dmk; }
      else if (tid < 64) { const int i = tid - 32; if ((wt >> i) & 1u) tls[48 + __builtin_popcount(wt & ((1u << i) - 1u))] = i; if (i >= nw && i < NTw) tls[48 + i] = dmk; } }
    asm volatile("s_waitcnt lgkmcnt(0)\n\ts_barrier" ::: "memory");
    const lds_fptr luth = lutN + hr * 256;
    const bf16* kvb = KV + (size_t)bg * SEQ * 64;
    { f32x16 ob[2]; float lt;
      nsa_branch_pipe<false, 32>(kvb + 2 * kvstride, kvb + 3 * kvstride, (const __attribute__((address_space(3))) int*)(shm3 + L_TL), NTs, qc, qr, selm, luth, shm, lt, ob);
      const float gs = gl[64 + lane]; stash_acc(stash, ob, lt > 0.f ? gs * __builtin_amdgcn_rcpf(lt) : 0.f, wsf, lane, r32, hi, false); }
    { f32x16 ob[2]; float lt;
      nsa_branch_pipe<true, 32>(kvb + 4 * kvstride, kvb + 5 * kvstride, (const __attribute__((address_space(3))) int*)(shm3 + L_TL) + 48, NTw, qc, qr, 0xffffffffu, luth, shm, lt, ob);
      const float gw = gl[128 + lane]; stash_acc(stash, ob, lt > 0.f ? gw * __builtin_amdgcn_rcpf(lt) : 0.f, wsf, lane, r32, hi, false); }
    bf16* Ow = O + ((size_t)b * SEQ + 64 * qc + 32 * qh) * 1024 + hh * 64;
    { f32x16 ot[2];
#pragma unroll
      for (int d0 = 0; d0 < 2; ++d0)
#pragma unroll
          for (int r = 0; r < 16; ++r) ot[d0][r] = stash[(d0 * 16 + r) * 64 + lane];
      asm volatile("s_waitcnt lgkmcnt(0)" ::: "memory");
      bf16* stg = (bf16*)(shm + L_OST) + wid * 4096;
#pragma unroll
      for (int r = 0; r < 16; ++r) { const int orow = crow(r, hi);
#pragma unroll
          for (int d0 = 0; d0 < 2; ++d0) stg[orow * 64 + d0 * 32 + r32] = __float2bfloat16(ot[d0][r]); }
      asm volatile("s_waitcnt lgkmcnt(0)" ::: "memory");
#pragma unroll
      for (int i = 0; i < 4; ++i) { const int row = i * 8 + (lane >> 3), ch = lane & 7; const u32x4 v = *(const u32x4*)(stg + row * 64 + ch * 8); *(u32x4*)(Ow + (size_t)row * 1024 + ch * 8) = v; } }
    asm volatile("s_waitcnt lgkmcnt(0)\n\ts_barrier" ::: "memory");
}
#undef NSA_WAIT_BAR
#undef NSA_SBAR
}

namespace pg8 {
__device__ __forceinline__ float sigm(float x) { return __builtin_amdgcn_rcpf(1.0f + __builtin_amdgcn_exp2f(-1.4426950408889634f * x)); }
__device__ __forceinline__ u32x4 pack8(const f32x4 a, const f32x4 b) { u32x4 w; w.x = cvt_pk_bf16(a[0], a[1]); w.y = cvt_pk_bf16(a[2], a[3]); w.z = cvt_pk_bf16(b[0], b[1]); w.w = cvt_pk_bf16(b[2], b[3]); return w; }
__device__ __forceinline__ float gelu_tanh(float x) { const float t = 0.7978845608028654f * (x + 0.044715f * x * x * x); return x * sigm(2.0f * t); }

struct EpiSwiglu {
    static constexpr bool PERM = true, AFTER_DRAIN = false;
    bf16_t* O; int ldc;
    __device__ __forceinline__ void operator()(const f32x4 (&acc)[2][2][4][2], const Unit& u, int wr, int wc, int fr, int fq) const {
        const int row0 = u.pm * BM + wr * 64 + fr, col0 = u.pn * HALF + wc * 32 + 8 * fq;
#pragma unroll
        for (int ai = 0; ai < 2; ++ai)
#pragma unroll
            for (int m = 0; m < 4; ++m) {
                bf16_t* rowp = O + (size_t)(row0 + ai * HALF + m * 16) * ldc + col0;
                f32x4 h[2];
#pragma unroll
                for (int n = 0; n < 2; ++n) { const f32x4 gt = acc[ai][0][m][n], up = acc[ai][1][m][n];
#pragma unroll
                    for (int e = 0; e < 4; ++e) h[n][e] = gt[e] * sigm(gt[e]) * up[e]; }
                *(u32x4*)rowp = pack8(h[0], h[1]);
            }
    }
};
struct EpiPlain {
    static constexpr bool PERM = true, AFTER_DRAIN = false;
    bf16_t* O; int ldc;
    __device__ __forceinline__ void operator()(const f32x4 (&acc)[2][2][4][2], const Unit& u, int wr, int wc, int fr, int fq) const {
        const int row0 = u.pm * BM + wr * 64 + fr, col0 = u.pn * BM + wc * 32 + 8 * fq;
#pragma unroll
        for (int ai = 0; ai < 2; ++ai)
#pragma unroll
            for (int m = 0; m < 4; ++m) {
                bf16_t* rowp = O + (size_t)(row0 + ai * HALF + m * 16) * ldc + col0;
#pragma unroll
                for (int bj = 0; bj < 2; ++bj) *(u32x4*)(rowp + bj * HALF) = pack8(acc[ai][bj][m][0], acc[ai][bj][m][1]);
            }
    }
};
struct EpiNsaIn {
    static constexpr bool PERM = true, AFTER_DRAIN = false;
    bf16_t* Q; bf16_t* KV; float* gates; float qscale; size_t kvstride;
    __device__ __forceinline__ void operator()(const f32x4 (&acc)[2][2][4][2], const Unit& u, int wr, int wc, int fr, int fq) const {
        const int row0 = u.pm * BM + wr * 64 + fr, ct0 = wc * 32 + 8 * fq;
        if (u.pn < 4) {
#pragma unroll
            for (int ai = 0; ai < 2; ++ai)
#pragma unroll
                for (int m = 0; m < 4; ++m) { bf16_t* rowp = Q + (size_t)(row0 + ai * HALF + m * 16) * 1024 + u.pn * BM + ct0;
#pragma unroll
                    for (int bj = 0; bj < 2; ++bj) *(u32x4*)(rowp + bj * HALF) = pack8(acc[ai][bj][m][0] * qscale, acc[ai][bj][m][1] * qscale); }
        } else if (u.pn < 10) {
            bf16_t* base = KV + (size_t)(u.pn - 4) * kvstride;
#pragma unroll
            for (int ai = 0; ai < 2; ++ai)
#pragma unroll
                for (int m = 0; m < 4; ++m) { const int row = row0 + ai * HALF + m * 16, b = row >> 11, s = row & 2047;
#pragma unroll
                    for (int bj = 0; bj < 2; ++bj) { const int ct = bj * HALF + ct0, g = ct >> 6, d = ct & 63;
                        *(u32x4*)(base + ((size_t)((b * 4 + g) * 2048 + s)) * 64 + d) = pack8(acc[ai][bj][m][0], acc[ai][bj][m][1]); } }
        } else {
            if (ct0 < 48) {
#pragma unroll
                for (int ai = 0; ai < 2; ++ai)
#pragma unroll
                    for (int m = 0; m < 4; ++m) { float* gp = gates + (size_t)(row0 + ai * HALF + m * 16) * 48 + ct0;
#pragma unroll
                        for (int n = 0; n < 2; ++n) { const f32x4 v = acc[ai][0][m][n]; *(f32x4*)(gp + 4 * n) = (f32x4){sigm(v[0]), sigm(v[1]), sigm(v[2]), sigm(v[3])}; } }
            }
        }
    }
};
struct EpiFoxIn {
    static constexpr bool PERM = true, AFTER_DRAIN = false;
    bf16_t* QKV; float* flog; float qscale; size_t tstride;
    __device__ __forceinline__ void operator()(const f32x4 (&acc)[2][2][4][2], const Unit& u, int wr, int wc, int fr, int fq) const {
        const int row0 = u.pm * BM + wr * 64 + fr, ct0 = wc * 32 + 8 * fq;
        if (u.pn < 12) {
            const int t = u.pn >> 2; const float sc = (t == 0) ? qscale : 1.0f;
            bf16_t* base = QKV + (size_t)t * tstride + (u.pn & 3) * BM + ct0;
#pragma unroll
            for (int ai = 0; ai < 2; ++ai)
#pragma unroll
                for (int m = 0; m < 4; ++m) { bf16_t* rowp = base + (size_t)(row0 + ai * HALF + m * 16) * 1024;
#pragma unroll
                    for (int bj = 0; bj < 2; ++bj) *(u32x4*)(rowp + bj * HALF) = pack8(acc[ai][bj][m][0] * sc, acc[ai][bj][m][1] * sc); }
        } else {
            if (ct0 < 16) {
#pragma unroll
                for (int ai = 0; ai < 2; ++ai)
#pragma unroll
                    for (int m = 0; m < 4; ++m) { float* fp = flog + (size_t)(row0 + ai * HALF + m * 16) * 16 + ct0;
#pragma unroll
                        for (int n = 0; n < 2; ++n) *(f32x4*)(fp + 4 * n) = acc[ai][0][m][n]; }
            }
        }
    }
};
struct EpiCmp {
    static constexpr bool PERM = true, AFTER_DRAIN = false;
    bf16_t* Hc; const float* b1f;
    __device__ __forceinline__ void operator()(const f32x4 (&acc)[2][2][4][2], const Unit& u, int wr, int wc, int fr, int fq) const {
        const int row0 = u.pm * BM + wr * 64 + fr, ct0 = wc * 32 + 8 * fq;
        f32x4 bv[2][2];
#pragma unroll
        for (int bj = 0; bj < 2; ++bj)
#pragma unroll
            for (int n = 0; n < 2; ++n) bv[bj][n] = *(const f32x4*)(b1f + u.pn * BM + bj * HALF + ct0 + 4 * n);
#pragma unroll
        for (int ai = 0; ai < 2; ++ai)
#pragma unroll
            for (int m = 0; m < 4; ++m) { bf16_t* rowp = Hc + (size_t)(row0 + ai * HALF + m * 16) * 256 + ct0;
#pragma unroll
                for (int bj = 0; bj < 2; ++bj) { f32x4 v0 = acc[ai][bj][m][0] + bv[bj][0], v1 = acc[ai][bj][m][1] + bv[bj][1];
#pragma unroll
                    for (int e = 0; e < 4; ++e) { v0[e] = gelu_tanh(v0[e]); v1[e] = gelu_tanh(v1[e]); }
                    *(u32x4*)(rowp + bj * HALF) = pack8(v0, v1); } }
    }
};
struct CmpOrder {
    int G, c;
    __device__ __forceinline__ bool next(int i, Unit& u) const { const int L = i * G + c; if (L >= 32) return false; u.pm = L; u.pn = L >> 4; return true; }
    __device__ __forceinline__ void a_ready(const Unit&) const {}
    __device__ __forceinline__ void done(const Unit&) const {}
};
struct EpiSlab {
    static constexpr bool PERM = true, AFTER_DRAIN = false;
    float* S;
    __device__ __forceinline__ void operator()(const f32x4 (&acc)[2][2][4][2], const Unit& u, int wr, int wc, int fr, int fq) const {
        const int row0 = u.pm * BM + wr * 64 + fr, ct0 = wc * 32 + 8 * fq;
#pragma unroll
        for (int ai = 0; ai < 2; ++ai)
#pragma unroll
            for (int m = 0; m < 4; ++m) { float* rowp = S + (size_t)(row0 + ai * HALF + m * 16) * 256 + ct0;
#pragma unroll
                for (int bj = 0; bj < 2; ++bj)
#pragma unroll
                    for (int n = 0; n < 2; ++n) *(f32x4*)(rowp + bj * HALF + 4 * n) = acc[ai][bj][m][n]; }
    }
};
struct OneUnit {
    int pm, pn;
    __device__ __forceinline__ bool next(int i, Unit& u) const { if (i != 0) return false; u.pm = pm; u.pn = pn; return true; }
    __device__ __forceinline__ void a_ready(const Unit&) const {}
    __device__ __forceinline__ void done(const Unit&) const {}
};
}

constexpr int NWAVES = 8;
constexpr int BATCH = 8, SEQ = 2048, D = 1024, H = 16, HD = 64, FF = 2816, NGU = 2 * FF;
constexpr int M = BATCH * SEQ;
constexpr int NSA_IN = 2608, NSA_IN_PAD = 2816, FOX_IN = 3088, FOX_IN_PAD = 3328;
constexpr float RMS_EPS = 1e-6f;
constexpr float LOG2E = 1.4426950408889634f;
constexpr float QSCALE = 0.125f * LOG2E;
#ifndef MK_PER_PHASE
#define MK_PER_PHASE 0
#endif
#ifndef FOX_NAIVE
#define FOX_NAIVE 0
#endif
#ifndef NSA_NAIVE
#define NSA_NAIVE 0
#endif
constexpr int N_PHASES = 47 - (FOX_NAIVE ? 0 : 2);

constexpr size_t MiB = 1u << 20;
constexpr size_t WS_CTL = 0, CTL_ZERO_BYTES = 1 * MiB;
constexpr size_t WS_LUT = 1 * MiB;
constexpr size_t WS_B1F = 1 * MiB + 16384;
constexpr size_t WS_W2T = 1 * MiB + 32768;
constexpr size_t WS_CUM = 2 * MiB;
constexpr size_t WS_FLOG = 3 * MiB;
constexpr size_t WS_GATES = 4 * MiB;
constexpr size_t WS_WGU = 8 * MiB;
constexpr size_t WS_WD = 96 * MiB;
constexpr size_t WS_WNIN = 140 * MiB;
constexpr size_t WS_WNOUT = 151 * MiB;
constexpr size_t WS_WFIN = 155 * MiB;
constexpr size_t WS_WFOUT = 168 * MiB;
constexpr size_t WS_W1T = 172 * MiB;
constexpr size_t WS_U = 176 * MiB;
constexpr size_t WS_Y = 208 * MiB;
constexpr size_t WS_O = 240 * MiB;
constexpr size_t WS_R1 = 272 * MiB;
constexpr size_t WS_END = 368 * MiB;
constexpr size_t R1_KV = 32 * MiB, KV_STRIDE_E = (size_t)32 * 2048 * 64  , R1_HC = 80 * MiB, R1_KC2 = 84 * MiB, KC2_STRIDE_E = (size_t)32 * 128 * 64;
constexpr int CW_BAR = 4096;

constexpr int RING_OFF = 0, RING_BYTES = 131072;
constexpr int LDSCTL_OFF = 139264, MISC_OFF = LDSCTL_OFF + 320;
constexpr int LDS_BYTES = 147456;

#define GAS __attribute__((address_space(1)))
#define LAS __attribute__((address_space(3)))
typedef unsigned short bf16;
typedef unsigned v4u __attribute__((ext_vector_type(4)));
typedef float f32x4 __attribute__((ext_vector_type(4)));
typedef GAS unsigned gu32;
#define RLX_AGENT __ATOMIC_RELAXED, __HIP_MEMORY_SCOPE_AGENT
#define LDS_WAIT() asm volatile("s_waitcnt lgkmcnt(0)" ::: "memory")
__device__ __forceinline__ unsigned f2bf(float f) { unsigned u = __builtin_bit_cast(unsigned, f); return (u + 0x7fffu + ((u >> 16) & 1u)) >> 16; }
__device__ __forceinline__ unsigned pk2(float lo, float hi) { return f2bf(lo) | (f2bf(hi) << 16); }
__device__ __forceinline__ float bf_lo(unsigned u) { return __builtin_bit_cast(float, u << 16); }
__device__ __forceinline__ float bf_hi(unsigned u) { return __builtin_bit_cast(float, u & 0xffff0000u); }
__device__ __forceinline__ float bf2f(bf16 h) { return __builtin_bit_cast(float, (unsigned)h << 16); }
#define DPP_F(v, ctrl) __builtin_bit_cast(float, __builtin_amdgcn_update_dpp(0, __builtin_bit_cast(int, (v)), (ctrl), 0xF, 0xF, true))
__device__ __forceinline__ float sum8(float v) { v += DPP_F(v, 0xB1); v += DPP_F(v, 0x4E); v += DPP_F(v, 0x141); return v; }
__device__ __forceinline__ float lane_f(float v, int l) { return __builtin_bit_cast(float, __builtin_amdgcn_readlane(__builtin_bit_cast(int, v), l)); }
__device__ __forceinline__ float wave_sum(float v) {
    v = sum8(v); v += DPP_F(v, 0x140);
    return (lane_f(v, 0) + lane_f(v, 16)) + (lane_f(v, 32) + lane_f(v, 48));
}
__device__ __forceinline__ float wave_max(float v) {
    v = fmaxf(v, DPP_F(v, 0xB1)); v = fmaxf(v, DPP_F(v, 0x4E)); v = fmaxf(v, DPP_F(v, 0x141)); v = fmaxf(v, DPP_F(v, 0x140));
    return fmaxf(fmaxf(lane_f(v, 0), lane_f(v, 16)), fmaxf(lane_f(v, 32), lane_f(v, 48)));
}
__device__ __forceinline__ float ex2(float x) { return __builtin_amdgcn_exp2f(x); }

#define XB_TMO      128
#define XB_XCNT(j)  (256  + 64 * (j))
#define XB_XSUB(j)  (1280 + 64 * (j))
#define XB_XGEN(j)  (2304 + 64 * (j))
#define XB_TOP      3328
#define XB_TOPGEN   3392
#define XCD_BAR_WORDS 3456
#define XB_SPIN_CAP (1u << 18)

__device__ __forceinline__ unsigned xb_ld(unsigned* p)              { return __hip_atomic_load(p, __ATOMIC_RELAXED, __HIP_MEMORY_SCOPE_AGENT); }
__device__ __forceinline__ unsigned xb_add(unsigned* p, unsigned v) { return __hip_atomic_fetch_add(p, v, __ATOMIC_RELAXED, __HIP_MEMORY_SCOPE_AGENT); }
__device__ __forceinline__ unsigned xb_xcc_id() { return (unsigned)__builtin_amdgcn_s_getreg((3 << 11) | 20) & 0xFu; }
#define XB_SPIN(cond, bar) do { unsigned _sp = 0; while (cond) { __builtin_amdgcn_s_sleep(1); \
    if ((++_sp & 255u) == 0u) { if (xb_ld(&(bar)[XB_TMO])) break; if (_sp > XB_SPIN_CAP) { atomicAdd(&(bar)[XB_TMO], 1u); break; } } } } while (0)

struct XcdBarrier {
    unsigned* bar; unsigned x;
    volatile LAS unsigned* st;
};
__device__ __forceinline__ XcdBarrier xcd_barrier_post(unsigned* bar, volatile LAS unsigned* st) {
    XcdBarrier b; b.bar = bar; b.x = xb_xcc_id(); b.st = st;
    if (threadIdx.x == 0) (void)xb_add(&bar[XB_XCNT(b.x)], 1u);
    return b;
}
__device__ __forceinline__ void xcd_barrier_complete(unsigned* bar, unsigned x, unsigned& nloc, unsigned& nx) {
    const unsigned G = gridDim.x * gridDim.y * gridDim.z;
    unsigned sum, cnt, mine, sp = 0u;
    for (;;) {
        sum = 0u; cnt = 0u; mine = 0u;
#pragma unroll
        for (unsigned j = 0; j < 16; ++j) { const unsigned c = xb_ld(&bar[XB_XCNT(j)]); sum += c; cnt += (c > 0u) ? 1u : 0u; mine = (j == x) ? c : mine; }
        if (sum == G) break;
        __builtin_amdgcn_s_sleep(1);
        if ((++sp & 255u) == 0u) { if (xb_ld(&bar[XB_TMO])) break; if (sp > XB_SPIN_CAP) { atomicAdd(&bar[XB_TMO], 1u); break; } }
    }
    nloc = mine > 0u ? mine : 1u; nx = cnt > 0u ? cnt : 1u;
}
__device__ __forceinline__ void xcd_barrier(const XcdBarrier& b) {
    asm volatile("s_waitcnt vmcnt(0)" ::: "memory");
    __syncthreads();
    if (threadIdx.x == 0) {
        unsigned* bar = b.bar;
        __builtin_amdgcn_s_waitcnt(0);
        unsigned nloc = b.st[0], nx = b.st[1];
        if (nloc == 0u) { xcd_barrier_complete(bar, b.x, nloc, nx); b.st[0] = nloc; b.st[1] = nx; }
        const unsigned old = xb_add(&bar[XB_XSUB(b.x)], 1u);
        const unsigned gen = old / nloc;
        if (old + 1u == (gen + 1u) * nloc) {
            __builtin_amdgcn_fence(__ATOMIC_RELEASE, "agent");
            asm volatile("s_waitcnt vmcnt(0)" ::: "memory");
            const unsigned og = xb_add(&bar[XB_TOP], 1u);
            const unsigned tg = og / nx;
            if (og + 1u == (tg + 1u) * nx) xb_add(&bar[XB_TOPGEN], 1u);
            else XB_SPIN(xb_ld(&bar[XB_TOPGEN]) == tg, bar);
            __builtin_amdgcn_fence(__ATOMIC_ACQUIRE, "agent");
            xb_add(&bar[XB_XGEN(b.x)], 1u);
            asm volatile("s_waitcnt vmcnt(0)" ::: "memory");
        } else {
            XB_SPIN(xb_ld(&bar[XB_XGEN(b.x)]) == gen, bar);
            __builtin_amdgcn_fence(__ATOMIC_ACQUIRE, "agent");
            asm volatile("s_waitcnt vmcnt(0)" ::: "memory");
        }
    }
    __syncthreads();
}

struct Ctx { LAS unsigned char* lds; int tid, lane, wave, vcu, G, gw, ngw, bx; };

__device__ __forceinline__ void transpose_item(const float* W, int K, int N, bf16* WT, int drow0, int kb, int n0, LAS float* scr, int lane) {
    const int k0 = 64 * kb; const int c4 = 4 * (lane & 7); const bool ok = (n0 + c4) < N;
    f32x4 v[8];
#pragma unroll
    for (int i = 0; i < 8; ++i) { const int kk = 8 * i + (lane >> 3); v[i] = ok ? *(const f32x4*)(W + (size_t)(k0 + kk) * N + n0 + c4) : (f32x4){0.f, 0.f, 0.f, 0.f}; }
#pragma unroll
    for (int i = 0; i < 8; ++i) { const int kk = 8 * i + (lane >> 3); LAS float* d = scr + kk * 33 + c4; d[0] = v[i][0]; d[1] = v[i][1]; d[2] = v[i][2]; d[3] = v[i][3]; }
    LDS_WAIT(); asm volatile("" ::: "memory");
    const int c = lane & 7;
#pragma unroll
    for (int j = 0; j < 4; ++j) { const int n = (lane >> 3) + 8 * j; const LAS float* s = scr + (8 * c) * 33 + n;
        v4u o; o.x = pk2(s[0 * 33], s[1 * 33]); o.y = pk2(s[2 * 33], s[3 * 33]); o.z = pk2(s[4 * 33], s[5 * 33]); o.w = pk2(s[6 * 33], s[7 * 33]);
        *(GAS v4u*)(WT + (size_t)(drow0 + n) * K + k0 + 8 * c) = o; }
    LDS_WAIT(); asm volatile("" ::: "memory");
}
__device__ __forceinline__ int t5_bucket(int n) {
    if (n < 16) return n;
    int b = 16;
    b += (n >= 19); b += (n >= 21); b += (n >= 24); b += (n >= 27); b += (n >= 31); b += (n >= 35); b += (n >= 40); b += (n >= 46);
    b += (n >= 52); b += (n >= 59); b += (n >= 67); b += (n >= 77); b += (n >= 87); b += (n >= 99); b += (n >= 113);
    return b;
}
struct In {
    const float *x, *norm_g, *w_gate, *w_up, *w_down, *rel_bias, *nsa_w_in, *nsa_pe, *nsa_w1, *nsa_b1, *nsa_w2, *nsa_w_out, *fox_w_in, *fox_b_f, *fox_w_out;
};
__device__ __forceinline__ void first_norm_row(const float* xrow, const float* g, bf16* urow, bf16* hrow, int lane) {
    const f32x4* xp = (const f32x4*)xrow; const f32x4* gp = (const f32x4*)g;
    f32x4 v[4] = {xp[2 * lane], xp[2 * lane + 1], xp[128 + 2 * lane], xp[128 + 2 * lane + 1]};
    float ss = 0.f;
#pragma unroll
    for (int i = 0; i < 4; ++i) ss += (v[i][0] * v[i][0] + v[i][1] * v[i][1]) + (v[i][2] * v[i][2] + v[i][3] * v[i][3]);
    const float r = 1.0f / sqrtf(wave_sum(ss) * (1.0f / D) + RMS_EPS);
    { v4u h0, h1; h0.x = pk2(v[0][0], v[0][1]); h0.y = pk2(v[0][2], v[0][3]); h0.z = pk2(v[1][0], v[1][1]); h0.w = pk2(v[1][2], v[1][3]);
      h1.x = pk2(v[2][0], v[2][1]); h1.y = pk2(v[2][2], v[2][3]); h1.z = pk2(v[3][0], v[3][1]); h1.w = pk2(v[3][2], v[3][3]);
      ((v4u*)hrow)[lane] = h0; ((v4u*)hrow)[64 + lane] = h1; }
    const f32x4 g4[4] = {gp[2 * lane], gp[2 * lane + 1], gp[128 + 2 * lane], gp[128 + 2 * lane + 1]};
#pragma unroll
    for (int i = 0; i < 4; ++i) v[i] = v[i] * r * g4[i];
    v4u o0, o1; o0.x = pk2(v[0][0], v[0][1]); o0.y = pk2(v[0][2], v[0][3]); o0.z = pk2(v[1][0], v[1][1]); o0.w = pk2(v[1][2], v[1][3]);
    o1.x = pk2(v[2][0], v[2][1]); o1.y = pk2(v[2][2], v[2][3]); o1.z = pk2(v[3][0], v[3][1]); o1.w = pk2(v[3][2], v[3][3]);
    ((v4u*)urow)[lane] = o0; ((v4u*)urow)[64 + lane] = o1;
}
namespace cv {
constexpr int I_G = 16 * 88, I_D = 44 * 32, I_FFN = 2 * I_G + I_D;
constexpr int I_NIN = 16 * 88, I_SQ = 16 * 32, I_FIN = 16 * 104, I_W1 = 32 * 8, I_W2 = 8;
constexpr int T0 = 8 * I_FFN, T1 = T0 + 2 * I_NIN, T2 = T1 + 2 * I_SQ, T3 = T2 + 2 * I_FIN, T4 = T3 + 2 * I_SQ, T5 = T4 + 4 * I_W1, T6 = T5 + 4 * I_W2;
}
__device__ __forceinline__ void convert_item(const In& I, unsigned char* ws, int it, LAS float* scr, int lane) {
    using namespace cv;
    bf16* Wgu = (bf16*)(ws + WS_WGU); bf16* Wd = (bf16*)(ws + WS_WD); bf16* Wnin = (bf16*)(ws + WS_WNIN); bf16* Wnout = (bf16*)(ws + WS_WNOUT);
    bf16* Wfin = (bf16*)(ws + WS_WFIN); bf16* Wfout = (bf16*)(ws + WS_WFOUT); bf16* W1t = (bf16*)(ws + WS_W1T); bf16* W2t = (bf16*)(ws + WS_W2T);
    int r = it;
    if (r < T0) { const int f = r / I_FFN; r -= f * I_FFN;
        if (r < 2 * I_G) { const int up = r >= I_G; r -= up * I_G; const int kb = r / 88, nb = r % 88;
            transpose_item((up ? I.w_up : I.w_gate) + (size_t)f * D * FF, D, FF, Wgu + (size_t)f * NGU * D, 256 * (nb >> 2) + 32 * (nb & 3) + 128 * up, kb, 32 * nb, scr, lane); }
        else { r -= 2 * I_G; const int kb = r / 32, nb = r % 32; transpose_item(I.w_down + (size_t)f * FF * D, FF, D, Wd + (size_t)f * D * FF, 32 * nb, kb, 32 * nb, scr, lane); }
        return; }
    r -= T0;
    if (r < 2 * I_NIN) { const int j = r / I_NIN; r -= j * I_NIN; const int kb = r / 88, nb = r % 88;
        transpose_item(I.nsa_w_in + (size_t)j * D * NSA_IN, D, NSA_IN, Wnin + (size_t)j * NSA_IN_PAD * D, 32 * nb, kb, 32 * nb, scr, lane); return; }
    r -= 2 * I_NIN;
    if (r < 2 * I_SQ) { const int j = r / I_SQ; r -= j * I_SQ; const int kb = r / 32, nb = r % 32;
        transpose_item(I.nsa_w_out + (size_t)j * D * D, D, D, Wnout + (size_t)j * D * D, 32 * nb, kb, 32 * nb, scr, lane); return; }
    r -= 2 * I_SQ;
    if (r < 2 * I_FIN) { const int j = r / I_FIN; r -= j * I_FIN; const int kb = r / 104, nb = r % 104;
        transpose_item(I.fox_w_in + (size_t)j * D * FOX_IN, D, FOX_IN, Wfin + (size_t)j * FOX_IN_PAD * D, 32 * nb, kb, 32 * nb, scr, lane); return; }
    r -= 2 * I_FIN;
    if (r < 2 * I_SQ) { const int j = r / I_SQ; r -= j * I_SQ; const int kb = r / 32, nb = r % 32;
        transpose_item(I.fox_w_out + (size_t)j * D * D, D, D, Wfout + (size_t)j * D * D, 32 * nb, kb, 32 * nb, scr, lane); return; }
    r -= 2 * I_SQ;
    if (r < 4 * I_W1) { const int jk = r / I_W1; r -= jk * I_W1; const int kb = r / 8, nb = r % 8;
        transpose_item(I.nsa_w1 + (size_t)jk * 2048 * 256, 2048, 256, W1t + (size_t)jk * 256 * 2048, 32 * nb, kb, 32 * nb, scr, lane); return; }
    r -= 4 * I_W1;
    { const int jk = r >> 3; r &= 7; const int kb = r >> 1, nb = r & 1;
        transpose_item(I.nsa_w2 + (size_t)jk * 256 * 64, 256, 64, W2t + (size_t)jk * 64 * 256, 32 * nb, kb, 32 * nb, scr, lane); }
}
__device__ __forceinline__ void convert_range(const In& I, unsigned char* ws, int start, int count, int widx, int nw, LAS float* scr, int lane) {
    for (int it = start + widx; it < start + count; it += nw) convert_item(I, ws, it, scr, lane);
}
__device__ __forceinline__ void convert_for_next(const In& I, unsigned char* ws, int s, int widx, int nw, LAS float* scr, int lane) {
    using namespace cv;
    if (s >= 7) return;
    if ((s & 1) == 0) { const int L = s >> 1, j = L >> 1;
        if ((L & 1) == 0) { convert_range(I, ws, T0 + j * I_NIN, I_NIN, widx, nw, scr, lane); convert_range(I, ws, T1 + j * I_SQ, I_SQ, widx, nw, scr, lane);
                            convert_range(I, ws, T4 + j * 2 * I_W1, 2 * I_W1, widx, nw, scr, lane); convert_range(I, ws, T5 + j * 2 * I_W2, 2 * I_W2, widx, nw, scr, lane); }
        else { convert_range(I, ws, T2 + j * I_FIN, I_FIN, widx, nw, scr, lane); convert_range(I, ws, T3 + j * I_SQ, I_SQ, widx, nw, scr, lane); } }
    convert_range(I, ws, (s + 1) * I_FFN, I_FFN, widx, nw, scr, lane);
}
__device__ __forceinline__ void prologue(const Ctx& C, const In& I, unsigned char* ws, bf16* hs0) {
    LAS float* scr = (LAS float*)(C.lds + RING_OFF + C.wave * 16384);
    convert_range(I, ws, 0, (C.G == 256) ? cv::I_FFN : cv::T6, C.gw, C.ngw, scr, C.lane);
    float* lut = (float*)(ws + WS_LUT);
    for (int e = C.gw * 64 + C.lane; e < 16 * 132; e += C.ngw * 64) { const int h = e / 132, rel = e % 132; lut[e] = I.rel_bias[t5_bucket(rel > 128 ? 128 : rel) * 16 + h] * LOG2E; }
    float* b1f = (float*)(ws + WS_B1F);
    for (int w = C.ngw - 1 - C.gw; w < 256; w += C.ngw) {
        const int e0 = 4 * w, jk = e0 >> 8, col = (e0 & 255) + (C.lane & 3), ks = C.lane >> 2;
        const float* pe = I.nsa_pe + (size_t)jk * 2048 + 128 * ks; const float* w1 = I.nsa_w1 + (size_t)jk * 2048 * 256 + (size_t)(128 * ks) * 256 + col; float sacc = 0.f;
#pragma unroll 8
        for (int i = 0; i < 128; ++i) sacc += pe[i] * w1[(size_t)i * 256];
        sacc += __shfl_xor(sacc, 4); sacc += __shfl_xor(sacc, 8); sacc += __shfl_xor(sacc, 16); sacc += __shfl_xor(sacc, 32);
        if (C.lane < 4) b1f[e0 + C.lane] = sacc + I.nsa_b1[e0 + C.lane];
    }
    bf16* U = (bf16*)(ws + WS_U);
    if (C.G == 256) { const int mb = 2048 * (C.bx & 7) + 64 * (C.bx >> 3) + 8 * C.wave;
        for (int m = mb; m < mb + 8; ++m) first_norm_row(I.x + (size_t)m * D, I.norm_g, U + (size_t)m * D, hs0 + (size_t)m * D, C.lane); }
    else for (int m = C.gw; m < M; m += C.ngw) first_norm_row(I.x + (size_t)m * D, I.norm_g, U + (size_t)m * D, hs0 + (size_t)m * D, C.lane);
}

__device__ __forceinline__ void thin_pass(const Ctx& C, const bf16* hin, bf16* hout, bf16* u, float* out, const bf16* y, const float* gpost, float cmul, const float* gpre, bool last) {
    constexpr int RB = 4;
    const int lane = C.lane;
    const f32x4* gp = (const f32x4*)gpost; const f32x4 g4[4] = {gp[2 * lane], gp[2 * lane + 1], gp[128 + 2 * lane], gp[128 + 2 * lane + 1]};
    const f32x4* qp = (const f32x4*)(last ? gpost : gpre); const f32x4 q4[4] = {qp[2 * lane], qp[2 * lane + 1], qp[128 + 2 * lane], qp[128 + 2 * lane + 1]};
    const bool xl = (C.G == 256);
    const int mstart = xl ? 2048 * (C.bx & 7) + 64 * (C.bx >> 3) + 8 * C.wave : C.gw * RB, mstep = xl ? RB : C.ngw * RB, mend = xl ? mstart + 8 : M;
    for (int m0 = mstart; m0 < mend; m0 += mstep) {
        v4u yr[RB][2], hr[RB][2];
#pragma unroll
        for (int b = 0; b < RB; ++b) { const v4u* yp = (const v4u*)(y + (size_t)(m0 + b) * D); const v4u* hp = (const v4u*)(hin + (size_t)(m0 + b) * D);
            yr[b][0] = yp[lane]; yr[b][1] = yp[64 + lane]; hr[b][0] = hp[lane]; hr[b][1] = hp[64 + lane]; }
#pragma unroll
        for (int b = 0; b < RB; ++b) {
            const int m = m0 + b; const v4u y0 = yr[b][0], y1 = yr[b][1], h0 = hr[b][0], h1 = hr[b][1];
            f32x4 yv[4], h[4];
            yv[0] = (f32x4){bf_lo(y0.x), bf_hi(y0.x), bf_lo(y0.y), bf_hi(y0.y)}; yv[1] = (f32x4){bf_lo(y0.z), bf_hi(y0.z), bf_lo(y0.w), bf_hi(y0.w)};
            yv[2] = (f32x4){bf_lo(y1.x), bf_hi(y1.x), bf_lo(y1.y), bf_hi(y1.y)}; yv[3] = (f32x4){bf_lo(y1.z), bf_hi(y1.z), bf_lo(y1.w), bf_hi(y1.w)};
            h[0] = (f32x4){bf_lo(h0.x), bf_hi(h0.x), bf_lo(h0.y), bf_hi(h0.y)}; h[1] = (f32x4){bf_lo(h0.z), bf_hi(h0.z), bf_lo(h0.w), bf_hi(h0.w)};
            h[2] = (f32x4){bf_lo(h1.x), bf_hi(h1.x), bf_lo(h1.y), bf_hi(h1.y)}; h[3] = (f32x4){bf_lo(h1.z), bf_hi(h1.z), bf_lo(h1.w), bf_hi(h1.w)};
            float ss = 0.f;
#pragma unroll
            for (int i = 0; i < 4; ++i) ss += (yv[i][0] * yv[i][0] + yv[i][1] * yv[i][1]) + (yv[i][2] * yv[i][2] + yv[i][3] * yv[i][3]);
            const float ry = cmul / sqrtf(wave_sum(ss) * (1.0f / D) + RMS_EPS);
#pragma unroll
            for (int i = 0; i < 4; ++i) h[i] = h[i] + yv[i] * ry * g4[i];
            if (last) { f32x4* op = (f32x4*)(out + (size_t)m * D); op[2 * lane] = h[0]; op[2 * lane + 1] = h[1]; op[128 + 2 * lane] = h[2]; op[128 + 2 * lane + 1] = h[3]; }
            else {
                float s2 = 0.f;
#pragma unroll
                for (int i = 0; i < 4; ++i) s2 += (h[i][0] * h[i][0] + h[i][1] * h[i][1]) + (h[i][2] * h[i][2] + h[i][3] * h[i][3]);
                const float rh = 1.0f / sqrtf(wave_sum(s2) * (1.0f / D) + RMS_EPS);
                v4u o0, o1; o0.x = pk2(h[0][0], h[0][1]); o0.y = pk2(h[0][2], h[0][3]); o0.z = pk2(h[1][0], h[1][1]); o0.w = pk2(h[1][2], h[1][3]);
                o1.x = pk2(h[2][0], h[2][1]); o1.y = pk2(h[2][2], h[2][3]); o1.z = pk2(h[3][0], h[3][1]); o1.w = pk2(h[3][2], h[3][3]);
                v4u* hp = (v4u*)(hout + (size_t)m * D); hp[lane] = o0; hp[64 + lane] = o1;
#pragma unroll
                for (int i = 0; i < 4; ++i) h[i] = h[i] * rh * q4[i];
                o0.x = pk2(h[0][0], h[0][1]); o0.y = pk2(h[0][2], h[0][3]); o0.z = pk2(h[1][0], h[1][1]); o0.w = pk2(h[1][2], h[1][3]);
                o1.x = pk2(h[2][0], h[2][1]); o1.y = pk2(h[2][2], h[2][3]); o1.z = pk2(h[3][0], h[3][1]); o1.w = pk2(h[3][2], h[3][3]);
                v4u* up = (v4u*)(u + (size_t)m * D); up[lane] = o0; up[64 + lane] = o1;
            }
        }
    }
}

__device__ __forceinline__ void load_row64(const bf16* p, v4u (&r)[8]) { const v4u* q = (const v4u*)p;
#pragma unroll
    for (int i = 0; i < 8; ++i) r[i] = q[i]; }
__device__ __forceinline__ float dot64(const v4u (&a)[8], const v4u (&b)[8]) {
    float s0 = 0.f, s1 = 0.f;
#pragma unroll
    for (int i = 0; i < 8; ++i) {
        s0 += bf_lo(a[i].x) * bf_lo(b[i].x); s1 += bf_hi(a[i].x) * bf_hi(b[i].x);
        s0 += bf_lo(a[i].y) * bf_lo(b[i].y); s1 += bf_hi(a[i].y) * bf_hi(b[i].y);
        s0 += bf_lo(a[i].z) * bf_lo(b[i].z); s1 += bf_hi(a[i].z) * bf_hi(b[i].z);
        s0 += bf_lo(a[i].w) * bf_lo(b[i].w); s1 += bf_hi(a[i].w) * bf_hi(b[i].w);
    }
    return s0 + s1;
}
__device__ __forceinline__ int clampi(int v, int lo, int hi) { return v < lo ? lo : (v > hi ? hi : v); }

__device__ __forceinline__ void cmp2_naive(const Ctx& C, const bf16* Hc, const float* w2, bf16* KC2) {
    const int nth = C.ngw * 64;
    for (int e = C.gw * 64 + C.lane; e < 2 * 4096 * 64; e += nth) {
        const int d = e & 63, m = (e >> 6) & 4095, kv = e >> 18;
        float s = 0.f;
        if ((m & 127) != 127) { const bf16* hr = Hc + (size_t)(kv * 4096 + m) * 256; const float* w = w2 + (size_t)kv * 256 * 64 + d;
            for (int k = 0; k < 256; ++k) s += bf2f(hr[k]) * w[(size_t)k * 64]; }
        KC2[(size_t)kv * KC2_STRIDE_E + (size_t)m * 64 + d] = (bf16)f2bf(s);
    }
}

__device__ __forceinline__ void nsa_naive_token(int b, int g, int t, const bf16* Q, const bf16* KV, const bf16* KC2, const float* gates, const float* lut, bf16* O, int lane) {
    const int bg = b * 4 + g, cur = t >> 6;
    const size_t tok = (size_t)b * SEQ + t;
    const bf16* ks = KV + 2 * KV_STRIDE_E + (size_t)bg * SEQ * 64; const bf16* vs = KV + 3 * KV_STRIDE_E + (size_t)bg * SEQ * 64;
    const bf16* kw = KV + 4 * KV_STRIDE_E + (size_t)bg * SEQ * 64; const bf16* vw = KV + 5 * KV_STRIDE_E + (size_t)bg * SEQ * 64;
    const bf16* kcm = KC2 + (size_t)bg * 128 * 64; const bf16* vcm = KC2 + KC2_STRIDE_E + (size_t)bg * 128 * 64;
    float P0 = 0.f, P1 = 0.f; float oc[4];
    const int c0 = lane, c1 = lane + 64;
    const int rel0 = t - (16 * c0 + 31), rel1 = t - (16 * c1 + 31);
    const bool v0 = rel0 >= 0, v1 = (c1 <= 126) && (rel1 >= 0);
    const int cmax = (t >= 31) ? (((t - 31) >> 4) > 126 ? 126 : ((t - 31) >> 4)) : -1;
    {
        v4u k0[8], k1[8]; load_row64(kcm + (size_t)c0 * 64, k0); load_row64(kcm + (size_t)c1 * 64, k1);
#pragma unroll
        for (int r = 0; r < 4; ++r) {
            asm volatile("" ::: "memory");
            const int hh = g * 4 + r; v4u q[8]; load_row64(Q + tok * 1024 + hh * 64, q);
            const float* lh = lut + hh * 132;
            const float x0 = v0 ? dot64(q, k0) + lh[clampi(rel0, 0, 128)] : -1e30f;
            const float x1 = v1 ? dot64(q, k1) + lh[clampi(rel1, 0, 128)] : -1e30f;
            const float mx = wave_max(fmaxf(x0, x1));
            float p0 = v0 ? ex2(x0 - mx) : 0.f, p1 = v1 ? ex2(x1 - mx) : 0.f;
            const float sum = wave_sum(p0 + p1); const float inv = sum > 0.f ? 1.0f / sum : 0.f;
            p0 *= inv; p1 *= inv; P0 += p0; P1 += p1;
            float acc = 0.f;
#pragma unroll 4
            for (int c = 0; c <= cmax; ++c) { const float pc = __shfl(c < 64 ? p0 : p1, c & 63); acc += pc * bf2f(vcm[(size_t)c * 64 + lane]); }
            oc[r] = acc;
        }
    }
    unsigned mask;
    {
        const int j = lane & 31; float imp = 0.f;
#pragma unroll
        for (int dc = -1; dc <= 3; ++dc) { const int c = 4 * j + dc; const bool ok = (c >= 0) && (c <= 126); const int cc = ok ? c : 0;
            const float a0 = __shfl(P0, cc & 63), a1 = __shfl(P1, cc & 63); imp += ok ? (cc < 64 ? a0 : a1) : 0.f; }
        const bool forced = (j == 0) || (j == cur) || (j == cur - 1);
        const float sc = forced ? 1e9f : (j <= cur ? imp : -1e30f);
        int rank = 0;
#pragma unroll
        for (int i = 0; i < 32; ++i) { const float si = __shfl(sc, i); rank += ((si > sc) || (si == sc && i < j)) ? 1 : 0; }
        const unsigned long long bal = __ballot((rank < 16) && (lane < 32));
        mask = (unsigned)__builtin_amdgcn_readfirstlane((int)(unsigned)(bal & 0xffffffffull));
    }
#pragma unroll 1
    for (int r = 0; r < 4; ++r) {
        const int hh = g * 4 + r; v4u q[8]; load_row64(Q + tok * 1024 + hh * 64, q);
        const float* lh = lut + hh * 132;
        float osel, owin;
        {
            float mrun = -1e30f, l = 0.f, acc = 0.f;
            for (int jb = 0; jb <= cur; ++jb) {
                if (!((mask >> jb) & 1u)) continue;
                const int pos = jb * 64 + lane, rel = t - pos; const bool val = rel >= 0;
                v4u kr[8]; load_row64(ks + (size_t)pos * 64, kr);
                const float x = val ? dot64(q, kr) + lh[clampi(rel, 0, 128)] : -1e30f;
                const float mn = fmaxf(mrun, wave_max(x)), alpha = ex2(mrun - mn);
                const float p = val ? ex2(x - mn) : 0.f;
                l = l * alpha + wave_sum(p); acc *= alpha; mrun = mn;
#pragma unroll 8
                for (int k = 0; k < 64; ++k) acc += __shfl(p, k) * bf2f(vs[(size_t)(jb * 64 + k) * 64 + lane]);
            }
            osel = l > 0.f ? acc / l : 0.f;
        }
        {
            float mrun = -1e30f, l = 0.f, acc = 0.f;
            for (int i = 0; i < 8; ++i) {
                const int p0 = t - 511 + 64 * i; if (p0 + 63 < 0) continue;
                const int pos = p0 + lane, rel = t - pos; const bool val = pos >= 0;
                v4u kr[8]; load_row64(kw + (size_t)(val ? pos : 0) * 64, kr);
                const float x = val ? dot64(q, kr) + lh[clampi(rel, 0, 128)] : -1e30f;
                const float mn = fmaxf(mrun, wave_max(x)), alpha = ex2(mrun - mn);
                const float p = val ? ex2(x - mn) : 0.f;
                l = l * alpha + wave_sum(p); acc *= alpha; mrun = mn;
#pragma unroll 8
                for (int k = 0; k < 64; ++k) { const int pk = p0 + k; if (pk >= 0) acc += __shfl(p, k) * bf2f(vw[(size_t)pk * 64 + lane]); }
            }
            owin = l > 0.f ? acc / l : 0.f;
        }
        const float* gt = gates + tok * 48;
        const float o = gt[hh] * oc[r] + gt[16 + hh] * osel + gt[32 + hh] * owin;
        O[tok * 1024 + hh * 64 + lane] = (bf16)f2bf(o);
    }
}
__device__ __forceinline__ void nsa_naive_phase(const Ctx& C, const bf16* Q, const bf16* KV, const bf16* KC2, const float* gates, const float* lut, bf16* O) {
    for (int task = C.gw; task < BATCH * 4 * SEQ; task += C.ngw) { const int bg = task & 31, t = task >> 5; nsa_naive_token(bg >> 2, bg & 3, t, Q, KV, KC2, gates, lut, O, C.lane); }
}

__device__ __forceinline__ void fox_cum_phase(const Ctx& C, const float* flog, const float* bfp, float* cum) {
    for (int bh = C.gw; bh < BATCH * H; bh += C.ngw) {
        const int b = bh >> 4, h = bh & 15; const float bias = bfp[h]; float carry = 0.f;
        for (int i = 0; i < SEQ / 64; ++i) { const int s = 64 * i + C.lane;
            const float x = flog[((size_t)b * SEQ + s) * 16 + h] + bias;
            float v = (fminf(x, 0.f) - log1pf(expf(-fabsf(x)))) * LOG2E;
#pragma unroll
            for (int o = 1; o < 64; o <<= 1) { const float n = __shfl_up(v, o); if (C.lane >= o) v += n; }
            cum[(size_t)bh * SEQ + s] = carry + v;
            carry += __shfl(v, 63);
        }
    }
}
__device__ __forceinline__ void fox_naive_phase(const Ctx& C, const bf16* Q, const bf16* K, const bf16* V, const float* cum, bf16* O) {
    const int lane = C.lane;
    for (int task = C.gw; task < BATCH * H * SEQ; task += C.ngw) {
        const int bh = task & 127, t = task >> 7, b = bh >> 4, h = bh & 15;
        const size_t tok = (size_t)b * SEQ + t;
        v4u q[8]; load_row64(Q + tok * 1024 + h * 64, q);
        const float* cb = cum + (size_t)bh * SEQ; const float ct = cb[t];
        float mrun = -1e30f, l = 0.f, acc = 0.f;
        for (int i = 0; i <= (t >> 6); ++i) {
            const int pos = 64 * i + lane; const bool val = pos <= t; const int pc = val ? pos : t;
            v4u kr[8]; load_row64(K + ((size_t)b * SEQ + pc) * 1024 + h * 64, kr);
            const float x = val ? dot64(q, kr) + (ct - cb[pc]) : -1e30f;
            const float mn = fmaxf(mrun, wave_max(x)), alpha = ex2(mrun - mn);
            const float p = val ? ex2(x - mn) : 0.f;
            l = l * alpha + wave_sum(p); acc *= alpha; mrun = mn;
#pragma unroll 8
            for (int k = 0; k < 64; ++k) { const int pk = 64 * i + k; if (pk <= t) acc += __shfl(p, k) * bf2f(V[((size_t)b * SEQ + pk) * 1024 + h * 64 + lane]); }
        }
        O[tok * 1024 + h * 64 + lane] = (bf16)f2bf(acc / l);
    }
}

typedef short bf16x8_t __attribute__((ext_vector_type(8)));
__device__ __forceinline__ void cmp_tail_phase(const Ctx& C, const float* slabs, const float* b1f, const bf16* w2t, bf16* KC2) {
    LAS float* red = (LAS float*)(C.lds + RING_OFF);
    const int fr = C.lane & 15, fq = C.lane >> 4, tsel = C.wave >> 2, kq = C.wave & 3;
    for (int cu = C.vcu; cu < 256; cu += C.G) {
        const int tile = tsel * 256 + cu, row = tile * 16 + fr, kv = row >> 12;
        f32x4 acc[4];
#pragma unroll
        for (int nt = 0; nt < 4; ++nt) acc[nt] = (f32x4){0.f, 0.f, 0.f, 0.f};
#pragma unroll
        for (int kk = 0; kk < 2; ++kk) {
            const int k0 = 32 * (2 * kq + kk) + 8 * fq;
            f32x4 p0[8], p1[8];
#pragma unroll
            for (int kc = 0; kc < 8; ++kc) { const GAS f32x4* sp = (const GAS f32x4*)(slabs + ((size_t)kc * 8192 + row) * 256 + k0); p0[kc] = sp[0]; p1[kc] = sp[1]; }
            const GAS f32x4* bp = (const GAS f32x4*)(b1f + kv * 256 + k0); f32x4 s0 = bp[0], s1 = bp[1];
#pragma unroll
            for (int kc = 0; kc < 8; ++kc) { s0 += p0[kc]; s1 += p1[kc]; }
#pragma unroll
            for (int e = 0; e < 4; ++e) { s0[e] = pg8::gelu_tanh(s0[e]); s1[e] = pg8::gelu_tanh(s1[e]); }
            const pg8::u32x4 bw = pg8::pack8(s0, s1); const bf16x8_t bfrag = __builtin_bit_cast(bf16x8_t, bw);
            bf16x8_t afrag[4];
#pragma unroll
            for (int nt = 0; nt < 4; ++nt) afrag[nt] = *(const GAS bf16x8_t*)(w2t + ((size_t)kv * 64 + 16 * nt + fr) * 256 + k0);
#pragma unroll
            for (int nt = 0; nt < 4; ++nt) acc[nt] = __builtin_amdgcn_mfma_f32_16x16x32_bf16(afrag[nt], bfrag, acc[nt], 0, 0, 0);
        }
        LAS f32x4* rp = (LAS f32x4*)(red + (C.wave * 64 + C.lane) * 16);
#pragma unroll
        for (int nt = 0; nt < 4; ++nt) rp[nt] = acc[nt];
        __syncthreads();
        if (kq == 0) {
#pragma unroll
            for (int w = 1; w < 4; ++w) { const LAS f32x4* op = (const LAS f32x4*)(red + ((C.wave + w) * 64 + C.lane) * 16);
#pragma unroll
                for (int nt = 0; nt < 4; ++nt) acc[nt] += op[nt]; }
            const int m = row & 4095; const bool pad = (m & 127) == 127;
#pragma unroll
            for (int nt = 0; nt < 4; ++nt) { unsigned lo = pk2(acc[nt][0], acc[nt][1]), hi2 = pk2(acc[nt][2], acc[nt][3]); if (pad) { lo = 0u; hi2 = 0u; }
                *(unsigned long long*)(KC2 + (size_t)kv * KC2_STRIDE_E + (size_t)m * 64 + 16 * nt + 4 * fq) = (unsigned long long)lo | ((unsigned long long)hi2 << 32); }
        }
        __syncthreads();
    }
}

__device__ __forceinline__ void fox_flog_tasks(const Ctx& C, const bf16* U, const bf16* WfT, float* flog) {
    if (C.wave >= 4) return;
    const int fr = C.lane & 15, fq = C.lane >> 4;
    for (int task = C.vcu * 4 + C.wave; task < M / 16; task += C.G * 4) {
        const GAS bf16x8_t* ap = (const GAS bf16x8_t*)(U + (size_t)(task * 16 + fr) * D + 8 * fq); const GAS bf16x8_t* bp = (const GAS bf16x8_t*)(WfT + (size_t)fr * D + 8 * fq);
        f32x4 acc = (f32x4){0.f, 0.f, 0.f, 0.f};
#pragma unroll
        for (int kb = 0; kb < D / 32; kb += 16) {
            bf16x8_t a[16], b[16];
#pragma unroll
            for (int j = 0; j < 16; ++j) { a[j] = ap[4 * (kb + j)]; b[j] = bp[4 * (kb + j)]; }
#pragma unroll
            for (int j = 0; j < 16; ++j) acc = __builtin_amdgcn_mfma_f32_16x16x32_bf16(a[j], b[j], acc, 0, 0, 0);
        }
#pragma unroll
        for (int e = 0; e < 4; ++e) flog[(size_t)(task * 16 + 4 * fq + e) * 16 + fr] = acc[e];
    }
}

constexpr int FOX_CUM_OFF = 86016, FOX_WTOT_OFF = 94208, FOX_ROWQ_OFF = 95232;
static_assert(FOX_ROWQ_OFF + 2 * 2048 * 4 <= 139264, "FoX LDS map");
__device__ __forceinline__ void fox_fast_phase(const Ctx& C, char* ldsg, const bf16* Q, const bf16* K, const bf16* V, bf16* O, const float* flog, const float* bfp, bf16* Odummy) {
    LAS float* cumL = (LAS float*)(C.lds + FOX_CUM_OFF); LAS float* wtot = (LAS float*)(C.lds + FOX_WTOT_OFF);
    LAS float* rowq = (LAS float*)(C.lds + FOX_ROWQ_OFF); LAS float* rowd = rowq + SEQ;
    for (int cu = C.vcu; cu < 256; cu += C.G) {
        const int bh = cu >> 1, b = bh >> 4, h = bh & 15;
        int tid_ = C.tid; asm volatile("" : "+v"(tid_));
        const int lane_ = tid_ & 63, wave_ = __builtin_amdgcn_readfirstlane(tid_ >> 6);
#if defined(PROBE_FOXPRE)
#pragma unroll 1
        for (int prep_ = 0; prep_ < 1 + PROBE_FOXPRE; ++prep_) {
#endif
        {
            const int s0 = 4 * tid_; const float bias = bfp[h]; float a[4];
#pragma unroll
            for (int i = 0; i < 4; ++i) { const float x = flog[((size_t)b * SEQ + s0 + i) * 16 + h] + bias; a[i] = (fminf(x, 0.f) - log1pf(expf(-fabsf(x)))) * LOG2E; }
            a[1] += a[0]; a[2] += a[1]; a[3] += a[2];
            const float tot = a[3]; float v = tot;
#pragma unroll
            for (int o = 1; o < 64; o <<= 1) { const float n = __shfl_up(v, o); if (lane_ >= o) v += n; }
            if (lane_ == 63) wtot[wave_] = v;
            __syncthreads();
            float off = 0.f;
            for (int w = 0; w < wave_; ++w) off += wtot[w];
            const float ex = off + v - tot;
            *(LAS f32x4*)(cumL + s0) = (f32x4){ex + a[0], ex + a[1], ex + a[2], ex + a[3]};
            __syncthreads();
        }
        {
            float qm = 0.f, km = 0.f;
            const int sub = tid_ & 7, r8 = tid_ >> 3;
            const GAS v4u* Qg = (const GAS v4u*)(Q + ((size_t)b * SEQ) * 1024 + h * 64 + sub * 8); const GAS v4u* Kg = (const GAS v4u*)(K + ((size_t)b * SEQ) * 1024 + h * 64 + sub * 8);
            const int par = cu & 1;
#pragma unroll
            for (int hb = 0; hb < 2; ++hb) {
                v4u qa_[8], ka_[8];
#pragma unroll
                for (int j = 0; j < 8; ++j) { const int u = 2 * hb + (j >> 2), qbu = 2 * u + ((u >> 1) ^ par), row = 256 * qbu + 64 * (j & 3) + r8; qa_[j] = Qg[(size_t)row * 128]; ka_[j] = Kg[(size_t)row * 128]; }
#pragma unroll
                for (int j = 0; j < 8; ++j) { const int u = 2 * hb + (j >> 2), qbu = 2 * u + ((u >> 1) ^ par), row = 256 * qbu + 64 * (j & 3) + r8; const v4u a = qa_[j], c = ka_[j];
                    float sq = bf_lo(a.x) * bf_lo(a.x) + bf_hi(a.x) * bf_hi(a.x) + bf_lo(a.y) * bf_lo(a.y) + bf_hi(a.y) * bf_hi(a.y) + bf_lo(a.z) * bf_lo(a.z) + bf_hi(a.z) * bf_hi(a.z) + bf_lo(a.w) * bf_lo(a.w) + bf_hi(a.w) * bf_hi(a.w);
                    float sk = bf_lo(c.x) * bf_lo(c.x) + bf_hi(c.x) * bf_hi(c.x) + bf_lo(c.y) * bf_lo(c.y) + bf_hi(c.y) * bf_hi(c.y) + bf_lo(c.z) * bf_lo(c.z) + bf_hi(c.z) * bf_hi(c.z) + bf_lo(c.w) * bf_lo(c.w) + bf_hi(c.w) * bf_hi(c.w);
                    float dq = bf_lo(a.x) * bf_lo(c.x) + bf_hi(a.x) * bf_hi(c.x) + bf_lo(a.y) * bf_lo(c.y) + bf_hi(a.y) * bf_hi(c.y) + bf_lo(a.z) * bf_lo(c.z) + bf_hi(a.z) * bf_hi(c.z) + bf_lo(a.w) * bf_lo(c.w) + bf_hi(a.w) * bf_hi(c.w);
                    sq = sum8(sq); sk = sum8(sk); dq = sum8(dq);
                    qm = fmaxf(qm, sq); km = fmaxf(km, sk);
                    if (sub == 0) { rowq[row] = sq; rowd[row] = dq; } }
            }
            {
                v4u ka_[16];
#pragma unroll
                for (int j = 0; j < 16; ++j) { const int u = j >> 2, qbu = 2 * u + ((u >> 1) ^ par ^ 1), row = 256 * qbu + 64 * (j & 3) + r8; ka_[j] = Kg[(size_t)row * 128]; }
#pragma unroll
                for (int j = 0; j < 16; ++j) { const v4u c = ka_[j];
                    float sk = bf_lo(c.x) * bf_lo(c.x) + bf_hi(c.x) * bf_hi(c.x) + bf_lo(c.y) * bf_lo(c.y) + bf_hi(c.y) * bf_hi(c.y) + bf_lo(c.z) * bf_lo(c.z) + bf_hi(c.z) * bf_hi(c.z) + bf_lo(c.w) * bf_lo(c.w) + bf_hi(c.w) * bf_hi(c.w);
                    sk = sum8(sk); km = fmaxf(km, sk); }
            }
            qm = wave_max(qm); km = wave_max(km);
            if (lane_ == 0) { wtot[8 + wave_] = qm; wtot[16 + wave_] = km; }
            __syncthreads();
            float qa = 0.f, ka = 0.f;
#pragma unroll
            for (int w = 0; w < 8; ++w) { qa = fmaxf(qa, wtot[8 + w]); ka = fmaxf(ka, wtot[16 + w]); }
            const float Kmax = sqrtf(ka); if (tid_ == 0) wtot[48] = 0.02f * sqrtf(qa * ka) + 32.0f;
#pragma unroll
            for (int uu = 0; uu < 2; ++uu) { const int u = 2 * uu + (tid_ >> 8), qbu = 2 * u + ((u >> 1) ^ par), row = 256 * qbu + (tid_ & 255);
                const float t = wave_max(sqrtf(rowq[row]) * Kmax - rowd[row]); if (lane_ == 0) wtot[32 + 4 * u + (wave_ & 3)] = t; }
            __syncthreads();
        }
#if defined(PROBE_FOXPRE)
        }
#endif
#pragma unroll 1
        for (int i = 0; i < 4; ++i) {
            const int qb = (cu & 1) ? (i == 0 ? 6 : i == 1 ? 1 : i == 2 ? 4 : 3) : (i == 0 ? 7 : i == 1 ? 0 : i == 2 ? 5 : 2);
            const int uo = qb >> 1; const float Tskip = fmaxf(fmaxf(wtot[32 + 4 * uo], wtot[33 + 4 * uo]), fmaxf(wtot[34 + 4 * uo], wtot[35 + 4 * uo])) + wtot[48];
            int tskip = 0; { const float c0 = cumL[qb * 256]; for (int t = 0; t + 4 < 4 * qb + 4; ++t) { if (c0 - cumL[64 * t + 63] < -Tskip) tskip = t + 1; else break; } }
            tskip = __builtin_amdgcn_readfirstlane(tskip) & ~1;
#if defined(PROBE_FOXDIAG)
            attn_body::attn_unit<64>(b, h, qb, (const attn_body::bf16*)Q, (const attn_body::bf16*)K, (const attn_body::bf16*)V, (attn_body::bf16*)Odummy, ldsg + RING_OFF, cumL, (PROBE_FOXDIAG == 2 && qb >= 1) ? 4 * qb - 4 : 4 * qb);
#endif
#if defined(PROBE_FOX)
            attn_body::attn_unit<64, PROBE_FOX>(b, h, qb, (const attn_body::bf16*)Q, (const attn_body::bf16*)K, (const attn_body::bf16*)V, (attn_body::bf16*)Odummy, ldsg + RING_OFF, cumL, tskip);
#endif
            attn_body::attn_unit<64>(b, h, qb, (const attn_body::bf16*)Q, (const attn_body::bf16*)K, (const attn_body::bf16*)V, (attn_body::bf16*)O, ldsg + RING_OFF, cumL, tskip);
        }
        __syncthreads();
    }
}

__device__ __forceinline__ void nsa_fast_phase(const Ctx& C, char* ldsg, const bf16* Q, const bf16* KV, const bf16* KC2, const float* gates, const float* lutg, bf16* O) {
    static_assert(nsa::NSA_LDS_END <= LDSCTL_OFF, "NSA LDS map");
    for (int cu = C.vcu; cu < 256; cu += C.G) {
        const int bg = cu >> 3, s = cu & 7;
#pragma unroll 1
        for (int i = 0; i < 4; ++i) {
            const int qc = (i == 0) ? 31 - s : (i == 1) ? s : (i == 2) ? 16 + s : 15 - s;
            nsa::nsa_unit(bg >> 2, bg & 3, qc, (const attn_body::bf16*)Q, (const attn_body::bf16*)KV, (const attn_body::bf16*)KC2, KV_STRIDE_E, KC2_STRIDE_E, gates, lutg, (attn_body::bf16*)O, ldsg + RING_OFF);
        }
    }
}

struct Args { const float* in[15]; float* out; unsigned char* ws; int ph_lo, ph_hi; };
__device__ __forceinline__ Ctx make_ctx(unsigned char* lds) {
    Ctx C; int tid = threadIdx.x; asm volatile("" : "+v"(tid));
    C.lds = (LAS unsigned char*)lds; C.tid = tid; C.lane = tid & 63; C.wave = __builtin_amdgcn_readfirstlane(tid >> 6);
    int bx = blockIdx.x, G = gridDim.x; asm volatile("" : "+s"(bx), "+s"(G));
    C.G = G; C.bx = bx; C.vcu = (C.G % 8 == 0) ? (bx % 8) * (C.G / 8) + bx / 8 : bx;
    C.gw = C.vcu * NWAVES + C.wave; C.ngw = C.G * NWAVES;
    return C;
}
__device__ __forceinline__ unsigned char* opaque_ptr(unsigned char* p) { asm volatile("" : "+s"(p)); return p; }
__global__ void __launch_bounds__(NWAVES * 64, 2) fwd_kernel(Args args) {
    extern __shared__ __attribute__((aligned(16))) unsigned char lds[];
#ifndef CODE_SHIFT
#define CODE_SHIFT 0
#endif
#define CS_STR2(x) #x
#define CS_STR(x) CS_STR2(x)
#if CODE_SHIFT > 0
    asm volatile(".rept " CS_STR(CODE_SHIFT) "\n\ts_nop 0\n\t.endr");
#endif
    volatile LAS unsigned* MISC = (volatile LAS unsigned*)((LAS unsigned char*)lds + MISC_OFF);
    for (int u = threadIdx.x; u < LDS_BYTES / 4; u += NWAVES * 64) ((LAS unsigned*)((LAS unsigned char*)lds))[u] = 0u;
    __syncthreads();
    const int lo = args.ph_lo, hi = args.ph_hi;
    XcdBarrier bar; bar.bar = (unsigned*)(args.ws + WS_CTL) + CW_BAR; bar.x = 0; bar.st = nullptr;
    if (hi - lo > 1) bar = xcd_barrier_post((unsigned*)(args.ws + WS_CTL) + CW_BAR, MISC + 8);
    int ph = 0;
#ifndef PROBE_DUP
#define PROBE_DUP 0
#endif
#define PH_BEGIN_K(kind) if (ph >= lo && ph < hi) { for (int rep_ = (PROBE_DUP >> (kind)) & 1; rep_ >= 0; --rep_) { unsigned char* const ws = opaque_ptr(args.ws); const Ctx C = make_ctx(lds); (void)ws; (void)C;
#define PH_BEGIN PH_BEGIN_K(0)
#define PH_END   } if (ph + 1 < hi) { XcdBarrier b2 = bar; b2.bar = (unsigned*)opaque_ptr((unsigned char*)bar.bar); asm volatile("" : "+s"(b2.x)); xcd_barrier(b2); } } ++ph;
#define WSP(T, off) ((T*)(ws + (off)))

    PH_BEGIN_K(9) {
        In I; I.x = args.in[0]; I.norm_g = args.in[1]; I.w_gate = args.in[2]; I.w_up = args.in[3]; I.w_down = args.in[4]; I.rel_bias = args.in[5]; I.nsa_w_in = args.in[6]; I.nsa_pe = args.in[7];
        I.nsa_w1 = args.in[8]; I.nsa_b1 = args.in[9]; I.nsa_w2 = args.in[10]; I.nsa_w_out = args.in[11]; I.fox_w_in = args.in[12]; I.fox_b_f = args.in[13]; I.fox_w_out = args.in[14];
        prologue(C, I, ws, (bf16*)((unsigned char*)args.out + 32 * MiB)); } PH_END

#pragma unroll 1
    for (int s = 0; s < 8; ++s) {
        const int L = s >> 1, half = s & 1;
        PH_BEGIN_K(0) { pg8::Gemm g{WSP(bf16, WS_U), WSP(bf16, WS_WGU) + (size_t)s * NGU * D, D, D, D}; pg8::StaticOrder S; S.init(M, NGU, C.G, C.bx);
            pg8::EpiSwiglu E{WSP(bf16, WS_R1), FF}; pg8::gemm_phase<pg8::EpiSwiglu, pg8::StaticOrder, true, true>(C.lds + RING_OFF, g, S, E);
            if (C.G == 256 && C.bx >= 128 && rep_ == 0) {
                In I; I.x = args.in[0]; I.norm_g = args.in[1]; I.w_gate = args.in[2]; I.w_up = args.in[3]; I.w_down = args.in[4]; I.rel_bias = args.in[5]; I.nsa_w_in = args.in[6]; I.nsa_pe = args.in[7];
                I.nsa_w1 = args.in[8]; I.nsa_b1 = args.in[9]; I.nsa_w2 = args.in[10]; I.nsa_w_out = args.in[11]; I.fox_w_in = args.in[12]; I.fox_b_f = args.in[13]; I.fox_w_out = args.in[14];
                convert_for_next(I, ws, s, (C.bx - 128) * NWAVES + C.wave, 128 * NWAVES, (LAS float*)(C.lds + RING_OFF + C.wave * 16384), C.lane); } } PH_END
        PH_BEGIN_K(1) { pg8::Gemm g{WSP(bf16, WS_R1), WSP(bf16, WS_WD) + (size_t)s * D * FF, FF, FF, FF}; pg8::StaticOrder S; S.init(M, D, C.G, C.bx);
            pg8::EpiPlain E{WSP(bf16, WS_Y), D}; pg8::gemm_phase<pg8::EpiPlain, pg8::StaticOrder, true, true>(C.lds + RING_OFF, g, S, E); } PH_END
        PH_BEGIN_K(8) { const float* gL = args.in[1] + (size_t)L * 6 * D; const float* gpost = gL + (half ? 5 : 1) * D; const float* gpre = half ? (L < 3 ? gL + 6 * D : nullptr) : gL + 2 * D;
            bf16* hsd = (bf16*)((unsigned char*)args.out + 32 * MiB); const bool last = (s == 7);
            thin_pass(C, last ? WSP(bf16, WS_O) : hsd, rep_ ? WSP(bf16, WS_R1) : hsd, rep_ ? WSP(bf16, WS_R1 + 32 * MiB) : WSP(bf16, WS_U), rep_ ? WSP(float, WS_R1) : args.out, WSP(bf16, WS_Y), gpost, 0.5f, gpre, last); } PH_END
        if (half == 0) {
            const int j = L >> 1;
            if ((L & 1) == 0) {
                PH_BEGIN_K(2) { pg8::Gemm g{WSP(bf16, WS_U), WSP(bf16, WS_WNIN) + (size_t)j * NSA_IN_PAD * D, D, D, D}; pg8::StaticOrder S; S.init(M, NSA_IN_PAD, C.G, C.bx);
                    pg8::EpiNsaIn E{WSP(bf16, WS_R1), WSP(bf16, WS_R1 + R1_KV), WSP(float, WS_GATES), QSCALE, KV_STRIDE_E};
                    pg8::gemm_phase<pg8::EpiNsaIn, pg8::StaticOrder, true, true>(C.lds + RING_OFF, g, S, E); } PH_END
                PH_BEGIN_K(3) { const int xj = (C.bx >> 3) & 31, kc = xj & 7, Lu = (xj >> 4) * 16 + 2 * (C.bx & 7) + ((xj >> 3) & 1);
                    if (C.bx < 256) { int kch = 256; asm volatile("" : "+s"(kch));
                        pg8::Gemm g{WSP(bf16, WS_R1 + R1_KV) + kc * 256, WSP(bf16, WS_W1T) + (size_t)j * 512 * 2048 + kc * 256, 1024, 2048, kch}; pg8::OneUnit S{Lu, Lu >> 4};
                        pg8::EpiSlab E{WSP(float, WS_Y) + (size_t)kc * 8192 * 256}; pg8::gemm_phase<pg8::EpiSlab, pg8::OneUnit, true, true>(C.lds + RING_OFF, g, S, E); } } PH_END
                PH_BEGIN_K(5) cmp_tail_phase(C, WSP(float, WS_Y), WSP(float, WS_B1F) + j * 512, WSP(bf16, WS_W2T) + (size_t)j * 2 * 64 * 256, WSP(bf16, WS_R1 + R1_KC2)); PH_END
#if NSA_NAIVE
                PH_BEGIN_K(6) nsa_naive_phase(C, WSP(bf16, WS_R1), WSP(bf16, WS_R1 + R1_KV), WSP(bf16, WS_R1 + R1_KC2), WSP(float, WS_GATES), WSP(float, WS_LUT), WSP(bf16, WS_O)); PH_END
#else
                PH_BEGIN_K(6) nsa_fast_phase(C, (char*)lds, WSP(bf16, WS_R1), WSP(bf16, WS_R1 + R1_KV), WSP(bf16, WS_R1 + R1_KC2), WSP(float, WS_GATES), WSP(float, WS_LUT), WSP(bf16, WS_O)); PH_END
#endif
                PH_BEGIN_K(4) { pg8::Gemm g{WSP(bf16, WS_O), WSP(bf16, WS_WNOUT) + (size_t)j * D * D, D, D, D}; pg8::StaticOrder S; S.init(M, D, C.G, C.bx);
                    pg8::EpiPlain E{WSP(bf16, WS_Y), D}; pg8::gemm_phase<pg8::EpiPlain, pg8::StaticOrder, true, true>(C.lds + RING_OFF, g, S, E); } PH_END
            } else {
                PH_BEGIN_K(2) { fox_flog_tasks(C, WSP(bf16, WS_U), WSP(bf16, WS_WFIN) + ((size_t)j * FOX_IN_PAD + 3 * D) * D, WSP(float, WS_FLOG));
                    pg8::Gemm g{WSP(bf16, WS_U), WSP(bf16, WS_WFIN) + (size_t)j * FOX_IN_PAD * D, D, D, D}; pg8::StaticOrder S; S.init(M, 3 * D, C.G, C.bx);
                    pg8::EpiFoxIn E{WSP(bf16, WS_R1), WSP(float, WS_FLOG), QSCALE, (size_t)M * D}; pg8::gemm_phase<pg8::EpiFoxIn, pg8::StaticOrder, true, true>(C.lds + RING_OFF, g, S, E); } PH_END
#if FOX_NAIVE
                PH_BEGIN_K(7) fox_cum_phase(C, WSP(float, WS_FLOG), args.in[13] + j * 16, WSP(float, WS_CUM)); PH_END
                PH_BEGIN_K(7) fox_naive_phase(C, WSP(bf16, WS_R1), WSP(bf16, WS_R1) + (size_t)M * D, WSP(bf16, WS_R1) + (size_t)2 * M * D, WSP(float, WS_CUM), WSP(bf16, WS_O)); PH_END
#else
                PH_BEGIN_K(7) fox_fast_phase(C, (char*)lds, WSP(bf16, WS_R1), WSP(bf16, WS_R1) + (size_t)M * D, WSP(bf16, WS_R1) + (size_t)2 * M * D, WSP(bf16, WS_O), WSP(float, WS_FLOG), args.in[13] + j * 16, WSP(bf16, WS_Y)); PH_END
#endif
                PH_BEGIN_K(4) { pg8::Gemm g{WSP(bf16, WS_O), WSP(bf16, WS_WFOUT) + (size_t)j * D * D, D, D, D}; pg8::StaticOrder S; S.init(M, D, C.G, C.bx);
                    pg8::EpiPlain E{WSP(bf16, WS_Y), D}; pg8::gemm_phase<pg8::EpiPlain, pg8::StaticOrder, true, true>(C.lds + RING_OFF, g, S, E); } PH_END
            }
            PH_BEGIN_K(8) { const float* gL = args.in[1] + (size_t)L * 6 * D; bf16* hsd = (bf16*)((unsigned char*)args.out + 32 * MiB);
                thin_pass(C, hsd, rep_ ? WSP(bf16, WS_R1) : (L == 3 ? WSP(bf16, WS_O) : hsd), rep_ ? WSP(bf16, WS_R1 + 32 * MiB) : WSP(bf16, WS_U), args.out, WSP(bf16, WS_Y), gL + 3 * D, 1.0f, gL + 4 * D, false); } PH_END
        }
    }
#undef PH_BEGIN
#undef PH_END
#undef WSP
}

extern "C" void kernel_launch(void* const* d_in, const int* in_sizes, int n_in, void* d_out, int out_size, void* d_ws, size_t ws_size, hipStream_t stream) {
    static int grid = 0;
    if (grid == 0) {
        if (n_in != 15 || in_sizes[0] != M * D || out_size != M * D || ws_size < WS_END) { fprintf(stderr, "kernel_launch: unexpected shapes (n_in %d, in0 %d, out %d, ws %zu < %zu); nothing launched\n", n_in, n_in > 0 ? in_sizes[0] : -1, out_size, ws_size, (size_t)WS_END); grid = -1; return; }
        int dev = 0, cus = 0, per_cu = 0;
        if (hipGetDevice(&dev) != hipSuccess || hipDeviceGetAttribute(&cus, hipDeviceAttributeMultiprocessorCount, dev) != hipSuccess) { grid = -1; return; }
        if (hipFuncSetAttribute((const void*)fwd_kernel, hipFuncAttributeMaxDynamicSharedMemorySize, LDS_BYTES) != hipSuccess) { fprintf(stderr, "kernel_launch: hipFuncSetAttribute failed\n"); grid = -1; return; }
        if (hipOccupancyMaxActiveBlocksPerMultiprocessor(&per_cu, (const void*)fwd_kernel, NWAVES * 64, LDS_BYTES) != hipSuccess || per_cu < 1)
            fprintf(stderr, "kernel_launch: note: occupancy query reports %d workgroups per CU\n", per_cu);
        (void)hipGetLastError();
        grid = cus;
    }
    if (grid < 0) return;
    if (hipMemsetAsync((char*)d_ws + WS_CTL, 0, CTL_ZERO_BYTES, stream) != hipSuccess) { fprintf(stderr, "kernel_launch: hipMemsetAsync failed\n"); return; }
    Args a{};
    for (int i = 0; i < 15; ++i) a.in[i] = (const float*)d_in[i];
    a.out = (float*)d_out; a.ws = (unsigned char*)d_ws;
#if MK_PER_PHASE
    for (int p = 0; p < N_PHASES; ++p) { a.ph_lo = p; a.ph_hi = p + 1; hipLaunchKernelGGL(fwd_kernel, dim3(grid), dim3(NWAVES * 64), LDS_BYTES, stream, a); }
#else
    a.ph_lo = 0; a.ph_hi = N_PHASES;
    hipLaunchKernelGGL(fwd_kernel, dim3(grid), dim3(NWAVES * 64), LDS_BYTES, stream, a);
#endif
    const hipError_t le = hipPeekAtLastError();
    if (le != hipSuccess) fprintf(stderr, "kernel_launch: launch failed: %s\n", hipGetErrorName(le));
}
```

```cpp
#include <hip/hip_runtime.h>
#include <cstdio>
#include <cstdint>
#define PG8_STR2(x) #x
#define PG8_STR(x) PG8_STR2(x)
namespace pg8 {
#define PG8_LAS __attribute__((address_space(3)))
typedef unsigned short bf16_t;
typedef short bf16x8 __attribute__((ext_vector_type(8)));
typedef float f32x4 __attribute__((ext_vector_type(4)));
typedef unsigned u32x4 __attribute__((ext_vector_type(4)));
constexpr int BM = 256, BK = 64, HALF = 128, HTB = HALF * BK * 2  , STAGE_BYTES = 8 * HTB, NXCD = 8, WGM = 8;

__host__ __device__ __forceinline__ int lds_byte(int r, int c) { const int st = (r >> 4) * 2 + (c >> 5), rr = r & 15, cc = c & 31, ob = rr * 64 + cc * 2; return st * 1024 + (ob ^ (((ob >> 9) & 1) << 5)); }
__host__ __device__ __forceinline__ void stage_rc(int b, int& R, int& C) { const int st = b / 1024, sb = b % 1024, swz = sb ^ (((sb >> 9) & 1) << 5); R = (st >> 1) * 16 + swz / 64; C = (st & 1) * 32 + (swz % 64) / 2; }
__host__ __device__ __forceinline__ int perm32(int rho) { const int n = rho >> 4, i = rho & 15; return 8 * (i >> 2) + 4 * n + (i & 3); }

struct Unit { int pm, pn; };
struct Gemm { const bf16_t* A; const bf16_t* Bt; int lda, ldb, K; };

struct StaticOrder {
    int nM, nN, nwg, G, c;
    __host__ __device__ void init(int M, int N, int G_, int c_) { nM = M / BM; nN = N / BM; nwg = nM * nN; G = G_; c = c_; }
    __host__ __device__ bool next(int i, Unit& u) const {
        const long L = (long)i * G + c; if (L >= nwg) return false;
        int wgid = (int)L; { const int q = nwg / NXCD, r = nwg % NXCD, xcd = wgid % NXCD, off = wgid / NXCD; wgid = (xcd < r ? xcd * (q + 1) : r * (q + 1) + (xcd - r) * q) + off; }
        const int nig = WGM * nN, gid = wgid / nig, fm = gid * WGM, gsz = (nM - fm) < WGM ? (nM - fm) : WGM;
        u.pm = fm + ((wgid % nig) % gsz); u.pn = (wgid % nig) / gsz; return true;
    }
    __device__ __forceinline__ void a_ready(const Unit&) const {}
    __device__ __forceinline__ void done(const Unit&) const {}
};

__device__ __forceinline__ unsigned cvt_pk_bf16(float lo, float hi) { unsigned r; asm volatile("v_cvt_pk_bf16_f32 %0, %1, %2" : "=v"(r) : "v"(lo), "v"(hi)); return r; }
typedef float f32x2 __attribute__((ext_vector_type(2)));
__device__ __forceinline__ f32x2 gelu_pk(f32x2 v) {
    const f32x2 av = __builtin_elementwise_abs(v), d = av * 0.2316418882f + 1.0f;
    f32x2 t; t.x = __builtin_amdgcn_rcpf(d.x); t.y = __builtin_amdgcn_rcpf(d.y);
    f32x2 q = t * 0.5307027145f + (-0.7265760135f); q = q * t + 0.7107068705f; q = q * t + (-0.142248368f); q = q * t + 0.127414796f; q = q * t;
    const f32x2 s = (v * v) * (-0.72134752044f);
    f32x2 e; e.x = __builtin_amdgcn_exp2f(s.x); e.y = __builtin_amdgcn_exp2f(s.y);
    const f32x2 m = v * (q * e), r = v - m;
    f32x2 o; o.x = v.x < 0.f ? m.x : r.x; o.y = v.y < 0.f ? m.y : r.y; return o;
}

template <class Epi, class Sched, bool ALIGN_EPI = false, bool SP2 = false>
__device__ __forceinline__ void gemm_phase(PG8_LAS unsigned char* lds, const Gemm g, const Sched& S, const Epi& E) {
    int tid = threadIdx.x; asm volatile("" : "+v"(tid));
    const int wid = __builtin_amdgcn_readfirstlane(tid >> 6), lane = tid & 63, wr = wid >> 2, wc = wid & 3, fr = lane & 15, fq = lane >> 4;
    const int K = g.K, nt = K / BK;
    unsigned voffA[2], voffB[2];
#pragma unroll
    for (int i = 0; i < 2; ++i) { int R, C; stage_rc(tid * 16 + i * 8192, R, C); const int Rb = Epi::PERM ? ((R & ~31) + perm32(R & 31)) : R;
        voffA[i] = (unsigned)(R * g.lda + C) * 2u; voffB[i] = (unsigned)(Rb * g.ldb + C) * 2u; }
    const size_t kstep = (size_t)(BK * 2);
    const size_t hstepA = (size_t)HALF * g.lda * 2, hstepB = (size_t)HALF * g.ldb * 2;
    const size_t tstepA = 2 * hstepA, tstepB = 2 * hstepB;
    const unsigned ldsw = (unsigned)wid * 1024u;
    const int aoff = lds_byte(wr * 64 + fr, fq * 8), boff = lds_byte(wc * 32 + fr, fq * 8);
#define PG8_SA(b, h) (((b) * 2 + (h)) * HTB)
#define PG8_SB(b, h) ((4 + (b) * 2 + (h)) * HTB)
#define PG8_STAGE(bufoff, gbase, voff) do { _Pragma("unroll") for (int _i = 0; _i < 2; ++_i) \
        __builtin_amdgcn_global_load_lds((const unsigned*)((const char*)(gbase) + (voff)[_i]), (PG8_LAS unsigned*)(lds + (bufoff) + ldsw + _i * 8192), 16, 0, 0); } while (0)
#define PG8_LDA(dst, b, h) do { _Pragma("unroll") for (int m = 0; m < 4; ++m) _Pragma("unroll") for (int k = 0; k < 2; ++k) dst[m][k] = *(const PG8_LAS bf16x8*)(lds + PG8_SA(b, h) + aoff + m * 2048 + k * 1024); } while (0)
#define PG8_LDB(dst, b, h) do { _Pragma("unroll") for (int n = 0; n < 2; ++n) _Pragma("unroll") for (int k = 0; k < 2; ++k) dst[n][k] = *(const PG8_LAS bf16x8*)(lds + PG8_SB(b, h) + boff + n * 2048 + k * 1024); } while (0)
#define PG8_MMA(ai, bj, At, Bt) do { __builtin_amdgcn_s_setprio(1); _Pragma("unroll") for (int m = 0; m < 4; ++m) _Pragma("unroll") for (int n = 0; n < 2; ++n) _Pragma("unroll") for (int k = 0; k < 2; ++k) \
        acc[ai][bj][m][n] = __builtin_amdgcn_mfma_f32_16x16x32_bf16(Bt[n][k], At[m][k], acc[ai][bj][m][n], 0, 0, 0); __builtin_amdgcn_s_setprio(0); } while (0)
#define PG8_WAIT_V(n) asm volatile("s_waitcnt vmcnt(" #n ")" ::: "memory")
#define PG8_WAIT_L(n) asm volatile("s_waitcnt lgkmcnt(" #n ")" ::: "memory")
#define PG8_BAR __builtin_amdgcn_s_barrier()
#define PG8_SCHED __builtin_amdgcn_sched_barrier(0)
    Unit cur, nxt; int ui = 0;
    if (!S.next(0, cur)) return;
    f32x4 acc[2][2][4][2];
#pragma unroll
    for (int a = 0; a < 2; ++a)
#pragma unroll
        for (int b = 0; b < 2; ++b)
#pragma unroll
            for (int m = 0; m < 4; ++m)
#pragma unroll
                for (int n = 0; n < 2; ++n) acc[a][b][m][n] = (f32x4){0.f, 0.f, 0.f, 0.f};
    bf16x8 At[4][2], B0[2][2], B1[2][2];
    const char* cA = (const char*)g.A + (size_t)cur.pm * tstepA; const char* cB = (const char*)g.Bt + (size_t)cur.pn * tstepB;
    S.a_ready(cur);
    if constexpr (SP2) {
        PG8_STAGE(PG8_SB(0, 0), cB, voffB); PG8_STAGE(PG8_SB(0, 1), cB + hstepB, voffB); PG8_STAGE(PG8_SA(0, 0), cA, voffA); PG8_STAGE(PG8_SA(0, 1), cA + hstepA, voffA);
        if (wr == 1) PG8_BAR;
        PG8_WAIT_V(2); PG8_BAR;
        PG8_STAGE(PG8_SB(1, 0), cB + kstep, voffB); PG8_STAGE(PG8_SA(1, 0), cA + kstep, voffA); PG8_STAGE(PG8_SB(1, 1), cB + hstepB + kstep, voffB);
        PG8_WAIT_V(6); PG8_BAR;
    } else {
        PG8_STAGE(PG8_SB(0, 0), cB, voffB); PG8_STAGE(PG8_SA(0, 0), cA, voffA); PG8_STAGE(PG8_SB(0, 1), cB + hstepB, voffB); PG8_STAGE(PG8_SA(0, 1), cA + hstepA, voffA);
        if (wr == 1) PG8_BAR;
        PG8_WAIT_V(4); PG8_BAR;
        PG8_STAGE(PG8_SB(1, 0), cB + kstep, voffB); PG8_STAGE(PG8_SA(1, 0), cA + kstep, voffA); PG8_STAGE(PG8_SB(1, 1), cB + hstepB + kstep, voffB);
        PG8_WAIT_V(6); PG8_BAR;
    }
    for (;;) {
        const bool has_next = S.next(ui + 1, nxt);
        const char* nA = has_next ? (const char*)g.A + (size_t)nxt.pm * tstepA : cA; const char* nB = has_next ? (const char*)g.Bt + (size_t)nxt.pn * tstepB : cB;
        for (int t = 0; t < nt; t += 2) {
#if defined(KLOOP_ALIGN)
            asm volatile(".p2align 6\n\t.rept " PG8_STR(KLOOP_ALIGN) "\n\ts_nop 0\n\t.endr");
#endif
            const bool last = (t == nt - 2);
            const char* a1 = cA + (size_t)(t + 1) * kstep;
            const char* a2 = last ? nA : cA + (size_t)(t + 2) * kstep; const char* b2 = last ? nB : cB + (size_t)(t + 2) * kstep;
            const char* a3 = a2 + kstep; const char* b3 = b2 + kstep;
            if (last && has_next) S.a_ready(nxt);
            if constexpr (SP2) {
            PG8_LDB(B0, 0, 0); PG8_LDB(B1, 0, 1); PG8_SCHED; PG8_LDA(At, 0, 0); PG8_STAGE(PG8_SA(1, 1), a1 + hstepA, voffA);
            PG8_WAIT_V(8); PG8_WAIT_L(0); PG8_BAR; PG8_MMA(0, 0, At, B0); PG8_MMA(0, 1, At, B1); PG8_BAR; PG8_SCHED;
            PG8_LDA(At, 0, 1); PG8_STAGE(PG8_SB(0, 0), b2, voffB); PG8_STAGE(PG8_SB(0, 1), b2 + hstepB, voffB); PG8_STAGE(PG8_SA(0, 0), a2, voffA);
            PG8_WAIT_V(8); PG8_WAIT_L(0); PG8_BAR; PG8_MMA(1, 0, At, B0); PG8_MMA(1, 1, At, B1); PG8_BAR; PG8_SCHED;
            PG8_LDB(B0, 1, 0); PG8_LDB(B1, 1, 1); PG8_SCHED; PG8_LDA(At, 1, 0); PG8_STAGE(PG8_SA(0, 1), a2 + hstepA, voffA);
            PG8_WAIT_V(8); PG8_WAIT_L(0); PG8_BAR; PG8_MMA(0, 0, At, B0); PG8_MMA(0, 1, At, B1); PG8_BAR; PG8_SCHED;
            PG8_LDA(At, 1, 1); PG8_STAGE(PG8_SB(1, 0), b3, voffB); PG8_STAGE(PG8_SB(1, 1), b3 + hstepB, voffB); PG8_STAGE(PG8_SA(1, 0), a3, voffA);
            PG8_WAIT_V(8); PG8_WAIT_L(0); PG8_BAR; PG8_MMA(1, 0, At, B0); PG8_MMA(1, 1, At, B1); PG8_BAR; PG8_SCHED;
            } else {
            PG8_LDB(B0, 0, 0); PG8_SCHED; PG8_LDA(At, 0, 0); PG8_STAGE(PG8_SA(1, 1), a1 + hstepA, voffA);
            PG8_WAIT_L(8); PG8_BAR; PG8_WAIT_L(0); PG8_MMA(0, 0, At, B0); PG8_BAR; PG8_SCHED;
            PG8_LDB(B1, 0, 1); PG8_STAGE(PG8_SB(0, 0), b2, voffB);
            PG8_BAR; PG8_WAIT_L(0); PG8_MMA(0, 1, At, B1); PG8_BAR;
            PG8_LDA(At, 0, 1); PG8_STAGE(PG8_SA(0, 0), a2, voffA);
            PG8_BAR; PG8_WAIT_L(0); PG8_MMA(1, 0, At, B0); PG8_BAR; PG8_SCHED;
            PG8_STAGE(PG8_SB(0, 1), b2 + hstepB, voffB);
            PG8_WAIT_V(6); PG8_BAR; PG8_MMA(1, 1, At, B1); PG8_BAR;
            PG8_LDB(B0, 1, 0); PG8_SCHED; PG8_LDA(At, 1, 0); PG8_STAGE(PG8_SA(0, 1), a2 + hstepA, voffA);
            PG8_WAIT_L(8); PG8_BAR; PG8_WAIT_L(0); PG8_MMA(0, 0, At, B0); PG8_BAR; PG8_SCHED;
            PG8_LDB(B1, 1, 1); PG8_STAGE(PG8_SB(1, 0), b3, voffB);
            PG8_BAR; PG8_WAIT_L(0); PG8_MMA(0, 1, At, B1); PG8_BAR;
            PG8_LDA(At, 1, 1); PG8_STAGE(PG8_SA(1, 0), a3, voffA);
            PG8_BAR; PG8_WAIT_L(0); PG8_MMA(1, 0, At, B0); PG8_BAR; PG8_SCHED;
            PG8_STAGE(PG8_SB(1, 1), b3 + hstepB, voffB);
            PG8_WAIT_V(6); PG8_BAR; PG8_MMA(1, 1, At, B1); PG8_BAR;
            }
        }
        if constexpr (ALIGN_EPI) { if (wr == 0) PG8_BAR; }
        if constexpr (!Epi::AFTER_DRAIN) { E(acc, cur, wr, wc, fr, fq); S.done(cur); }
        if (!has_next) break;
#pragma unroll
        for (int a = 0; a < 2; ++a)
#pragma unroll
            for (int b = 0; b < 2; ++b)
#pragma unroll
                for (int m = 0; m < 4; ++m)
#pragma unroll
                    for (int n = 0; n < 2; ++n) acc[a][b][m][n] = (f32x4){0.f, 0.f, 0.f, 0.f};
        cur = nxt; cA = nA; cB = nB; ++ui;
        if constexpr (ALIGN_EPI) { if (wr == 1) PG8_BAR; }
    }
    PG8_WAIT_V(0);
    if constexpr (!ALIGN_EPI) { if (wr == 0) PG8_BAR; }
    PG8_BAR;
    if constexpr (Epi::AFTER_DRAIN) { E.fused(acc, cur, wr, wc, fr, fq, lds, wid, lane); S.done(cur); }
#undef PG8_SA
#undef PG8_SB
#undef PG8_STAGE
#undef PG8_LDA
#undef PG8_LDB
#undef PG8_MMA
#undef PG8_WAIT_V
#undef PG8_WAIT_L
#undef PG8_BAR
#undef PG8_SCHED
}
}
#include <hip/hip_bf16.h>
#include <cmath>
namespace attn_body {
using bf16=__hip_bfloat16;
using bf16x8=__attribute__((ext_vector_type(8)))short;
using s16x4=__attribute__((ext_vector_type(4)))short;
using f32x16=__attribute__((ext_vector_type(16)))float;
using u32x4=__attribute__((ext_vector_type(4)))unsigned;
constexpr int BATCH=8,NHEAD=16,SEQ=2048,D=64,DM=NHEAD*D;
constexpr int NW=8,QBLK=32,QB=QBLK*NW,KVBLK=64,NQB=SEQ/QB;
constexpr int ATTN_PITCH=DM, ATTN_UNIT_ROWS=QB;
__device__ __forceinline__ int crow(int r,int hi){return (r&3)+8*(r>>2)+4*hi;}
#define SBAR() __builtin_amdgcn_sched_barrier(0)
__device__ __forceinline__ void cmask(f32x16&p0,f32x16&p1,int jb,int qrel,int hi){
  const float NEG=-INFINITY; int kb=64*jb+4*hi;
  #pragma unroll
  for(int r=0;r<16;++r){int kv=kb+(r&3)+8*(r>>2); if(kv>qrel)p0[r]=NEG; if(kv+32>qrel)p1[r]=NEG;}
}

constexpr int NSLOT=3, SLOTB=8192;
constexpr int LDS_K=0, LDS_V=NSLOT*SLOTB, LDS_WS=2*NSLOT*SLOTB, LDS_OST=LDS_WS+NW*64*4, LDS_BYTES=LDS_OST+NW*4096;
constexpr float C2=0.125f*1.4426950408889634f;
__device__ __forceinline__ void glds16(const void*gsrc,unsigned lds_dst){unsigned keep;
  asm volatile("s_mov_b32 %0, m0\n\ts_mov_b32 m0, %2\n\ts_nop 0\n\tglobal_load_lds_dwordx4 %1, off\n\ts_mov_b32 m0, %0":"=&s"(keep):"v"(gsrc),"s"(lds_dst):"memory");}
__device__ __forceinline__ void glds16s(const void*sbase,unsigned voff,unsigned lds_dst){unsigned keep;
  asm volatile("s_mov_b32 %0, m0\n\ts_mov_b32 m0, %2\n\ts_nop 0\n\tglobal_load_lds_dwordx4 %1, %3\n\ts_mov_b32 m0, %0":"=&s"(keep):"v"(voff),"s"(lds_dst),"s"(sbase):"memory");}
__device__ __forceinline__ float max3f(float a,float b,float c){float r;asm("v_max3_f32 %0, %1, %2, %3":"=v"(r):"v"(a),"v"(b),"v"(c));return r;}
__device__ __forceinline__ float max2f(float a,float b){float r;asm("v_max_f32_e32 %0, %1, %2":"=v"(r):"v"(a),"v"(b));return r;}
__device__ __forceinline__ float fadd_s(float a,float b){float r;asm("v_add_f32_e32 %0, %1, %2":"=v"(r):"v"(a),"v"(b));return r;}
__device__ __forceinline__ float fsub_s(float a,float b){float r;asm("v_sub_f32_e32 %0, %1, %2":"=v"(r):"v"(a),"v"(b));return r;}
typedef float f32x2_t __attribute__((ext_vector_type(2))); typedef __bf16 bf16x2_t __attribute__((ext_vector_type(2)));
__device__ __forceinline__ unsigned cvtpk_s(float lo,float hi){f32x2_t v={lo,hi};bf16x2_t b=__builtin_convertvector(v,bf16x2_t);return __builtin_bit_cast(unsigned,b);}
#define WAIT_BAR(N) asm volatile("s_waitcnt vmcnt(" #N ") lgkmcnt(0)\n\ts_barrier":::"memory")

__device__ __forceinline__ void qkt(f32x16&p0,f32x16&p1,const char*Kslot,const bf16x8*qr,const f32x16&negm,int r32,int hi){
  const char*kb=Kslot+hi*1024+r32*16;
  #pragma unroll
  for(int d0=0;d0<4;++d0){
    const bf16x8 b0=*reinterpret_cast<const bf16x8*>(kb+d0*2048);
    const bf16x8 b1=*reinterpret_cast<const bf16x8*>(kb+d0*2048+512);
    if(d0==0){p0=__builtin_amdgcn_mfma_f32_32x32x16_bf16(b0,qr[0],negm,0,0,0);p1=__builtin_amdgcn_mfma_f32_32x32x16_bf16(b1,qr[0],negm,0,0,0);}
    else{p0=__builtin_amdgcn_mfma_f32_32x32x16_bf16(b0,qr[d0],p0,0,0,0);p1=__builtin_amdgcn_mfma_f32_32x32x16_bf16(b1,qr[d0],p1,0,0,0);}}
}
typedef __attribute__((address_space(3))) const char* lds_cptr;
typedef short v4i16_t __attribute__((ext_vector_type(4)));
__device__ __forceinline__ void kload8(bf16x8*kf,lds_cptr kp){
  kf[0]=*(const __attribute__((address_space(3))) bf16x8*)(kp);      kf[1]=*(const __attribute__((address_space(3))) bf16x8*)(kp+512);
  kf[2]=*(const __attribute__((address_space(3))) bf16x8*)(kp+2048); kf[3]=*(const __attribute__((address_space(3))) bf16x8*)(kp+2560);
  kf[4]=*(const __attribute__((address_space(3))) bf16x8*)(kp+4096); kf[5]=*(const __attribute__((address_space(3))) bf16x8*)(kp+4608);
  kf[6]=*(const __attribute__((address_space(3))) bf16x8*)(kp+6144); kf[7]=*(const __attribute__((address_space(3))) bf16x8*)(kp+6656);
}
__device__ __forceinline__ void kload2(bf16x8*kf,lds_cptr kp,int j){ kf[2*j]=*(const __attribute__((address_space(3))) bf16x8*)(kp+j*2048); kf[2*j+1]=*(const __attribute__((address_space(3))) bf16x8*)(kp+j*2048+512); }
__device__ __forceinline__ s16x4 vtr(lds_cptr p){ return __builtin_bit_cast(s16x4,__builtin_amdgcn_ds_read_tr16_b64_v4i16((__attribute__((address_space(3))) v4i16_t*)p)); }
__device__ __forceinline__ float rowmax(const f32x16&p0,const f32x16&p1){
  float a=max3f(p0[0],p0[1],p1[0]),b=max3f(p0[2],p0[3],p1[1]);a=max3f(a,p1[2],p1[3]);
  #pragma unroll
  for(int r=4;r<16;r+=4){a=max3f(a,p0[r],p0[r+1]);b=max3f(b,p0[r+2],p0[r+3]);a=max3f(a,p1[r],p1[r+1]);b=max3f(b,p1[r+2],p1[r+3]);}
  const float m=max2f(a,b);
  auto rr=__builtin_amdgcn_permlane32_swap(__float_as_uint(m),__float_as_uint(m),false,false);
  return max2f(__uint_as_float(rr[0]),__uint_as_float(rr[1]));
}
__device__ __forceinline__ void pv(f32x16*o,int vb,bf16x8 pa0,bf16x8 pa1,bf16x8 pa2,bf16x8 pa3){
  #pragma unroll
  for(int d0=0;d0<2;++d0){s16x4 lo[4],hi[4];
    #pragma unroll
    for(int ks=0;ks<4;++ks){
      asm volatile("ds_read_b64_tr_b16 %0,%1 offset:%c2":"=&v"(lo[ks]):"v"(vb),"i"(d0*4096+ks*1024):"memory");
      asm volatile("ds_read_b64_tr_b16 %0,%1 offset:%c2":"=&v"(hi[ks]):"v"(vb),"i"(d0*4096+ks*1024+512):"memory");}
    asm volatile("s_waitcnt lgkmcnt(0)":::"memory");SBAR();
    #define PK(k) (bf16x8){lo[k][0],lo[k][1],lo[k][2],lo[k][3],hi[k][0],hi[k][1],hi[k][2],hi[k][3]}
    o[d0]=__builtin_amdgcn_mfma_f32_32x32x16_bf16(pa0,PK(0),o[d0],0,0,0);
    o[d0]=__builtin_amdgcn_mfma_f32_32x32x16_bf16(pa1,PK(1),o[d0],0,0,0);
    o[d0]=__builtin_amdgcn_mfma_f32_32x32x16_bf16(pa2,PK(2),o[d0],0,0,0);
    o[d0]=__builtin_amdgcn_mfma_f32_32x32x16_bf16(pa3,PK(3),o[d0],0,0,0);
    #undef PK
  }
}

#ifndef ATTN_STORE16
#define ATTN_STORE16(p,v) (*(u32x4*)(p)=(v))
#endif
template<int THRL,int VAR=0> __device__ __forceinline__ void attn_unit(int b,int h,int qb,const bf16*Q,const bf16*__restrict__ K,const bf16*__restrict__ V,bf16*O,char*shm,const __attribute__((address_space(3))) float*cumL,int tskip){
  int tid=threadIdx.x; asm volatile("":"+v"(tid));
  const int lane=tid&63,r32=lane&31,hi=lane>>5; const int wid=__builtin_amdgcn_readfirstlane(tid>>6);
  const long rowbase=(long)b*SEQ; const int q0=qb*QB;
  const bf16*Qw=Q+(rowbase+q0+wid*QBLK)*DM+h*D;
  const bf16*Kh=K+(rowbase+(long)tskip*KVBLK)*DM+h*D,*Vh=V+(rowbase+(long)tskip*KVBLK)*DM+h*D;
  const unsigned lds0=(unsigned)(uintptr_t)shm;
  float*wsf=(float*)(shm+LDS_WS)+wid*64;
  const bf16*ksrc=Kh+(long)lane*DM+wid*8;
  const bf16*vsrc=Vh+(long)(16*(wid&3)+(lane>>2))*DM+(wid>>2)*32+(lane&3)*8;
  const unsigned kdst=lds0+LDS_K+wid*1024, vdst=lds0+LDS_V+wid*1024;
  #define DMA_K(t,slot) glds16(ksrc+(long)(t)*KVBLK*DM,(unsigned)__builtin_amdgcn_readfirstlane(kdst+(slot)))
  #define DMA_V(t,slot) glds16(vsrc+(long)(t)*KVBLK*DM,(unsigned)__builtin_amdgcn_readfirstlane(vdst+(slot)))
  const int vb0=(int)(lds0+LDS_V)+((lane>>4)&1)*32+(lane&3)*8+(4*hi+((lane&15)>>2))*64;
  const char*Kbase=shm+LDS_K; bf16x8 kf[8];
  const lds_cptr shm3=(lds_cptr)shm; const lds_cptr kp0=shm3+LDS_K+hi*1024+r32*16; const lds_cptr vp0=shm3+LDS_V+((lane>>4)&1)*32+(lane&3)*8+(4*hi+((lane&15)>>2))*64;
  const int NT=(q0+QB)/KVBLK-tskip;
  DMA_K(0,0);DMA_V(0,0);DMA_K(1,SLOTB);
  bf16x8 qr[4];
  #pragma unroll
  for(int d0=0;d0<4;++d0)qr[d0]=*reinterpret_cast<const bf16x8*>(&Qw[(long)r32*DM+d0*16+hi*8]);
  const float cq=cumL[qb*QB+wid*QBLK+r32];
  float mhat=0.f,l_reg=0.f;f32x16 o[2];o[0]=f32x16{};o[1]=f32x16{};const f32x16 negm=f32x16{};
  typedef float f32x4_t __attribute__((ext_vector_type(4)));
  #define KBIAS(P0,P1,t) do{ if(VAR&1){ const float nm1_=cq-mhat; _Pragma("unroll") for(int r_=0;r_<16;++r_){P0[r_]+=nm1_;P1[r_]+=nm1_;} break; } const float nm_=cq-mhat; const __attribute__((address_space(3))) float*cb_=cumL+64*((t)+tskip)+4*hi; \
    _Pragma("unroll") for(int g_=0;g_<4;++g_){ const f32x4_t k0_=*(const __attribute__((address_space(3))) f32x4_t*)(cb_+8*g_); const f32x4_t k1_=*(const __attribute__((address_space(3))) f32x4_t*)(cb_+32+8*g_); \
      _Pragma("unroll") for(int e_=0;e_<4;++e_){ P0[4*g_+e_]+=(nm_-k0_[e_]); P1[4*g_+e_]+=(nm_-k1_[e_]); } } }while(0)
  const int qrel=wid*QBLK+r32;
  #define CMASK(P0,P1,t) do{int jb_=(t)-(NT-4); if(jb_>=0)cmask(P0,P1,jb_,qrel,hi);}while(0)
  bool resc=false;
  #define START(P0,P1) do{ const float rm=rowmax(P0,P1); resc=false; \
    { const float dl=rm; mhat=fadd_s(mhat,dl); \
      _Pragma("unroll") for(int r=0;r<16;++r){P0[r]=fsub_s(P0[r],dl);P1[r]=fsub_s(P1[r],dl);} \
      } \
    _Pragma("unroll") for(int r=0;r<16;++r)P0[r]=__builtin_amdgcn_exp2f(P0[r]); }while(0)
  #define RESC() do{ if(resc){ asm volatile("s_waitcnt lgkmcnt(0)":::"memory"); \
      _Pragma("unroll") for(int d_=0;d_<2;++d_) _Pragma("unroll") for(int r=0;r<16;++r)o[d_][r]*=wsf[crow(r,hi)]; } }while(0)
  f32x16 pA0,pA1,pB0,pB1;
  int sl_prev=0,sl_cur=0,sl_next=SLOTB;
  #define ROT() do{sl_prev=sl_cur;sl_cur=sl_next;sl_next=(sl_next==(NSLOT-1)*SLOTB)?0:sl_next+SLOTB;}while(0)
  DMA_K(2,2*SLOTB);
  WAIT_BAR(3);
  qkt(pA0,pA1,Kbase,qr,negm,r32,hi);asm volatile("s_nop 15\n\ts_nop 7":"+v"(pA0),"+v"(pA1));KBIAS(pA0,pA1,0);CMASK(pA0,pA1,0);
  START(pA0,pA1);
  _Pragma("unroll") for(int r=0;r<16;++r)pA1[r]=__builtin_amdgcn_exp2f(pA1[r]);
  WAIT_BAR(0);
  DMA_K(3,0);DMA_V(1,SLOTB);
  ROT();
  kload8(kf,kp0+sl_cur);
  WAIT_BAR(2);
  s16x4 vlo[8],vhi[8]; u32x4 pw0,pw1,pw2,pw3;
  #define PKW(P,B) cvtpk_s(P[B],P[B+1])
  #define PAF(k) __builtin_bit_cast(bf16x8,pw##k)
  #define VFR(i) (bf16x8){vlo[i][0],vlo[i][1],vlo[i][2],vlo[i][3],vhi[i][0],vhi[i][1],vhi[i][2],vhi[i][3]}
  #define PIN(x) asm volatile("":"+v"(x))
  #define MX3(a,b,c) __builtin_fmaxf(__builtin_fmaxf((a),(b)),(c))
  #define GAPA(MF,A0,A1,A2,A3,W0,W1,PW) do{ MF; sacc+=A0; sacc+=A1; sacc+=A2; sacc+=A3; PIN(sacc); W0; W1; PIN(PW); SBAR(); }while(0)
  #define EX(v) __builtin_amdgcn_exp2f(v)
  #define GAPB(MF,X,B) do{ MF; X[B]=EX(X[B]); X[B+1]=EX(X[B+1]); X[B+2]=EX(X[B+2]); X[B+3]=EX(X[B+3]); PIN(X); SBAR(); }while(0)
  #define VRD(i) do{ vlo[i]=vtr(vp_+(((i)>>2)*4096+((i)&3)*1024)); vhi[i]=vtr(vp_+(((i)>>2)*4096+((i)&3)*1024+512)); }while(0)
  #define KRD(G,j) do{ if(G){ kload2(kf,kp0+sl_next,j); SBAR(); } }while(0)
  #define STEP(C0,C1,P0,P1,t,GK,GV,GL) do{ SBAR(); \
    const lds_cptr vp_=vp0+sl_prev; \
    VRD(0); SBAR(); float sacc=(P0[0]+P0[1]); \
    GAPA(C0=__builtin_amdgcn_mfma_f32_32x32x16_bf16(kf[0],qr[0],negm,0,0,0), P0[2],P0[3],P0[4],P0[5],     pw0[0]=PKW(P0,0), pw0[1]=PKW(P0,2), pw0); \
    VRD(4); SBAR(); GAPA(C1=__builtin_amdgcn_mfma_f32_32x32x16_bf16(kf[1],qr[0],negm,0,0,0), P0[6],P0[7],P0[8],P0[9],     pw0[2]=PKW(P0,4), pw0[3]=PKW(P0,6), pw0); \
    VRD(1); SBAR(); GAPA(C0=__builtin_amdgcn_mfma_f32_32x32x16_bf16(kf[2],qr[1],C0,0,0,0),   P0[10],P0[11],P0[12],P0[13], pw1[0]=PKW(P0,8), pw1[1]=PKW(P0,10), pw1); \
    VRD(5); SBAR(); GAPA(C1=__builtin_amdgcn_mfma_f32_32x32x16_bf16(kf[3],qr[1],C1,0,0,0),   P0[14],P0[15],P1[0],P1[1],   pw1[2]=PKW(P0,12),pw1[3]=PKW(P0,14), pw1); \
    VRD(2); SBAR(); GAPA(C0=__builtin_amdgcn_mfma_f32_32x32x16_bf16(kf[4],qr[2],C0,0,0,0),   P1[2],P1[3],P1[4],P1[5],     pw2[0]=PKW(P1,0), pw2[1]=PKW(P1,2), pw2); \
    VRD(6); SBAR(); GAPA(C1=__builtin_amdgcn_mfma_f32_32x32x16_bf16(kf[5],qr[2],C1,0,0,0),   P1[6],P1[7],P1[8],P1[9],     pw2[2]=PKW(P1,4), pw2[3]=PKW(P1,6), pw2); \
    VRD(3); SBAR(); GAPA(C0=__builtin_amdgcn_mfma_f32_32x32x16_bf16(kf[6],qr[3],C0,0,0,0),   P1[10],P1[11],P1[12],P1[13], pw3[0]=PKW(P1,8), pw3[1]=PKW(P1,10), pw3); \
    VRD(7); SBAR(); GAPA(C1=__builtin_amdgcn_mfma_f32_32x32x16_bf16(kf[7],qr[3],C1,0,0,0),   P1[14],P1[15],0.f,0.f,       pw3[2]=PKW(P1,12),pw3[3]=PKW(P1,14), pw3); \
    l_reg+=sacc; \
    if(GK){DMA_K((t)+3,sl_cur);} if(GV){DMA_V((t)+1,sl_next);} \
    KBIAS(C0,C1,t); CMASK(C0,C1,t); \
    { float a=MX3(C0[0],C0[1],C1[0]),b=MX3(C0[2],C0[3],C1[1]); a=MX3(a,C1[2],C1[3]); \
      _Pragma("unroll") for(int r=4;r<16;r+=4){a=MX3(a,C0[r],C0[r+1]);b=MX3(b,C0[r+2],C0[r+3]);a=MX3(a,C1[r],C1[r+1]);b=MX3(b,C1[r+2],C1[r+3]);} \
      float rm=__builtin_fmaxf(a,b); { auto rr=__builtin_amdgcn_permlane32_swap(__float_as_uint(rm),__float_as_uint(rm),false,false); rm=__builtin_fmaxf(__uint_as_float(rr[0]),__uint_as_float(rr[1])); } \
      resc=false; \
      if(__builtin_expect(__any(rm>(float)THRL),0)){ const float dl=__builtin_fmaxf(rm,0.f); mhat+=dl; \
        _Pragma("unroll") for(int r=0;r<16;++r){C0[r]-=dl;C1[r]-=dl;} \
        const float f=__builtin_amdgcn_exp2f(-dl); l_reg*=f; if(hi==0)wsf[r32]=f; resc=true; } } \
    SBAR(); \
    GAPB(o[0]=__builtin_amdgcn_mfma_f32_32x32x16_bf16(PAF(0),VFR(0),o[0],0,0,0), C0,0); \
    GAPB(o[1]=__builtin_amdgcn_mfma_f32_32x32x16_bf16(PAF(0),VFR(4),o[1],0,0,0), C0,4); \
    KRD(GL,0); GAPB(o[0]=__builtin_amdgcn_mfma_f32_32x32x16_bf16(PAF(1),VFR(1),o[0],0,0,0), C0,8); \
    KRD(GL,1); GAPB(o[1]=__builtin_amdgcn_mfma_f32_32x32x16_bf16(PAF(1),VFR(5),o[1],0,0,0), C0,12); \
    KRD(GL,2); GAPB(o[0]=__builtin_amdgcn_mfma_f32_32x32x16_bf16(PAF(2),VFR(2),o[0],0,0,0), C1,0); \
    KRD(GL,3); GAPB(o[1]=__builtin_amdgcn_mfma_f32_32x32x16_bf16(PAF(2),VFR(6),o[1],0,0,0), C1,4); \
    GAPB(o[0]=__builtin_amdgcn_mfma_f32_32x32x16_bf16(PAF(3),VFR(3),o[0],0,0,0), C1,8); \
    GAPB(o[1]=__builtin_amdgcn_mfma_f32_32x32x16_bf16(PAF(3),VFR(7),o[1],0,0,0), C1,12); \
    }while(0)
  int t=1;
  #undef CMASK
  #define CMASK(P0,P1,t) do{}while(0)
  for(;t+5<NT;t+=2){
    STEP(pB0,pB1,pA0,pA1,t,true,true,true);     WAIT_BAR(2); RESC(); ROT();
    STEP(pA0,pA1,pB0,pB1,t+1,true,true,true);   WAIT_BAR(2); RESC(); ROT();
  }
  #undef CMASK
  #define CMASK(P0,P1,t) do{int jb_=(t)-(NT-4); if(jb_>=0)cmask(P0,P1,jb_,qrel,hi);}while(0)
  #define ENDW(tt) do{ if((tt)+3<NT){WAIT_BAR(2);} else if((tt)+2<NT){WAIT_BAR(1);} else {WAIT_BAR(0);} }while(0)
  for(;t+1<NT;t+=2){
    STEP(pB0,pB1,pA0,pA1,t,(t+3<NT),(t+1<NT),(t+1<NT));       ENDW(t);   RESC(); ROT();
    STEP(pA0,pA1,pB0,pB1,t+1,(t+4<NT),(t+2<NT),(t+2<NT));     ENDW(t+1); RESC(); ROT();
  }
  STEP(pB0,pB1,pA0,pA1,NT-1,false,false,false); RESC();
  { float sacc=pB0[0]+pB0[1]; _Pragma("unroll") for(int r=2;r<16;++r)sacc+=pB0[r]; _Pragma("unroll") for(int r=0;r<16;++r)sacc+=pB1[r]; l_reg+=sacc;
    pw0=(u32x4){PKW(pB0,0),PKW(pB0,2),PKW(pB0,4),PKW(pB0,6)};pw1=(u32x4){PKW(pB0,8),PKW(pB0,10),PKW(pB0,12),PKW(pB0,14)};pw2=(u32x4){PKW(pB1,0),PKW(pB1,2),PKW(pB1,4),PKW(pB1,6)};pw3=(u32x4){PKW(pB1,8),PKW(pB1,10),PKW(pB1,12),PKW(pB1,14)};
    SBAR(); pv(o,vb0+sl_cur,PAF(0),PAF(1),PAF(2),PAF(3)); }
  #undef PKW
  #undef PAF
  #undef VFR
  #undef PIN
  #undef MX3
  #undef GAPA
  #undef GAPB
  #undef EX
  #undef VRD
  #undef KRD
  #undef STEP
  #undef ENDW
  {auto rr=__builtin_amdgcn_permlane32_swap(__float_as_uint(l_reg),__float_as_uint(l_reg),false,false);l_reg=__uint_as_float(rr[0])+__uint_as_float(rr[1]);}
  if(hi==0)wsf[32+r32]=l_reg;asm volatile("s_waitcnt lgkmcnt(0)":::"memory");
  float rli[16];
  #pragma unroll
  for(int r=0;r<16;++r)rli[r]=__builtin_amdgcn_rcpf(wsf[32+crow(r,hi)]);
  bf16*Ow=O+(rowbase+q0+wid*QBLK)*DM+h*D;
  { bf16*stg=(bf16*)(shm+LDS_OST)+wid*2048;
    #pragma unroll
    for(int r=0;r<16;++r){const int orow=crow(r,hi);
      #pragma unroll
      for(int d0=0;d0<2;++d0)stg[orow*64+d0*32+r32]=__float2bfloat16(o[d0][r]*rli[r]);}
    asm volatile("s_waitcnt lgkmcnt(0)":::"memory");
    #pragma unroll
    for(int i=0;i<4;++i){const int row=i*8+(lane>>3),ch=lane&7; const u32x4 v=*(const u32x4*)(stg+row*64+ch*8); ATTN_STORE16(Ow+(long)row*DM+ch*8,v);} }
  asm volatile("s_waitcnt lgkmcnt(0)\n\ts_barrier":::"memory");
  #undef KBIAS
  #undef DMA_K
  #undef DMA_V
  #undef CMASK
  #undef START
  #undef RESC
  #undef ROT
}
template<bool WIN,int THRL> __device__ __forceinline__ void nsa_branch_pipe(const bf16*__restrict__ Kb,const bf16*__restrict__ Vb,const __attribute__((address_space(3))) int*tl,int NT,int qc,const bf16x8*qr,unsigned selbits,
    const __attribute__((address_space(3))) float*luth,char*shm,float&l_out,f32x16(&o)[2]){
  int tid=threadIdx.x; asm volatile("":"+v"(tid));
  const int lane=tid&63,r32=lane&31,hi=lane>>5; const int wid=__builtin_amdgcn_readfirstlane(tid>>6);
  const unsigned lds0=(unsigned)(uintptr_t)shm;
  float*wsf=(float*)(shm+LDS_WS)+wid*64;
  const unsigned koff=(unsigned)(lane*64+wid*8)*2u, voff=(unsigned)((16*(wid&3)+(lane>>2))*64+(wid>>2)*32+(lane&3)*8)*2u;
  #define TLJ(t) (__builtin_amdgcn_readfirstlane(tl[t])&63)
  const unsigned kdst=lds0+LDS_K+wid*1024, vdst=lds0+LDS_V+wid*1024;
  #define DMA_K(t,slot) glds16s((const char*)Kb+(size_t)TLJ(t)*8192,koff,(unsigned)__builtin_amdgcn_readfirstlane(kdst+(slot)))
  #define DMA_V(t,slot) glds16s((const char*)Vb+(size_t)TLJ(t)*8192,voff,(unsigned)__builtin_amdgcn_readfirstlane(vdst+(slot)))
  const int vb0=(int)(lds0+LDS_V)+((lane>>4)&1)*32+(lane&3)*8+(4*hi+((lane&15)>>2))*64;
  const char*Kbase=shm+LDS_K; bf16x8 kf[8];
  const lds_cptr shm3=(lds_cptr)shm; const lds_cptr kp0=shm3+LDS_K+hi*1024+r32*16; const lds_cptr vp0=shm3+LDS_V+((lane>>4)&1)*32+(lane&3)*8+(4*hi+((lane&15)>>2))*64;
  DMA_K(0,0);DMA_V(0,0);DMA_K(1,SLOTB);
  const int qi=(wid&1)*QBLK+r32;
  float mhat=0.f,l_reg=0.f;o[0]=f32x16{};o[1]=f32x16{};const f32x16 negm=f32x16{};
  unsigned amA=0xffffffffu,amB=0xffffffffu;
  #define NSAHOOK(C0,C1,t,AM) do{ const int e_=__builtin_amdgcn_readfirstlane(tl[t]); const int j_=e_&63, dq_=qc-j_; \
    { const float nm_=-mhat; _Pragma("unroll") for(int r_=0;r_<16;++r_){ C0[r_]+=nm_; C1[r_]+=nm_; } } \
    if(dq_<=2){ const volatile __attribute__((address_space(3))) float*lp_=luth+(64*dq_+qi+1-4*hi);     \
      _Pragma("unroll") for(int r_=0;r_<16;++r_){ const int ko_=(r_&3)+8*(r_>>2); C0[r_]+=lp_[63-ko_]; C1[r_]+=lp_[31-ko_]; } } \
    if(dq_==0){ _Pragma("unroll") for(int r_=0;r_<16;++r_){ const int kid_=4*hi+(r_&3)+8*(r_>>2); if(kid_>qi)C0[r_]=-1e30f; if(kid_+32>qi)C1[r_]=-1e30f; } } \
    if(WIN&&dq_==8){ _Pragma("unroll") for(int r_=0;r_<16;++r_){ const int kid_=4*hi+(r_&3)+8*(r_>>2); if(kid_<=qi)C0[r_]=-1e30f; if(kid_+32<=qi)C1[r_]=-1e30f; } } \
    AM=((e_>=0)&&(WIN||((selbits>>j_)&1u)))?0xffffffffu:0u; }while(0)
  bool resc=false;
  #define START(P0,P1) do{ const float rm=rowmax(P0,P1); resc=false; \
    { const float dl=__builtin_fmaxf(rm,-100.f); mhat=fadd_s(mhat,dl);     \
      _Pragma("unroll") for(int r=0;r<16;++r){P0[r]=fsub_s(P0[r],dl);P1[r]=fsub_s(P1[r],dl);} \
      } \
    _Pragma("unroll") for(int r=0;r<16;++r)P0[r]=__builtin_amdgcn_exp2f(P0[r]); }while(0)
  #define RESC() do{ if(resc){ asm volatile("s_waitcnt lgkmcnt(0)":::"memory"); \
      _Pragma("unroll") for(int d_=0;d_<2;++d_) _Pragma("unroll") for(int r=0;r<16;++r)o[d_][r]*=wsf[crow(r,hi)]; } }while(0)
  f32x16 pA0,pA1,pB0,pB1;
  int sl_prev=0,sl_cur=0,sl_next=SLOTB;
  #define ROT() do{sl_prev=sl_cur;sl_cur=sl_next;sl_next=(sl_next==(NSLOT-1)*SLOTB)?0:sl_next+SLOTB;}while(0)
  DMA_K(2,2*SLOTB);
  WAIT_BAR(3);
  qkt(pA0,pA1,Kbase,qr,negm,r32,hi);asm volatile("s_nop 15\n\ts_nop 7":"+v"(pA0),"+v"(pA1));NSAHOOK(pA0,pA1,0,amA);
  START(pA0,pA1);
  _Pragma("unroll") for(int r=0;r<16;++r)pA1[r]=__builtin_amdgcn_exp2f(pA1[r]);
  WAIT_BAR(0);
  DMA_K(3,0);DMA_V(1,SLOTB);
  ROT();
  kload8(kf,kp0+sl_cur);
  WAIT_BAR(2);
  s16x4 vlo[8],vhi[8]; u32x4 pw0,pw1,pw2,pw3;
  #define PKW(P,B) cvtpk_s(P[B],P[B+1])
  #define PAF(k) __builtin_bit_cast(bf16x8,pw##k)
  #define VFR(i) (bf16x8){vlo[i][0],vlo[i][1],vlo[i][2],vlo[i][3],vhi[i][0],vhi[i][1],vhi[i][2],vhi[i][3]}
  #define PIN(x) asm volatile("":"+v"(x))
  #define MX3(a,b,c) __builtin_fmaxf(__builtin_fmaxf((a),(b)),(c))
  #define GAPA(MF,A0,A1,A2,A3,W0,W1,PW) do{ MF; sacc+=A0; sacc+=A1; sacc+=A2; sacc+=A3; PIN(sacc); W0; W1; PIN(PW); SBAR(); }while(0)
  #define EX(v) __builtin_amdgcn_exp2f(v)
  #define GAPB(MF,X,B) do{ MF; X[B]=EX(X[B]); X[B+1]=EX(X[B+1]); X[B+2]=EX(X[B+2]); X[B+3]=EX(X[B+3]); PIN(X); SBAR(); }while(0)
  #define VRD(i) do{ vlo[i]=vtr(vp_+(((i)>>2)*4096+((i)&3)*1024)); vhi[i]=vtr(vp_+(((i)>>2)*4096+((i)&3)*1024+512)); }while(0)
  #define KRD(G,j) do{ if(G){ kload2(kf,kp0+sl_next,j); SBAR(); } }while(0)
  #define STEP(C0,C1,P0,P1,t,GK,GV,GL,AMC,AMP) do{ SBAR(); \
    const lds_cptr vp_=vp0+sl_prev; \
    VRD(0); SBAR(); float sacc=(P0[0]+P0[1]); \
    GAPA(C0=__builtin_amdgcn_mfma_f32_32x32x16_bf16(kf[0],qr[0],negm,0,0,0), P0[2],P0[3],P0[4],P0[5],     pw0[0]=PKW(P0,0)&AMP, pw0[1]=PKW(P0,2)&AMP, pw0); \
    VRD(4); SBAR(); GAPA(C1=__builtin_amdgcn_mfma_f32_32x32x16_bf16(kf[1],qr[0],negm,0,0,0), P0[6],P0[7],P0[8],P0[9],     pw0[2]=PKW(P0,4)&AMP, pw0[3]=PKW(P0,6)&AMP, pw0); \
    VRD(1); SBAR(); GAPA(C0=__builtin_amdgcn_mfma_f32_32x32x16_bf16(kf[2],qr[1],C0,0,0,0),   P0[10],P0[11],P0[12],P0[13], pw1[0]=PKW(P0,8)&AMP, pw1[1]=PKW(P0,10)&AMP, pw1); \
    VRD(5); SBAR(); GAPA(C1=__builtin_amdgcn_mfma_f32_32x32x16_bf16(kf[3],qr[1],C1,0,0,0),   P0[14],P0[15],P1[0],P1[1],   pw1[2]=PKW(P0,12)&AMP,pw1[3]=PKW(P0,14)&AMP, pw1); \
    VRD(2); SBAR(); GAPA(C0=__builtin_amdgcn_mfma_f32_32x32x16_bf16(kf[4],qr[2],C0,0,0,0),   P1[2],P1[3],P1[4],P1[5],     pw2[0]=PKW(P1,0)&AMP, pw2[1]=PKW(P1,2)&AMP, pw2); \
    VRD(6); SBAR(); GAPA(C1=__builtin_amdgcn_mfma_f32_32x32x16_bf16(kf[5],qr[2],C1,0,0,0),   P1[6],P1[7],P1[8],P1[9],     pw2[2]=PKW(P1,4)&AMP, pw2[3]=PKW(P1,6)&AMP, pw2); \
    VRD(3); SBAR(); GAPA(C0=__builtin_amdgcn_mfma_f32_32x32x16_bf16(kf[6],qr[3],C0,0,0,0),   P1[10],P1[11],P1[12],P1[13], pw3[0]=PKW(P1,8)&AMP, pw3[1]=PKW(P1,10)&AMP, pw3); \
    VRD(7); SBAR(); GAPA(C1=__builtin_amdgcn_mfma_f32_32x32x16_bf16(kf[7],qr[3],C1,0,0,0),   P1[14],P1[15],0.f,0.f,       pw3[2]=PKW(P1,12)&AMP,pw3[3]=PKW(P1,14)&AMP, pw3); \
    l_reg+=(AMP?sacc:0.f); \
    if(GK){DMA_K((t)+3,sl_cur);} if(GV){DMA_V((t)+1,sl_next);} \
    NSAHOOK(C0,C1,t,AMC); \
    { float a=MX3(C0[0],C0[1],C1[0]),b=MX3(C0[2],C0[3],C1[1]); a=MX3(a,C1[2],C1[3]); \
      _Pragma("unroll") for(int r=4;r<16;r+=4){a=MX3(a,C0[r],C0[r+1]);b=MX3(b,C0[r+2],C0[r+3]);a=MX3(a,C1[r],C1[r+1]);b=MX3(b,C1[r+2],C1[r+3]);} \
      float rm=__builtin_fmaxf(a,b); { auto rr=__builtin_amdgcn_permlane32_swap(__float_as_uint(rm),__float_as_uint(rm),false,false); rm=__builtin_fmaxf(__uint_as_float(rr[0]),__uint_as_float(rr[1])); } \
      rm=AMC?rm:-1e30f; resc=false; \
      if(__builtin_expect(__any(rm>(float)THRL),0)){ const float dl=__builtin_fmaxf(rm,0.f); mhat+=dl; \
        _Pragma("unroll") for(int r=0;r<16;++r){C0[r]-=dl;C1[r]-=dl;} \
        const float f=__builtin_amdgcn_exp2f(-dl); l_reg*=f; if(hi==0)wsf[r32]=f; resc=true; } } \
    SBAR(); \
    GAPB(o[0]=__builtin_amdgcn_mfma_f32_32x32x16_bf16(PAF(0),VFR(0),o[0],0,0,0), C0,0); \
    GAPB(o[1]=__builtin_amdgcn_mfma_f32_32x32x16_bf16(PAF(0),VFR(4),o[1],0,0,0), C0,4); \
    KRD(GL,0); GAPB(o[0]=__builtin_amdgcn_mfma_f32_32x32x16_bf16(PAF(1),VFR(1),o[0],0,0,0), C0,8); \
    KRD(GL,1); GAPB(o[1]=__builtin_amdgcn_mfma_f32_32x32x16_bf16(PAF(1),VFR(5),o[1],0,0,0), C0,12); \
    KRD(GL,2); GAPB(o[0]=__builtin_amdgcn_mfma_f32_32x32x16_bf16(PAF(2),VFR(2),o[0],0,0,0), C1,0); \
    KRD(GL,3); GAPB(o[1]=__builtin_amdgcn_mfma_f32_32x32x16_bf16(PAF(2),VFR(6),o[1],0,0,0), C1,4); \
    GAPB(o[0]=__builtin_amdgcn_mfma_f32_32x32x16_bf16(PAF(3),VFR(3),o[0],0,0,0), C1,8); \
    GAPB(o[1]=__builtin_amdgcn_mfma_f32_32x32x16_bf16(PAF(3),VFR(7),o[1],0,0,0), C1,12); \
    }while(0)
  int t=1;
  for(;t+5<NT;t+=2){
    STEP(pB0,pB1,pA0,pA1,t,true,true,true,amB,amA);     WAIT_BAR(2); RESC(); ROT();
    STEP(pA0,pA1,pB0,pB1,t+1,true,true,true,amA,amB);   WAIT_BAR(2); RESC(); ROT();
  }
  #define ENDW(tt) do{ if((tt)+3<NT){WAIT_BAR(2);} else if((tt)+2<NT){WAIT_BAR(1);} else {WAIT_BAR(0);} }while(0)
  for(;t+1<NT;t+=2){
    STEP(pB0,pB1,pA0,pA1,t,(t+3<NT),(t+1<NT),(t+1<NT),amB,amA);       ENDW(t);   RESC(); ROT();
    STEP(pA0,pA1,pB0,pB1,t+1,(t+4<NT),(t+2<NT),(t+2<NT),amA,amB);     ENDW(t+1); RESC(); ROT();
  }
  STEP(pB0,pB1,pA0,pA1,NT-1,false,false,false,amB,amA); RESC();
  { float sacc=pB0[0]+pB0[1]; _Pragma("unroll") for(int r=2;r<16;++r)sacc+=pB0[r]; _Pragma("unroll") for(int r=0;r<16;++r)sacc+=pB1[r]; l_reg+=(amB?sacc:0.f);
    pw0=(u32x4){PKW(pB0,0)&amB,PKW(pB0,2)&amB,PKW(pB0,4)&amB,PKW(pB0,6)&amB};pw1=(u32x4){PKW(pB0,8)&amB,PKW(pB0,10)&amB,PKW(pB0,12)&amB,PKW(pB0,14)&amB};pw2=(u32x4){PKW(pB1,0)&amB,PKW(pB1,2)&amB,PKW(pB1,4)&amB,PKW(pB1,6)&amB};pw3=(u32x4){PKW(pB1,8)&amB,PKW(pB1,10)&amB,PKW(pB1,12)&amB,PKW(pB1,14)&amB};
    SBAR(); pv(o,vb0+sl_cur,PAF(0),PAF(1),PAF(2),PAF(3)); }
  #undef PKW
  #undef PAF
  #undef VFR
  #undef PIN
  #undef MX3
  #undef GAPA
  #undef GAPB
  #undef EX
  #undef VRD
  #undef KRD
  #undef STEP
  #undef ENDW
  {auto rr=__builtin_amdgcn_permlane32_swap(__float_as_uint(l_reg),__float_as_uint(l_reg),false,false);l_out=__uint_as_float(rr[0])+__uint_as_float(rr[1]);}
  asm volatile("s_waitcnt lgkmcnt(0)\n\ts_barrier":::"memory");
  #undef NSAHOOK
  #undef TLJ
  #undef DMA_K
  #undef DMA_V
  #undef START
  #undef RESC
  #undef ROT
}
constexpr int ATTN_LDS_BYTES=LDS_BYTES;
struct AttnTensors { const bf16* Q; const bf16* K; const bf16* V; bf16* O; };
struct AttnUnit { int bh; int qb; };
#undef SBAR
#undef WAIT_BAR
}
namespace nsa {
using namespace attn_body;
typedef __attribute__((address_space(3))) char* lds_ptr;
typedef __attribute__((address_space(3))) float* lds_fptr;
typedef float f32x4_t __attribute__((ext_vector_type(4)));
constexpr int L_K = LDS_K, L_V = LDS_V, L_WS = LDS_WS, L_OST = LDS_WS + 2048;
constexpr int L_IMP = L_OST;
constexpr int L_IMPT = L_K + 2 * 8192;
constexpr int L_LUTPAD = L_OST + 65536, L_LUT = L_LUTPAD + 64;
constexpr int L_MASK = L_LUT + 4096 + 192;
constexpr int L_TL = L_MASK + 256;
constexpr int L_GATE = L_TL + 384;
constexpr int NSA_LDS_END = L_GATE + 8 * 3 * 64 * 4;
#define NSA_WAIT_BAR(N) asm volatile("s_waitcnt vmcnt(" #N ") lgkmcnt(0)\n\ts_barrier" ::: "memory")
#define NSA_SBAR() __builtin_amdgcn_sched_barrier(0)

__device__ __forceinline__ float rowmax_cv(const f32x16& p0, const f32x16& p1) {
    float a = __builtin_fmaxf(p0[0], p1[0]), b = __builtin_fmaxf(p0[1], p1[1]);
#pragma unroll
    for (int r = 2; r < 16; r += 2) { a = __builtin_fmaxf(a, __builtin_fmaxf(p0[r], p1[r])); b = __builtin_fmaxf(b, __builtin_fmaxf(p0[r + 1], p1[r + 1])); }
    const float m = __builtin_fmaxf(a, b);
    return __builtin_fmaxf(m, __shfl_xor(m, 32));
}
__device__ __forceinline__ bf16x8 pack8f(const f32x16& p, int base, unsigned amask) {
    u32x4 w; w[0] = cvtpk_s(p[base], p[base + 1]) & amask; w[1] = cvtpk_s(p[base + 2], p[base + 3]) & amask; w[2] = cvtpk_s(p[base + 4], p[base + 5]) & amask; w[3] = cvtpk_s(p[base + 6], p[base + 7]) & amask;
    return __builtin_bit_cast(bf16x8, w);
}
__device__ __forceinline__ void pv2(f32x16 (&o)[2], int vb, bf16x8 pa0, bf16x8 pa1, bf16x8 pa2, bf16x8 pa3) {
    s16x4 lo[2][4], hi[2][4];
#pragma unroll
    for (int d0 = 0; d0 < 2; ++d0)
#pragma unroll
        for (int ks = 0; ks < 4; ++ks) {
            asm volatile("ds_read_b64_tr_b16 %0,%1 offset:%c2" : "=&v"(lo[d0][ks]) : "v"(vb), "i"(d0 * 4096 + ks * 1024) : "memory");
            asm volatile("ds_read_b64_tr_b16 %0,%1 offset:%c2" : "=&v"(hi[d0][ks]) : "v"(vb), "i"(d0 * 4096 + ks * 1024 + 512) : "memory"); }
    asm volatile("s_waitcnt lgkmcnt(0)" ::: "memory"); NSA_SBAR();
#define NSA_PK(d, k) (bf16x8){lo[d][k][0], lo[d][k][1], lo[d][k][2], lo[d][k][3], hi[d][k][0], hi[d][k][1], hi[d][k][2], hi[d][k][3]}
    o[0] = __builtin_amdgcn_mfma_f32_32x32x16_bf16(pa0, NSA_PK(0, 0), o[0], 0, 0, 0); o[1] = __builtin_amdgcn_mfma_f32_32x32x16_bf16(pa0, NSA_PK(1, 0), o[1], 0, 0, 0);
    o[0] = __builtin_amdgcn_mfma_f32_32x32x16_bf16(pa1, NSA_PK(0, 1), o[0], 0, 0, 0); o[1] = __builtin_amdgcn_mfma_f32_32x32x16_bf16(pa1, NSA_PK(1, 1), o[1], 0, 0, 0);
    o[0] = __builtin_amdgcn_mfma_f32_32x32x16_bf16(pa2, NSA_PK(0, 2), o[0], 0, 0, 0); o[1] = __builtin_amdgcn_mfma_f32_32x32x16_bf16(pa2, NSA_PK(1, 2), o[1], 0, 0, 0);
    o[0] = __builtin_amdgcn_mfma_f32_32x32x16_bf16(pa3, NSA_PK(0, 3), o[0], 0, 0, 0); o[1] = __builtin_amdgcn_mfma_f32_32x32x16_bf16(pa3, NSA_PK(1, 3), o[1], 0, 0, 0);
#undef NSA_PK
}
__device__ __forceinline__ void stash_acc(lds_fptr stash, const f32x16 (&ob)[2], float f, lds_fptr wsf, int lane, int r32, int hi, bool first) {
    if (hi == 0) wsf[r32] = f;
    asm volatile("s_waitcnt lgkmcnt(0)" ::: "memory");
#pragma unroll
    for (int g = 0; g < 4; ++g) { const f32x4_t fv = *(const __attribute__((address_space(3))) f32x4_t*)(wsf + 8 * g + 4 * hi);
#pragma unroll
        for (int e = 0; e < 4; ++e) { const int r = 4 * g + e;
#pragma unroll
            for (int d0 = 0; d0 < 2; ++d0) { const lds_fptr p = stash + (d0 * 16 + r) * 64 + lane; float v = ob[d0][r] * fv[e]; if (!first) v += *p; *p = v; } } }
    asm volatile("s_waitcnt lgkmcnt(0)" ::: "memory");
}

__device__ __forceinline__ void nsa_unit(int b, int g, int qc, const bf16* Q, const bf16* KV, const bf16* KC2, size_t kvstride, size_t kc2stride, const float* gates, const float* lutg, bf16* O, char* shm) {
    int tid = threadIdx.x; asm volatile("" : "+v"(tid));
    const int lane = tid & 63, r32 = lane & 31, hi = lane >> 5; const int wid = __builtin_amdgcn_readfirstlane(tid >> 6);
    const int hr = wid >> 1, qh = wid & 1, hh = g * 4 + hr, bg = b * 4 + g;
    const int qi = 32 * qh + r32, t = 64 * qc + qi;
    const size_t tok = (size_t)b * SEQ + t;
    const lds_ptr shm3 = (lds_ptr)shm; const unsigned lds0 = (unsigned)(uintptr_t)shm;
    const lds_fptr lutN = (lds_fptr)(shm3 + L_LUT); const lds_fptr wsf = (lds_fptr)(shm3 + L_WS) + wid * 64;
    const bf16* Qw = Q + ((size_t)b * SEQ + 64 * qc + 32 * qh) * 1024 + hh * 64;
    bf16x8 qr[4];
#pragma unroll
    for (int d0 = 0; d0 < 4; ++d0) qr[d0] = *reinterpret_cast<const bf16x8*>(&Qw[(size_t)r32 * 1024 + d0 * 16 + hi * 8]);
    const lds_fptr gl = (lds_fptr)(shm3 + L_GATE) + wid * 192;
    { const float* gt = gates + tok * 48; const float g0 = gt[hh], g1 = gt[16 + hh], g2 = gt[32 + hh];
      const bf16* kcm = KC2 + (size_t)bg * 128 * 64; const bf16* vcm = KC2 + kc2stride + (size_t)bg * 128 * 64;
      const bf16* ksrc = kcm + (size_t)lane * 64 + wid * 8;
      const bf16* vsrc = vcm + (size_t)(16 * (wid & 3) + (lane >> 2)) * 64 + (wid >> 2) * 32 + (lane & 3) * 8;
      glds16(ksrc, (unsigned)__builtin_amdgcn_readfirstlane(lds0 + L_K + wid * 1024)); glds16(vsrc, (unsigned)__builtin_amdgcn_readfirstlane(lds0 + L_V + wid * 1024));
      glds16(ksrc + 4096, (unsigned)__builtin_amdgcn_readfirstlane(lds0 + L_K + 8192 + wid * 1024)); glds16(vsrc + 4096, (unsigned)__builtin_amdgcn_readfirstlane(lds0 + L_V + 8192 + wid * 1024));
      for (int e = tid; e < 1024; e += 512) { const int hd = e >> 8, rel = (e & 255) - 64; const float* lg = lutg + (g * 4 + hd) * 132; const float lv = lg[rel < 0 ? 0 : (rel > 128 ? 128 : rel)] - lg[128]; lutN[e] = rel < 0 ? 0.f : lv; }
      if (tid < 16) ((lds_fptr)(shm3 + L_LUTPAD))[tid] = 0.f;
      gl[lane] = g0; gl[64 + lane] = g1; gl[128 + lane] = g2; }
    NSA_WAIT_BAR(0);
    const lds_fptr stash = (lds_fptr)(shm3 + L_OST) + wid * 2048;
    f32x16 obc[2]; obc[0] = f32x16{}; obc[1] = f32x16{};
    {
        const f32x16 zero = f32x16{};
        f32x16 pc[2][2];
        qkt(pc[0][0], pc[0][1], shm + L_K, qr, zero, r32, hi);
        qkt(pc[1][0], pc[1][1], shm + L_K + 8192, qr, zero, r32, hi);
        const lds_fptr lh = lutN + hr * 256 + 64;
        float mx = -1e30f;
        {
            const volatile __attribute__((address_space(3))) float* lhv = lh;
            f32x16 lv[2][2];
#pragma unroll
            for (int T = 0; T < 2; ++T)
#pragma unroll
                for (int v = 0; v < 2; ++v)
#pragma unroll
                    for (int r = 0; r < 16; ++r) { const int c = 64 * T + 32 * v + 4 * hi + (r & 3) + 8 * (r >> 2); const int rel = t - 31 - 16 * c; lv[T][v][r] = lhv[rel < 0 ? 0 : (rel > 128 ? 128 : rel)]; }
#pragma unroll
            for (int T = 0; T < 2; ++T)
#pragma unroll
                for (int v = 0; v < 2; ++v)
#pragma unroll
                    for (int r = 0; r < 16; ++r) { const int c = 64 * T + 32 * v + 4 * hi + (r & 3) + 8 * (r >> 2); const int rel = t - 31 - 16 * c; const bool ok = (rel >= 0) && (c <= 126);
                        const float x = ok ? pc[T][v][r] + lv[T][v][r] : -1e30f; pc[T][v][r] = x; mx = __builtin_fmaxf(mx, x); }
        }
        mx = __builtin_fmaxf(mx, __shfl_xor(mx, 32));
        float ls = 0.f;
#pragma unroll
        for (int T = 0; T < 2; ++T)
#pragma unroll
            for (int v = 0; v < 2; ++v)
#pragma unroll
                for (int r = 0; r < 16; ++r) { const float x = pc[T][v][r]; const float p = (x > -1e29f) ? __builtin_amdgcn_exp2f(x - mx) : 0.f; pc[T][v][r] = p; ls += p; }
        ls += __shfl_xor(ls, 32);
        const float inv = ls > 0.f ? 1.0f / ls : 0.f;
#pragma unroll
        for (int T = 0; T < 2; ++T)
#pragma unroll
            for (int v = 0; v < 2; ++v)
#pragma unroll
                for (int r = 0; r < 16; ++r) pc[T][v][r] *= inv;
        {
            float Gv[16], Ev[16], Er[16];
#pragma unroll
            for (int n = 0; n < 16; ++n) { const int T = n >> 3, v = (n >> 2) & 1, gI = n & 3; const f32x16& pp = pc[T][v];
                Gv[n] = (pp[4 * gI] + pp[4 * gI + 1]) + (pp[4 * gI + 2] + pp[4 * gI + 3]); Ev[n] = pp[4 * gI + 3]; }
#pragma unroll
            for (int n = 0; n < 16; ++n) Er[n] = __shfl_xor(Ev[n], 32);
            const lds_fptr impw = (lds_fptr)(shm3 + L_IMP) + (hr * 64 + qi) * 32 + hi;
#pragma unroll
            for (int n = 0; n < 16; ++n) { const float prev = hi ? Er[n] : (n > 0 ? Er[n > 0 ? n - 1 : 0] : 0.f); impw[2 * n] = Gv[n] + prev; }
        }
        const int vb0 = (int)(lds0 + L_V) + ((lane >> 4) & 1) * 32 + (lane & 3) * 8 + (4 * hi + ((lane & 15) >> 2)) * 64;
#pragma unroll
        for (int T = 0; T < 2; ++T) {
            const bf16x8 pa0 = pack8f(pc[T][0], 0, 0xffffffffu), pa1 = pack8f(pc[T][0], 8, 0xffffffffu), pa2 = pack8f(pc[T][1], 0, 0xffffffffu), pa3 = pack8f(pc[T][1], 8, 0xffffffffu);
            NSA_SBAR();
            pv2(obc, vb0 + T * 8192, pa0, pa1, pa2, pa3);
        }
    }
    asm volatile("s_waitcnt lgkmcnt(0)\n\ts_barrier" ::: "memory");
    unsigned selm, uni;
    if (qc >= 16) {
        const lds_fptr ip = (lds_fptr)(shm3 + L_IMP); const lds_fptr it = (lds_fptr)(shm3 + L_IMPT);
        const int q = tid >> 3, jj = tid & 7;
        {
            f32x4_t s = *(const __attribute__((address_space(3))) f32x4_t*)(ip + (0 * 64 + q) * 32 + 4 * jj);
            s += *(const __attribute__((address_space(3))) f32x4_t*)(ip + (1 * 64 + q) * 32 + 4 * jj);
            s += *(const __attribute__((address_space(3))) f32x4_t*)(ip + (2 * 64 + q) * 32 + 4 * jj);
            s += *(const __attribute__((address_space(3))) f32x4_t*)(ip + (3 * 64 + q) * 32 + 4 * jj);
            *(__attribute__((address_space(3))) f32x4_t*)(it + q * 32 + 4 * jj) = s;
        }
        asm volatile("s_waitcnt lgkmcnt(0)\n\ts_barrier" ::: "memory");
        {
            const f32x4_t v = *(const __attribute__((address_space(3))) f32x4_t*)(it + q * 32 + 4 * jj);
            int rk0 = 0, rk1 = 0, rk2 = 0, rk3 = 0;
#pragma unroll
            for (int ii = 0; ii < 8; ++ii) { const f32x4_t w = *(const __attribute__((address_space(3))) f32x4_t*)(it + q * 32 + 4 * ii);
#pragma unroll
                for (int e = 0; e < 4; ++e) { const int i = 4 * ii + e; const bool in = (i >= 1) & (i <= qc - 2); const float vi = w[e];
                    rk0 += (int)(in & ((vi > v[0]) | ((vi == v[0]) & (i < 4 * jj + 0)))); rk1 += (int)(in & ((vi > v[1]) | ((vi == v[1]) & (i < 4 * jj + 1))));
                    rk2 += (int)(in & ((vi > v[2]) | ((vi == v[2]) & (i < 4 * jj + 2)))); rk3 += (int)(in & ((vi > v[3]) | ((vi == v[3]) & (i < 4 * jj + 3)))); } }
            unsigned bits = 0u;
            { const int j = 4 * jj + 0; const bool forced = (j == 0) || (j == qc) || (j == qc - 1), cand = (j >= 1) && (j <= qc - 2); if (forced || (cand && rk0 < 13)) bits |= 1u << j; }
            { const int j = 4 * jj + 1; const bool forced = (j == 0) || (j == qc) || (j == qc - 1), cand = (j >= 1) && (j <= qc - 2); if (forced || (cand && rk1 < 13)) bits |= 1u << j; }
            { const int j = 4 * jj + 2; const bool forced = (j == 0) || (j == qc) || (j == qc - 1), cand = (j >= 1) && (j <= qc - 2); if (forced || (cand && rk2 < 13)) bits |= 1u << j; }
            { const int j = 4 * jj + 3; const bool forced = (j == 0) || (j == qc) || (j == qc - 1), cand = (j >= 1) && (j <= qc - 2); if (forced || (cand && rk3 < 13)) bits |= 1u << j; }
            bits |= (unsigned)__shfl_xor((int)bits, 1); bits |= (unsigned)__shfl_xor((int)bits, 2); bits |= (unsigned)__shfl_xor((int)bits, 4);
            if (jj == 0) ((__attribute__((address_space(3))) unsigned*)(shm3 + L_MASK))[q] = bits;
        }
        asm volatile("s_waitcnt lgkmcnt(0)\n\ts_barrier" ::: "memory");
        const __attribute__((address_space(3))) unsigned* mk = (const __attribute__((address_space(3))) unsigned*)(shm3 + L_MASK);
        selm = mk[qi];
        unsigned u = mk[lane];
#pragma unroll
        for (int o = 1; o < 64; o <<= 1) u |= (unsigned)__shfl_xor((int)u, o);
        uni = (unsigned)__builtin_amdgcn_readfirstlane((int)u);
    } else { selm = (2u << qc) - 1u; uni = selm; }
    stash_acc(stash, obc, gl[lane], wsf, lane, r32, hi, true);
    const int j0w = qc >= 8 ? qc - 8 : 0; const unsigned wt = ((2u << qc) - 1u) & ~((1u << j0w) - 1u);
    const int ns = __builtin_popcount(uni), nw = __builtin_popcount(wt);
    const int NTs = ns < 4 ? 4 : ns + (ns & 1), NTw = nw < 4 ? 4 : nw + (nw & 1);
    { __attribute__((address_space(3))) int* tls = (__attribute__((address_space(3))) int*)(shm3 + L_TL); int dmk = (int)0x80000000u; asm volatile("" : "+v"(dmk));
      if (tid < 32) { if ((uni >> tid) & 1u) tls[__builtin_popcount(uni & ((1u << tid) - 1u))] = tid; if (tid >= ns && tid < NTs) tls[tid] = dmk; if (tid == 0 && NTs > 32) tls[32] = dmk, tls[33] = dmk; }
      else if (tid < 64) { const int i = tid - 32; if ((wt >> i) & 1u) tls[48 + __builtin_popcount(wt & ((1u << i) - 1u))] = i; if (i >= nw && i < NTw) tls[48 + i] = dmk; } }
    asm volatile("s_waitcnt lgkmcnt(0)\n\ts_barrier" ::: "memory");
    const lds_fptr luth = lutN + hr * 256;
    const bf16* kvb = KV + (size_t)bg * SEQ * 64;
    { f32x16 ob[2]; float lt;
      nsa_branch_pipe<false, 32>(kvb + 2 * kvstride, kvb + 3 * kvstride, (const __attribute__((address_space(3))) int*)(shm3 + L_TL), NTs, qc, qr, selm, luth, shm, lt, ob);
      const float gs = gl[64 + lane]; stash_acc(stash, ob, lt > 0.f ? gs * __builtin_amdgcn_rcpf(lt) : 0.f, wsf, lane, r32, hi, false); }
    { f32x16 ob[2]; float lt;
      nsa_branch_pipe<true, 32>(kvb + 4 * kvstride, kvb + 5 * kvstride, (const __attribute__((address_space(3))) int*)(shm3 + L_TL) + 48, NTw, qc, qr, 0xffffffffu, luth, shm, lt, ob);
      const float gw = gl[128 + lane]; stash_acc(stash, ob, lt > 0.f ? gw * __builtin_amdgcn_rcpf(lt) : 0.f, wsf, lane, r32, hi, false); }
    bf16* Ow = O + ((size_t)b * SEQ + 64 * qc + 32 * qh) * 1024 + hh * 64;
    { f32x16 ot[2];
#pragma unroll
      for (int d0 = 0; d0 < 2; ++d0)
#pragma unroll
          for (int r = 0; r < 16; ++r) ot[d0][r] = stash[(d0 * 16 + r) * 64 + lane];
      asm volatile("s_waitcnt lgkmcnt(0)" ::: "memory");
      bf16* stg = (bf16*)(shm + L_OST) + wid * 4096;
#pragma unroll
      for (int r = 0; r < 16; ++r) { const int orow = crow(r, hi);
#pragma unroll
          for (int d0 = 0; d0 < 2; ++d0) stg[orow * 64 + d0 * 32 + r32] = __float2bfloat16(ot[d0][r]); }
      asm volatile("s_waitcnt lgkmcnt(0)" ::: "memory");
#pragma unroll
      for (int i = 0; i < 4; ++i) { const int row = i * 8 + (lane >> 3), ch = lane & 7; const u32x4 v = *(const u32x4*)(stg + row * 64 + ch * 8); *(u32x4*)(Ow + (size_t)row * 1024 + ch * 8) = v; } }
    asm volatile("s_waitcnt lgkmcnt(0)\n\ts_barrier" ::: "memory");
}
#undef NSA_WAIT_BAR
#undef NSA_SBAR
}

namespace pg8 {
__device__ __forceinline__ float sigm(float x) { return __builtin_amdgcn_rcpf(1.0f + __builtin_amdgcn_exp2f(-1.4426950408889634f * x)); }
__device__ __forceinline__ u32x4 pack8(const f32x4 a, const f32x4 b) { u32x4 w; w.x = cvt_pk_bf16(a[0], a[1]); w.y = cvt_pk_bf16(a[2], a[3]); w.z = cvt_pk_bf16(b[0], b[1]); w.w = cvt_pk_bf16(b[2], b[3]); return w; }
__device__ __forceinline__ float gelu_tanh(float x) { const float t = 0.7978845608028654f * (x + 0.044715f * x * x * x); return x * sigm(2.0f * t); }

struct EpiSwiglu {
    static constexpr bool PERM = true, AFTER_DRAIN = false;
    bf16_t* O; int ldc;
    __device__ __forceinline__ void operator()(const f32x4 (&acc)[2][2][4][2], const Unit& u, int wr, int wc, int fr, int fq) const {
        const int row0 = u.pm * BM + wr * 64 + fr, col0 = u.pn * HALF + wc * 32 + 8 * fq;
#pragma unroll
        for (int ai = 0; ai < 2; ++ai)
#pragma unroll
            for (int m = 0; m < 4; ++m) {
                bf16_t* rowp = O + (size_t)(row0 + ai * HALF + m * 16) * ldc + col0;
                f32x4 h[2];
#pragma unroll
                for (int n = 0; n < 2; ++n) { const f32x4 gt = acc[ai][0][m][n], up = acc[ai][1][m][n];
#pragma unroll
                    for (int e = 0; e < 4; ++e) h[n][e] = gt[e] * sigm(gt[e]) * up[e]; }
                *(u32x4*)rowp = pack8(h[0], h[1]);
            }
    }
};
struct EpiPlain {
    static constexpr bool PERM = true, AFTER_DRAIN = false;
    bf16_t* O; int ldc;
    __device__ __forceinline__ void operator()(const f32x4 (&acc)[2][2][4][2], const Unit& u, int wr, int wc, int fr, int fq) const {
        const int row0 = u.pm * BM + wr * 64 + fr, col0 = u.pn * BM + wc * 32 + 8 * fq;
#pragma unroll
        for (int ai = 0; ai < 2; ++ai)
#pragma unroll
            for (int m = 0; m < 4; ++m) {
                bf16_t* rowp = O + (size_t)(row0 + ai * HALF + m * 16) * ldc + col0;
#pragma unroll
                for (int bj = 0; bj < 2; ++bj) *(u32x4*)(rowp + bj * HALF) = pack8(acc[ai][bj][m][0], acc[ai][bj][m][1]);
            }
    }
};
struct EpiNsaIn {
    static constexpr bool PERM = true, AFTER_DRAIN = false;
    bf16_t* Q; bf16_t* KV; float* gates; float qscale; size_t kvstride;
    __device__ __forceinline__ void operator()(const f32x4 (&acc)[2][2][4][2], const Unit& u, int wr, int wc, int fr, int fq) const {
        const int row0 = u.pm * BM + wr * 64 + fr, ct0 = wc * 32 + 8 * fq;
        if (u.pn < 4) {
#pragma unroll
            for (int ai = 0; ai < 2; ++ai)
#pragma unroll
                for (int m = 0; m < 4; ++m) { bf16_t* rowp = Q + (size_t)(row0 + ai * HALF + m * 16) * 1024 + u.pn * BM + ct0;
#pragma unroll
                    for (int bj = 0; bj < 2; ++bj) *(u32x4*)(rowp + bj * HALF) = pack8(acc[ai][bj][m][0] * qscale, acc[ai][bj][m][1] * qscale); }
        } else if (u.pn < 10) {
            bf16_t* base = KV + (size_t)(u.pn - 4) * kvstride;
#pragma unroll
            for (int ai = 0; ai < 2; ++ai)
#pragma unroll
                for (int m = 0; m < 4; ++m) { const int row = row0 + ai * HALF + m * 16, b = row >> 11, s = row & 2047;
#pragma unroll
                    for (int bj = 0; bj < 2; ++bj) { const int ct = bj * HALF + ct0, g = ct >> 6, d = ct & 63;
                        *(u32x4*)(base + ((size_t)((b * 4 + g) * 2048 + s)) * 64 + d) = pack8(acc[ai][bj][m][0], acc[ai][bj][m][1]); } }
        } else {
            if (ct0 < 48) {
#pragma unroll
                for (int ai = 0; ai < 2; ++ai)
#pragma unroll
                    for (int m = 0; m < 4; ++m) { float* gp = gates + (size_t)(row0 + ai * HALF + m * 16) * 48 + ct0;
#pragma unroll
                        for (int n = 0; n < 2; ++n) { const f32x4 v = acc[ai][0][m][n]; *(f32x4*)(gp + 4 * n) = (f32x4){sigm(v[0]), sigm(v[1]), sigm(v[2]), sigm(v[3])}; } }
            }
        }
    }
};
struct EpiFoxIn {
    static constexpr bool PERM = true, AFTER_DRAIN = false;
    bf16_t* QKV; float* flog; float qscale; size_t tstride;
    __device__ __forceinline__ void operator()(const f32x4 (&acc)[2][2][4][2], const Unit& u, int wr, int wc, int fr, int fq) const {
        const int row0 = u.pm * BM + wr * 64 + fr, ct0 = wc * 32 + 8 * fq;
        if (u.pn < 12) {
            const int t = u.pn >> 2; const float sc = (t == 0) ? qscale : 1.0f;
            bf16_t* base = QKV + (size_t)t * tstride + (u.pn & 3) * BM + ct0;
#pragma unroll
            for (int ai = 0; ai < 2; ++ai)
#pragma unroll
                for (int m = 0; m < 4; ++m) { bf16_t* rowp = base + (size_t)(row0 + ai * HALF + m * 16) * 1024;
#pragma unroll
                    for (int bj = 0; bj < 2; ++bj) *(u32x4*)(rowp + bj * HALF) = pack8(acc[ai][bj][m][0] * sc, acc[ai][bj][m][1] * sc); }
        } else {
            if (ct0 < 16) {
#pragma unroll
                for (int ai = 0; ai < 2; ++ai)
#pragma unroll
                    for (int m = 0; m < 4; ++m) { float* fp = flog + (size_t)(row0 + ai * HALF + m * 16) * 16 + ct0;
#pragma unroll
                        for (int n = 0; n < 2; ++n) *(f32x4*)(fp + 4 * n) = acc[ai][0][m][n]; }
            }
        }
    }
};
struct EpiCmp {
    static constexpr bool PERM = true, AFTER_DRAIN = false;
    bf16_t* Hc; const float* b1f;
    __device__ __forceinline__ void operator()(const f32x4 (&acc)[2][2][4][2], const Unit& u, int wr, int wc, int fr, int fq) const {
        const int row0 = u.pm * BM + wr * 64 + fr, ct0 = wc * 32 + 8 * fq;
        f32x4 bv[2][2];
#pragma unroll
        for (int bj = 0; bj < 2; ++bj)
#pragma unroll
            for (int n = 0; n < 2; ++n) bv[bj][n] = *(const f32x4*)(b1f + u.pn * BM + bj * HALF + ct0 + 4 * n);
#pragma unroll
        for (int ai = 0; ai < 2; ++ai)
#pragma unroll
            for (int m = 0; m < 4; ++m) { bf16_t* rowp = Hc + (size_t)(row0 + ai * HALF + m * 16) * 256 + ct0;
#pragma unroll
                for (int bj = 0; bj < 2; ++bj) { f32x4 v0 = acc[ai][bj][m][0] + bv[bj][0], v1 = acc[ai][bj][m][1] + bv[bj][1];
#pragma unroll
                    for (int e = 0; e < 4; ++e) { v0[e] = gelu_tanh(v0[e]); v1[e] = gelu_tanh(v1[e]); }
                    *(u32x4*)(rowp + bj * HALF) = pack8(v0, v1); } }
    }
};
struct CmpOrder {
    int G, c;
    __device__ __forceinline__ bool next(int i, Unit& u) const { const int L = i * G + c; if (L >= 32) return false; u.pm = L; u.pn = L >> 4; return true; }
    __device__ __forceinline__ void a_ready(const Unit&) const {}
    __device__ __forceinline__ void done(const Unit&) const {}
};
struct EpiSlab {
    static constexpr bool PERM = true, AFTER_DRAIN = false;
    float* S;
    __device__ __forceinline__ void operator()(const f32x4 (&acc)[2][2][4][2], const Unit& u, int wr, int wc, int fr, int fq) const {
        const int row0 = u.pm * BM + wr * 64 + fr, ct0 = wc * 32 + 8 * fq;
#pragma unroll
        for (int ai = 0; ai < 2; ++ai)
#pragma unroll
            for (int m = 0; m < 4; ++m) { float* rowp = S + (size_t)(row0 + ai * HALF + m * 16) * 256 + ct0;
#pragma unroll
                for (int bj = 0; bj < 2; ++bj)
#pragma unroll
                    for (int n = 0; n < 2; ++n) *(f32x4*)(rowp + bj * HALF + 4 * n) = acc[ai][bj][m][n]; }
    }
};
struct OneUnit {
    int pm, pn;
    __device__ __forceinline__ bool next(int i, Unit& u) const { if (i != 0) return false; u.pm = pm; u.pn = pn; return true; }
    __device__ __forceinline__ void a_ready(const Unit&) const {}
    __device__ __forceinline__ void done(const Unit&) const {}
};
}

constexpr int NWAVES = 8;
constexpr int BATCH = 8, SEQ = 2048, D = 1024, H = 16, HD = 64, FF = 2816, NGU = 2 * FF;
constexpr int M = BATCH * SEQ;
constexpr int NSA_IN = 2608, NSA_IN_PAD = 2816, FOX_IN = 3088, FOX_IN_PAD = 3328;
constexpr float RMS_EPS = 1e-6f;
constexpr float LOG2E = 1.4426950408889634f;
constexpr float QSCALE = 0.125f * LOG2E;
#ifndef MK_PER_PHASE
#define MK_PER_PHASE 0
#endif
#ifndef FOX_NAIVE
#define FOX_NAIVE 0
#endif
#ifndef NSA_NAIVE
#define NSA_NAIVE 0
#endif
constexpr int N_PHASES = 47 - (FOX_NAIVE ? 0 : 2);

constexpr size_t MiB = 1u << 20;
constexpr size_t WS_CTL = 0, CTL_ZERO_BYTES = 1 * MiB;
constexpr size_t WS_LUT = 1 * MiB;
constexpr size_t WS_B1F = 1 * MiB + 16384;
constexpr size_t WS_W2T = 1 * MiB + 32768;
constexpr size_t WS_CUM = 2 * MiB;
constexpr size_t WS_FLOG = 3 * MiB;
constexpr size_t WS_GATES = 4 * MiB;
constexpr size_t WS_WGU = 8 * MiB;
constexpr size_t WS_WD = 96 * MiB;
constexpr size_t WS_WNIN = 140 * MiB;
constexpr size_t WS_WNOUT = 151 * MiB;
constexpr size_t WS_WFIN = 155 * MiB;
constexpr size_t WS_WFOUT = 168 * MiB;
constexpr size_t WS_W1T = 172 * MiB;
constexpr size_t WS_U = 176 * MiB;
constexpr size_t WS_Y = 208 * MiB;
constexpr size_t WS_O = 240 * MiB;
constexpr size_t WS_R1 = 272 * MiB;
constexpr size_t WS_END = 368 * MiB;
constexpr size_t R1_KV = 32 * MiB, KV_STRIDE_E = (size_t)32 * 2048 * 64  , R1_HC = 80 * MiB, R1_KC2 = 84 * MiB, KC2_STRIDE_E = (size_t)32 * 128 * 64;
constexpr int CW_BAR = 4096;

constexpr int RING_OFF = 0, RING_BYTES = 131072;
constexpr int LDSCTL_OFF = 139264, MISC_OFF = LDSCTL_OFF + 320;
constexpr int LDS_BYTES = 147456;

#define GAS __attribute__((address_space(1)))
#define LAS __attribute__((address_space(3)))
typedef unsigned short bf16;
typedef unsigned v4u __attribute__((ext_vector_type(4)));
typedef float f32x4 __attribute__((ext_vector_type(4)));
typedef GAS unsigned gu32;
#define RLX_AGENT __ATOMIC_RELAXED, __HIP_MEMORY_SCOPE_AGENT
#define LDS_WAIT() asm volatile("s_waitcnt lgkmcnt(0)" ::: "memory")
__device__ __forceinline__ unsigned f2bf(float f) { unsigned u = __builtin_bit_cast(unsigned, f); return (u + 0x7fffu + ((u >> 16) & 1u)) >> 16; }
__device__ __forceinline__ unsigned pk2(float lo, float hi) { unsigned r; asm("v_cvt_pk_bf16_f32 %0, %1, %2" : "=v"(r) : "v"(lo), "v"(hi)); return r; }
__device__ __forceinline__ float bf_lo(unsigned u) { return __builtin_bit_cast(float, u << 16); }
__device__ __forceinline__ float bf_hi(unsigned u) { return __builtin_bit_cast(float, u & 0xffff0000u); }
__device__ __forceinline__ float bf2f(bf16 h) { return __builtin_bit_cast(float, (unsigned)h << 16); }
#define DPP_F(v, ctrl) __builtin_bit_cast(float, __builtin_amdgcn_update_dpp(0, __builtin_bit_cast(int, (v)), (ctrl), 0xF, 0xF, true))
__device__ __forceinline__ float sum8(float v) { v += DPP_F(v, 0xB1); v += DPP_F(v, 0x4E); v += DPP_F(v, 0x141); return v; }
__device__ __forceinline__ float lane_f(float v, int l) { return __builtin_bit_cast(float, __builtin_amdgcn_readlane(__builtin_bit_cast(int, v), l)); }
__device__ __forceinline__ float wave_sum(float v) {
    v = sum8(v); v += DPP_F(v, 0x140);
    return (lane_f(v, 0) + lane_f(v, 16)) + (lane_f(v, 32) + lane_f(v, 48));
}
__device__ __forceinline__ float wave_max(float v) {
    v = fmaxf(v, DPP_F(v, 0xB1)); v = fmaxf(v, DPP_F(v, 0x4E)); v = fmaxf(v, DPP_F(v, 0x141)); v = fmaxf(v, DPP_F(v, 0x140));
    return fmaxf(fmaxf(lane_f(v, 0), lane_f(v, 16)), fmaxf(lane_f(v, 32), lane_f(v, 48)));
}
__device__ __forceinline__ float ex2(float x) { return __builtin_amdgcn_exp2f(x); }

#define XB_TMO      128
#define XB_XCNT(j)  (256  + 64 * (j))
#define XB_XSUB(j)  (1280 + 64 * (j))
#define XB_XGEN(j)  (2304 + 64 * (j))
#define XB_TOP      3328
#define XB_TOPGEN   3392
#define XCD_BAR_WORDS 3456
#define XB_SPIN_CAP (1u << 18)

__device__ __forceinline__ unsigned xb_ld(unsigned* p)              { return __hip_atomic_load(p, __ATOMIC_RELAXED, __HIP_MEMORY_SCOPE_AGENT); }
__device__ __forceinline__ unsigned xb_add(unsigned* p, unsigned v) { return __hip_atomic_fetch_add(p, v, __ATOMIC_RELAXED, __HIP_MEMORY_SCOPE_AGENT); }
__device__ __forceinline__ unsigned xb_xcc_id() { return (unsigned)__builtin_amdgcn_s_getreg((3 << 11) | 20) & 0xFu; }
#define XB_SPIN(cond, bar) do { unsigned _sp = 0; while (cond) { __builtin_amdgcn_s_sleep(1); \
    if ((++_sp & 255u) == 0u) { if (xb_ld(&(bar)[XB_TMO])) break; if (_sp > XB_SPIN_CAP) { atomicAdd(&(bar)[XB_TMO], 1u); break; } } } } while (0)

struct XcdBarrier {
    unsigned* bar; unsigned x;
    volatile LAS unsigned* st;
};
__device__ __forceinline__ XcdBarrier xcd_barrier_post(unsigned* bar, volatile LAS unsigned* st) {
    XcdBarrier b; b.bar = bar; b.x = xb_xcc_id(); b.st = st;
    if (threadIdx.x == 0) (void)xb_add(&bar[XB_XCNT(b.x)], 1u);
    return b;
}
__device__ __forceinline__ void xcd_barrier_complete(unsigned* bar, unsigned x, unsigned& nloc, unsigned& nx) {
    const unsigned G = gridDim.x * gridDim.y * gridDim.z;
    unsigned sum, cnt, mine, sp = 0u;
    for (;;) {
        sum = 0u; cnt = 0u; mine = 0u;
#pragma unroll
        for (unsigned j = 0; j < 16; ++j) { const unsigned c = xb_ld(&bar[XB_XCNT(j)]); sum += c; cnt += (c > 0u) ? 1u : 0u; mine = (j == x) ? c : mine; }
        if (sum == G) break;
        __builtin_amdgcn_s_sleep(1);
        if ((++sp & 255u) == 0u) { if (xb_ld(&bar[XB_TMO])) break; if (sp > XB_SPIN_CAP) { atomicAdd(&bar[XB_TMO], 1u); break; } }
    }
    nloc = mine > 0u ? mine : 1u; nx = cnt > 0u ? cnt : 1u;
}
__device__ __forceinline__ void xcd_barrier(const XcdBarrier& b) {
    asm volatile("s_waitcnt vmcnt(0)" ::: "memory");
    __syncthreads();
    if (threadIdx.x == 0) {
        unsigned* bar = b.bar;
        __builtin_amdgcn_s_waitcnt(0);
        unsigned nloc = b.st[0], nx = b.st[1];
        if (nloc == 0u) { xcd_barrier_complete(bar, b.x, nloc, nx); b.st[0] = nloc; b.st[1] = nx; }
        const unsigned old = xb_add(&bar[XB_XSUB(b.x)], 1u);
        const unsigned gen = old / nloc;
        if (old + 1u == (gen + 1u) * nloc) {
            __builtin_amdgcn_fence(__ATOMIC_RELEASE, "agent");
            asm volatile("s_waitcnt vmcnt(0)" ::: "memory");
            const unsigned og = xb_add(&bar[XB_TOP], 1u);
            const unsigned tg = og / nx;
            if (og + 1u == (tg + 1u) * nx) xb_add(&bar[XB_TOPGEN], 1u);
            else XB_SPIN(xb_ld(&bar[XB_TOPGEN]) == tg, bar);
            __builtin_amdgcn_fence(__ATOMIC_ACQUIRE, "agent");
            xb_add(&bar[XB_XGEN(b.x)], 1u);
            asm volatile("s_waitcnt vmcnt(0)" ::: "memory");
        } else {
            XB_SPIN(xb_ld(&bar[XB_XGEN(b.x)]) == gen, bar);
            __builtin_amdgcn_fence(__ATOMIC_ACQUIRE, "agent");
            asm volatile("s_waitcnt vmcnt(0)" ::: "memory");
        }
    }
    __syncthreads();
}

struct Ctx { LAS unsigned char* lds; int tid, lane, wave, vcu, G, gw, ngw, bx; };

__device__ __forceinline__ void transpose_item(const float* W, int K, int N, bf16* WT, int drow0, int kb, int n0, LAS float* scr, int lane) {
    const int k0 = 64 * kb; const int c4 = 4 * (lane & 7); const bool ok = (n0 + c4) < N;
    f32x4 v[8];
#pragma unroll
    for (int i = 0; i < 8; ++i) { const int kk = 8 * i + (lane >> 3); v[i] = ok ? *(const f32x4*)(W + (size_t)(k0 + kk) * N + n0 + c4) : (f32x4){0.f, 0.f, 0.f, 0.f}; }
#pragma unroll
    for (int i = 0; i < 8; ++i) { const int kk = 8 * i + (lane >> 3); LAS float* d = scr + kk * 33 + c4; d[0] = v[i][0]; d[1] = v[i][1]; d[2] = v[i][2]; d[3] = v[i][3]; }
    LDS_WAIT(); asm volatile("" ::: "memory");
    const int c = lane & 7;
#pragma unroll
    for (int j = 0; j < 4; ++j) { const int n = (lane >> 3) + 8 * j; const LAS float* s = scr + (8 * c) * 33 + n;
        v4u o; o.x = pk2(s[0 * 33], s[1 * 33]); o.y = pk2(s[2 * 33], s[3 * 33]); o.z = pk2(s[4 * 33], s[5 * 33]); o.w = pk2(s[6 * 33], s[7 * 33]);
        *(GAS v4u*)(WT + (size_t)(drow0 + n) * K + k0 + 8 * c) = o; }
    LDS_WAIT(); asm volatile("" ::: "memory");
}
__device__ __forceinline__ int t5_bucket(int n) {
    if (n < 16) return n;
    int b = 16;
    b += (n >= 19); b += (n >= 21); b += (n >= 24); b += (n >= 27); b += (n >= 31); b += (n >= 35); b += (n >= 40); b += (n >= 46);
    b += (n >= 52); b += (n >= 59); b += (n >= 67); b += (n >= 77); b += (n >= 87); b += (n >= 99); b += (n >= 113);
    return b;
}
struct In {
    const float *x, *norm_g, *w_gate, *w_up, *w_down, *rel_bias, *nsa_w_in, *nsa_pe, *nsa_w1, *nsa_b1, *nsa_w2, *nsa_w_out, *fox_w_in, *fox_b_f, *fox_w_out;
};
__device__ __forceinline__ void first_norm_row(const float* xrow, const float* g, bf16* urow, bf16* hrow, int lane) {
    const f32x4* xp = (const f32x4*)xrow; const f32x4* gp = (const f32x4*)g;
    f32x4 v[4] = {xp[2 * lane], xp[2 * lane + 1], xp[128 + 2 * lane], xp[128 + 2 * lane + 1]};
    float ss = 0.f;
#pragma unroll
    for (int i = 0; i < 4; ++i) ss += (v[i][0] * v[i][0] + v[i][1] * v[i][1]) + (v[i][2] * v[i][2] + v[i][3] * v[i][3]);
    const float r = 1.0f / sqrtf(wave_sum(ss) * (1.0f / D) + RMS_EPS);
    { v4u h0, h1; h0.x = pk2(v[0][0], v[0][1]); h0.y = pk2(v[0][2], v[0][3]); h0.z = pk2(v[1][0], v[1][1]); h0.w = pk2(v[1][2], v[1][3]);
      h1.x = pk2(v[2][0], v[2][1]); h1.y = pk2(v[2][2], v[2][3]); h1.z = pk2(v[3][0], v[3][1]); h1.w = pk2(v[3][2], v[3][3]);
      ((v4u*)hrow)[lane] = h0; ((v4u*)hrow)[64 + lane] = h1; }
    const f32x4 g4[4] = {gp[2 * lane], gp[2 * lane + 1], gp[128 + 2 * lane], gp[128 + 2 * lane + 1]};
#pragma unroll
    for (int i = 0; i < 4; ++i) v[i] = v[i] * r * g4[i];
    v4u o0, o1; o0.x = pk2(v[0][0], v[0][1]); o0.y = pk2(v[0][2], v[0][3]); o0.z = pk2(v[1][0], v[1][1]); o0.w = pk2(v[1][2], v[1][3]);
    o1.x = pk2(v[2][0], v[2][1]); o1.y = pk2(v[2][2], v[2][3]); o1.z = pk2(v[3][0], v[3][1]); o1.w = pk2(v[3][2], v[3][3]);
    ((v4u*)urow)[lane] = o0; ((v4u*)urow)[64 + lane] = o1;
}
namespace cv {
constexpr int I_G = 16 * 88, I_D = 44 * 32, I_FFN = 2 * I_G + I_D;
constexpr int I_NIN = 16 * 88, I_SQ = 16 * 32, I_FIN = 16 * 104, I_W1 = 32 * 8, I_W2 = 8;
constexpr int T0 = 8 * I_FFN, T1 = T0 + 2 * I_NIN, T2 = T1 + 2 * I_SQ, T3 = T2 + 2 * I_FIN, T4 = T3 + 2 * I_SQ, T5 = T4 + 4 * I_W1, T6 = T5 + 4 * I_W2;
}
__device__ __forceinline__ void convert_item(const In& I, unsigned char* ws, int it, LAS float* scr, int lane) {
    using namespace cv;
    bf16* Wgu = (bf16*)(ws + WS_WGU); bf16* Wd = (bf16*)(ws + WS_WD); bf16* Wnin = (bf16*)(ws + WS_WNIN); bf16* Wnout = (bf16*)(ws + WS_WNOUT);
    bf16* Wfin = (bf16*)(ws + WS_WFIN); bf16* Wfout = (bf16*)(ws + WS_WFOUT); bf16* W1t = (bf16*)(ws + WS_W1T); bf16* W2t = (bf16*)(ws + WS_W2T);
    int r = it;
    if (r < T0) { const int f = r / I_FFN; r -= f * I_FFN;
        if (r < 2 * I_G) { const int up = r >= I_G; r -= up * I_G; const int kb = r / 88, nb = r % 88;
            transpose_item((up ? I.w_up : I.w_gate) + (size_t)f * D * FF, D, FF, Wgu + (size_t)f * NGU * D, 256 * (nb >> 2) + 32 * (nb & 3) + 128 * up, kb, 32 * nb, scr, lane); }
        else { r -= 2 * I_G; const int kb = r / 32, nb = r % 32; transpose_item(I.w_down + (size_t)f * FF * D, FF, D, Wd + (size_t)f * D * FF, 32 * nb, kb, 32 * nb, scr, lane); }
        return; }
    r -= T0;
    if (r < 2 * I_NIN) { const int j = r / I_NIN; r -= j * I_NIN; const int kb = r / 88, nb = r % 88;
        transpose_item(I.nsa_w_in + (size_t)j * D * NSA_IN, D, NSA_IN, Wnin + (size_t)j * NSA_IN_PAD * D, 32 * nb, kb, 32 * nb, scr, lane); return; }
    r -= 2 * I_NIN;
    if (r < 2 * I_SQ) { const int j = r / I_SQ; r -= j * I_SQ; const int kb = r / 32, nb = r % 32;
        transpose_item(I.nsa_w_out + (size_t)j * D * D, D, D, Wnout + (size_t)j * D * D, 32 * nb, kb, 32 * nb, scr, lane); return; }
    r -= 2 * I_SQ;
    if (r < 2 * I_FIN) { const int j = r / I_FIN; r -= j * I_FIN; const int kb = r / 104, nb = r % 104;
        transpose_item(I.fox_w_in + (size_t)j * D * FOX_IN, D, FOX_IN, Wfin + (size_t)j * FOX_IN_PAD * D, 32 * nb, kb, 32 * nb, scr, lane); return; }
    r -= 2 * I_FIN;
    if (r < 2 * I_SQ) { const int j = r / I_SQ; r -= j * I_SQ; const int kb = r / 32, nb = r % 32;
        transpose_item(I.fox_w_out + (size_t)j * D * D, D, D, Wfout + (size_t)j * D * D, 32 * nb, kb, 32 * nb, scr, lane); return; }
    r -= 2 * I_SQ;
    if (r < 4 * I_W1) { const int jk = r / I_W1; r -= jk * I_W1; const int kb = r / 8, nb = r % 8;
        transpose_item(I.nsa_w1 + (size_t)jk * 2048 * 256, 2048, 256, W1t + (size_t)jk * 256 * 2048, 32 * nb, kb, 32 * nb, scr, lane); return; }
    r -= 4 * I_W1;
    { const int jk = r >> 3; r &= 7; const int kb = r >> 1, nb = r & 1;
        transpose_item(I.nsa_w2 + (size_t)jk * 256 * 64, 256, 64, W2t + (size_t)jk * 64 * 256, 32 * nb, kb, 32 * nb, scr, lane); }
}
__device__ __forceinline__ void convert_range(const In& I, unsigned char* ws, int start, int count, int widx, int nw, LAS float* scr, int lane) {
    for (int it = start + widx; it < start + count; it += nw) convert_item(I, ws, it, scr, lane);
}
__device__ __forceinline__ void convert_for_next(const In& I, unsigned char* ws, int s, int widx, int nw, LAS float* scr, int lane) {
    using namespace cv;
    if (s >= 7) return;
    if ((s & 1) == 0) { const int L = s >> 1, j = L >> 1;
        if ((L & 1) == 0) { convert_range(I, ws, T0 + j * I_NIN, I_NIN, widx, nw, scr, lane); convert_range(I, ws, T1 + j * I_SQ, I_SQ, widx, nw, scr, lane);
                            convert_range(I, ws, T4 + j * 2 * I_W1, 2 * I_W1, widx, nw, scr, lane); convert_range(I, ws, T5 + j * 2 * I_W2, 2 * I_W2, widx, nw, scr, lane); }
        else { convert_range(I, ws, T2 + j * I_FIN, I_FIN, widx, nw, scr, lane); convert_range(I, ws, T3 + j * I_SQ, I_SQ, widx, nw, scr, lane); } }
    convert_range(I, ws, (s + 1) * I_FFN, I_FFN, widx, nw, scr, lane);
}
__device__ __forceinline__ void prologue(const Ctx& C, const In& I, unsigned char* ws, bf16* hs0) {
    LAS float* scr = (LAS float*)(C.lds + RING_OFF + C.wave * 16384);
    convert_range(I, ws, 0, (C.G == 256) ? cv::I_FFN : cv::T6, C.gw, C.ngw, scr, C.lane);
    float* lut = (float*)(ws + WS_LUT);
    for (int e = C.gw * 64 + C.lane; e < 16 * 132; e += C.ngw * 64) { const int h = e / 132, rel = e % 132; lut[e] = I.rel_bias[t5_bucket(rel > 128 ? 128 : rel) * 16 + h] * LOG2E; }
    float* b1f = (float*)(ws + WS_B1F);
    for (int w = C.ngw - 1 - C.gw; w < 256; w += C.ngw) {
        const int e0 = 4 * w, jk = e0 >> 8, col = (e0 & 255) + (C.lane & 3), ks = C.lane >> 2;
        const float* pe = I.nsa_pe + (size_t)jk * 2048 + 128 * ks; const float* w1 = I.nsa_w1 + (size_t)jk * 2048 * 256 + (size_t)(128 * ks) * 256 + col; float sacc = 0.f;
#pragma unroll 8
        for (int i = 0; i < 128; ++i) sacc += pe[i] * w1[(size_t)i * 256];
        sacc += __shfl_xor(sacc, 4); sacc += __shfl_xor(sacc, 8); sacc += __shfl_xor(sacc, 16); sacc += __shfl_xor(sacc, 32);
        if (C.lane < 4) b1f[e0 + C.lane] = sacc + I.nsa_b1[e0 + C.lane];
    }
    bf16* U = (bf16*)(ws + WS_U);
    if (C.G == 256) { const int mb = 2048 * (C.bx & 7) + 64 * (C.bx >> 3) + 8 * C.wave;
        for (int m = mb; m < mb + 8; ++m) first_norm_row(I.x + (size_t)m * D, I.norm_g, U + (size_t)m * D, hs0 + (size_t)m * D, C.lane); }
    else for (int m = C.gw; m < M; m += C.ngw) first_norm_row(I.x + (size_t)m * D, I.norm_g, U + (size_t)m * D, hs0 + (size_t)m * D, C.lane);
}

__device__ __forceinline__ void thin_pass(const Ctx& C, const bf16* hin, bf16* hout, bf16* u, float* out, const bf16* y, const float* gpost, float cmul, const float* gpre, bool last) {
    constexpr int RB = 4;
    const int lane = C.lane;
    const f32x4* gp = (const f32x4*)gpost; const f32x4 g4[4] = {gp[2 * lane], gp[2 * lane + 1], gp[128 + 2 * lane], gp[128 + 2 * lane + 1]};
    const f32x4* qp = (const f32x4*)(last ? gpost : gpre); const f32x4 q4[4] = {qp[2 * lane], qp[2 * lane + 1], qp[128 + 2 * lane], qp[128 + 2 * lane + 1]};
    const bool xl = (C.G == 256);
    const int mstart = xl ? 2048 * (C.bx & 7) + 64 * (C.bx >> 3) + 8 * C.wave : C.gw * RB, mstep = xl ? RB : C.ngw * RB, mend = xl ? mstart + 8 : M;
    for (int m0 = mstart; m0 < mend; m0 += mstep) {
        v4u yr[RB][2], hr[RB][2];
#pragma unroll
        for (int b = 0; b < RB; ++b) { const v4u* yp = (const v4u*)(y + (size_t)(m0 + b) * D); const v4u* hp = (const v4u*)(hin + (size_t)(m0 + b) * D);
            yr[b][0] = yp[lane]; yr[b][1] = yp[64 + lane]; hr[b][0] = hp[lane]; hr[b][1] = hp[64 + lane]; }
#pragma unroll
        for (int b = 0; b < RB; ++b) {
            const int m = m0 + b; const v4u y0 = yr[b][0], y1 = yr[b][1], h0 = hr[b][0], h1 = hr[b][1];
            f32x4 yv[4], h[4];
            yv[0] = (f32x4){bf_lo(y0.x), bf_hi(y0.x), bf_lo(y0.y), bf_hi(y0.y)}; yv[1] = (f32x4){bf_lo(y0.z), bf_hi(y0.z), bf_lo(y0.w), bf_hi(y0.w)};
            yv[2] = (f32x4){bf_lo(y1.x), bf_hi(y1.x), bf_lo(y1.y), bf_hi(y1.y)}; yv[3] = (f32x4){bf_lo(y1.z), bf_hi(y1.z), bf_lo(y1.w), bf_hi(y1.w)};
            h[0] = (f32x4){bf_lo(h0.x), bf_hi(h0.x), bf_lo(h0.y), bf_hi(h0.y)}; h[1] = (f32x4){bf_lo(h0.z), bf_hi(h0.z), bf_lo(h0.w), bf_hi(h0.w)};
            h[2] = (f32x4){bf_lo(h1.x), bf_hi(h1.x), bf_lo(h1.y), bf_hi(h1.y)}; h[3] = (f32x4){bf_lo(h1.z), bf_hi(h1.z), bf_lo(h1.w), bf_hi(h1.w)};
            float ss = 0.f;
#pragma unroll
            for (int i = 0; i < 4; ++i) ss += (yv[i][0] * yv[i][0] + yv[i][1] * yv[i][1]) + (yv[i][2] * yv[i][2] + yv[i][3] * yv[i][3]);
            const float ry = cmul / sqrtf(wave_sum(ss) * (1.0f / D) + RMS_EPS);
#pragma unroll
            for (int i = 0; i < 4; ++i) h[i] = h[i] + yv[i] * ry * g4[i];
            if (last) { f32x4* op = (f32x4*)(out + (size_t)m * D); op[2 * lane] = h[0]; op[2 * lane + 1] = h[1]; op[128 + 2 * lane] = h[2]; op[128 + 2 * lane + 1] = h[3]; }
            else {
                float s2 = 0.f;
#pragma unroll
                for (int i = 0; i < 4; ++i) s2 += (h[i][0] * h[i][0] + h[i][1] * h[i][1]) + (h[i][2] * h[i][2] + h[i][3] * h[i][3]);
                const float rh = 1.0f / sqrtf(wave_sum(s2) * (1.0f / D) + RMS_EPS);
                v4u o0, o1; o0.x = pk2(h[0][0], h[0][1]); o0.y = pk2(h[0][2], h[0][3]); o0.z = pk2(h[1][0], h[1][1]); o0.w = pk2(h[1][2], h[1][3]);
                o1.x = pk2(h[2][0], h[2][1]); o1.y = pk2(h[2][2], h[2][3]); o1.z = pk2(h[3][0], h[3][1]); o1.w = pk2(h[3][2], h[3][3]);
                v4u* hp = (v4u*)(hout + (size_t)m * D); hp[lane] = o0; hp[64 + lane] = o1;
#pragma unroll
                for (int i = 0; i < 4; ++i) h[i] = h[i] * rh * q4[i];
                o0.x = pk2(h[0][0], h[0][1]); o0.y = pk2(h[0][2], h[0][3]); o0.z = pk2(h[1][0], h[1][1]); o0.w = pk2(h[1][2], h[1][3]);
                o1.x = pk2(h[2][0], h[2][1]); o1.y = pk2(h[2][2], h[2][3]); o1.z = pk2(h[3][0], h[3][1]); o1.w = pk2(h[3][2], h[3][3]);
                v4u* up = (v4u*)(u + (size_t)m * D); up[lane] = o0; up[64 + lane] = o1;
            }
        }
    }
}

__device__ __forceinline__ void load_row64(const bf16* p, v4u (&r)[8]) { const v4u* q = (const v4u*)p;
#pragma unroll
    for (int i = 0; i < 8; ++i) r[i] = q[i]; }
__device__ __forceinline__ float dot64(const v4u (&a)[8], const v4u (&b)[8]) {
    float s0 = 0.f, s1 = 0.f;
#pragma unroll
    for (int i = 0; i < 8; ++i) {
        s0 += bf_lo(a[i].x) * bf_lo(b[i].x); s1 += bf_hi(a[i].x) * bf_hi(b[i].x);
        s0 += bf_lo(a[i].y) * bf_lo(b[i].y); s1 += bf_hi(a[i].y) * bf_hi(b[i].y);
        s0 += bf_lo(a[i].z) * bf_lo(b[i].z); s1 += bf_hi(a[i].z) * bf_hi(b[i].z);
        s0 += bf_lo(a[i].w) * bf_lo(b[i].w); s1 += bf_hi(a[i].w) * bf_hi(b[i].w);
    }
    return s0 + s1;
}
__device__ __forceinline__ int clampi(int v, int lo, int hi) { return v < lo ? lo : (v > hi ? hi : v); }

__device__ __forceinline__ void cmp2_naive(const Ctx& C, const bf16* Hc, const float* w2, bf16* KC2) {
    const int nth = C.ngw * 64;
    for (int e = C.gw * 64 + C.lane; e < 2 * 4096 * 64; e += nth) {
        const int d = e & 63, m = (e >> 6) & 4095, kv = e >> 18;
        float s = 0.f;
        if ((m & 127) != 127) { const bf16* hr = Hc + (size_t)(kv * 4096 + m) * 256; const float* w = w2 + (size_t)kv * 256 * 64 + d;
            for (int k = 0; k < 256; ++k) s += bf2f(hr[k]) * w[(size_t)k * 64]; }
        KC2[(size_t)kv * KC2_STRIDE_E + (size_t)m * 64 + d] = (bf16)f2bf(s);
    }
}

__device__ __forceinline__ void nsa_naive_token(int b, int g, int t, const bf16* Q, const bf16* KV, const bf16* KC2, const float* gates, const float* lut, bf16* O, int lane) {
    const int bg = b * 4 + g, cur = t >> 6;
    const size_t tok = (size_t)b * SEQ + t;
    const bf16* ks = KV + 2 * KV_STRIDE_E + (size_t)bg * SEQ * 64; const bf16* vs = KV + 3 * KV_STRIDE_E + (size_t)bg * SEQ * 64;
    const bf16* kw = KV + 4 * KV_STRIDE_E + (size_t)bg * SEQ * 64; const bf16* vw = KV + 5 * KV_STRIDE_E + (size_t)bg * SEQ * 64;
    const bf16* kcm = KC2 + (size_t)bg * 128 * 64; const bf16* vcm = KC2 + KC2_STRIDE_E + (size_t)bg * 128 * 64;
    float P0 = 0.f, P1 = 0.f; float oc[4];
    const int c0 = lane, c1 = lane + 64;
    const int rel0 = t - (16 * c0 + 31), rel1 = t - (16 * c1 + 31);
    const bool v0 = rel0 >= 0, v1 = (c1 <= 126) && (rel1 >= 0);
    const int cmax = (t >= 31) ? (((t - 31) >> 4) > 126 ? 126 : ((t - 31) >> 4)) : -1;
    {
        v4u k0[8], k1[8]; load_row64(kcm + (size_t)c0 * 64, k0); load_row64(kcm + (size_t)c1 * 64, k1);
#pragma unroll
        for (int r = 0; r < 4; ++r) {
            asm volatile("" ::: "memory");
            const int hh = g * 4 + r; v4u q[8]; load_row64(Q + tok * 1024 + hh * 64, q);
            const float* lh = lut + hh * 132;
            const float x0 = v0 ? dot64(q, k0) + lh[clampi(rel0, 0, 128)] : -1e30f;
            const float x1 = v1 ? dot64(q, k1) + lh[clampi(rel1, 0, 128)] : -1e30f;
            const float mx = wave_max(fmaxf(x0, x1));
            float p0 = v0 ? ex2(x0 - mx) : 0.f, p1 = v1 ? ex2(x1 - mx) : 0.f;
            const float sum = wave_sum(p0 + p1); const float inv = sum > 0.f ? 1.0f / sum : 0.f;
            p0 *= inv; p1 *= inv; P0 += p0; P1 += p1;
            float acc = 0.f;
#pragma unroll 4
            for (int c = 0; c <= cmax; ++c) { const float pc = __shfl(c < 64 ? p0 : p1, c & 63); acc += pc * bf2f(vcm[(size_t)c * 64 + lane]); }
            oc[r] = acc;
        }
    }
    unsigned mask;
    {
        const int j = lane & 31; float imp = 0.f;
#pragma unroll
        for (int dc = -1; dc <= 3; ++dc) { const int c = 4 * j + dc; const bool ok = (c >= 0) && (c <= 126); const int cc = ok ? c : 0;
            const float a0 = __shfl(P0, cc & 63), a1 = __shfl(P1, cc & 63); imp += ok ? (cc < 64 ? a0 : a1) : 0.f; }
        const bool forced = (j == 0) || (j == cur) || (j == cur - 1);
        const float sc = forced ? 1e9f : (j <= cur ? imp : -1e30f);
        int rank = 0;
#pragma unroll
        for (int i = 0; i < 32; ++i) { const float si = __shfl(sc, i); rank += ((si > sc) || (si == sc && i < j)) ? 1 : 0; }
        const unsigned long long bal = __ballot((rank < 16) && (lane < 32));
        mask = (unsigned)__builtin_amdgcn_readfirstlane((int)(unsigned)(bal & 0xffffffffull));
    }
#pragma unroll 1
    for (int r = 0; r < 4; ++r) {
        const int hh = g * 4 + r; v4u q[8]; load_row64(Q + tok * 1024 + hh * 64, q);
        const float* lh = lut + hh * 132;
        float osel, owin;
        {
            float mrun = -1e30f, l = 0.f, acc = 0.f;
            for (int jb = 0; jb <= cur; ++jb) {
                if (!((mask >> jb) & 1u)) continue;
                const int pos = jb * 64 + lane, rel = t - pos; const bool val = rel >= 0;
                v4u kr[8]; load_row64(ks + (size_t)pos * 64, kr);
                const float x = val ? dot64(q, kr) + lh[clampi(rel, 0, 128)] : -1e30f;
                const float mn = fmaxf(mrun, wave_max(x)), alpha = ex2(mrun - mn);
                const float p = val ? ex2(x - mn) : 0.f;
                l = l * alpha + wave_sum(p); acc *= alpha; mrun = mn;
#pragma unroll 8
                for (int k = 0; k < 64; ++k) acc += __shfl(p, k) * bf2f(vs[(size_t)(jb * 64 + k) * 64 + lane]);
            }
            osel = l > 0.f ? acc / l : 0.f;
        }
        {
            float mrun = -1e30f, l = 0.f, acc = 0.f;
            for (int i = 0; i < 8; ++i) {
                const int p0 = t - 511 + 64 * i; if (p0 + 63 < 0) continue;
                const int pos = p0 + lane, rel = t - pos; const bool val = pos >= 0;
                v4u kr[8]; load_row64(kw + (size_t)(val ? pos : 0) * 64, kr);
                const float x = val ? dot64(q, kr) + lh[clampi(rel, 0, 128)] : -1e30f;
                const float mn = fmaxf(mrun, wave_max(x)), alpha = ex2(mrun - mn);
                const float p = val ? ex2(x - mn) : 0.f;
                l = l * alpha + wave_sum(p); acc *= alpha; mrun = mn;
#pragma unroll 8
                for (int k = 0; k < 64; ++k) { const int pk = p0 + k; if (pk >= 0) acc += __shfl(p, k) * bf2f(vw[(size_t)pk * 64 + lane]); }
            }
            owin = l > 0.f ? acc / l : 0.f;
        }
        const float* gt = gates + tok * 48;
        const float o = gt[hh] * oc[r] + gt[16 + hh] * osel + gt[32 + hh] * owin;
        O[tok * 1024 + hh * 64 + lane] = (bf16)f2bf(o);
    }
}
__device__ __forceinline__ void nsa_naive_phase(const Ctx& C, const bf16* Q, const bf16* KV, const bf16* KC2, const float* gates, const float* lut, bf16* O) {
    for (int task = C.gw; task < BATCH * 4 * SEQ; task += C.ngw) { const int bg = task & 31, t = task >> 5; nsa_naive_token(bg >> 2, bg & 3, t, Q, KV, KC2, gates, lut, O, C.lane); }
}

__device__ __forceinline__ void fox_cum_phase(const Ctx& C, const float* flog, const float* bfp, float* cum) {
    for (int bh = C.gw; bh < BATCH * H; bh += C.ngw) {
        const int b = bh >> 4, h = bh & 15; const float bias = bfp[h]; float carry = 0.f;
        for (int i = 0; i < SEQ / 64; ++i) { const int s = 64 * i + C.lane;
            const float x = flog[((size_t)b * SEQ + s) * 16 + h] + bias;
            float v = (fminf(x, 0.f) - log1pf(expf(-fabsf(x)))) * LOG2E;
#pragma unroll
            for (int o = 1; o < 64; o <<= 1) { const float n = __shfl_up(v, o); if (C.lane >= o) v += n; }
            cum[(size_t)bh * SEQ + s] = carry + v;
            carry += __shfl(v, 63);
        }
    }
}
__device__ __forceinline__ void fox_naive_phase(const Ctx& C, const bf16* Q, const bf16* K, const bf16* V, const float* cum, bf16* O) {
    const int lane = C.lane;
    for (int task = C.gw; task < BATCH * H * SEQ; task += C.ngw) {
        const int bh = task & 127, t = task >> 7, b = bh >> 4, h = bh & 15;
        const size_t tok = (size_t)b * SEQ + t;
        v4u q[8]; load_row64(Q + tok * 1024 + h * 64, q);
        const float* cb = cum + (size_t)bh * SEQ; const float ct = cb[t];
        float mrun = -1e30f, l = 0.f, acc = 0.f;
        for (int i = 0; i <= (t >> 6); ++i) {
            const int pos = 64 * i + lane; const bool val = pos <= t; const int pc = val ? pos : t;
            v4u kr[8]; load_row64(K + ((size_t)b * SEQ + pc) * 1024 + h * 64, kr);
            const float x = val ? dot64(q, kr) + (ct - cb[pc]) : -1e30f;
            const float mn = fmaxf(mrun, wave_max(x)), alpha = ex2(mrun - mn);
            const float p = val ? ex2(x - mn) : 0.f;
            l = l * alpha + wave_sum(p); acc *= alpha; mrun = mn;
#pragma unroll 8
            for (int k = 0; k < 64; ++k) { const int pk = 64 * i + k; if (pk <= t) acc += __shfl(p, k) * bf2f(V[((size_t)b * SEQ + pk) * 1024 + h * 64 + lane]); }
        }
        O[tok * 1024 + h * 64 + lane] = (bf16)f2bf(acc / l);
    }
}

typedef short bf16x8_t __attribute__((ext_vector_type(8)));
__device__ __forceinline__ void cmp_tail_phase(const Ctx& C, const float* slabs, const float* b1f, const bf16* w2t, bf16* KC2) {
    LAS float* red = (LAS float*)(C.lds + RING_OFF);
    const int fr = C.lane & 15, fq = C.lane >> 4, tsel = C.wave >> 2, kq = C.wave & 3;
    for (int cu = C.vcu; cu < 256; cu += C.G) {
        const int tile = tsel * 256 + cu, row = tile * 16 + fr, kv = row >> 12;
        f32x4 acc[4];
#pragma unroll
        for (int nt = 0; nt < 4; ++nt) acc[nt] = (f32x4){0.f, 0.f, 0.f, 0.f};
#pragma unroll
        for (int kk = 0; kk < 2; ++kk) {
            const int k0 = 32 * (2 * kq + kk) + 8 * fq;
            f32x4 p0[8], p1[8];
#pragma unroll
            for (int kc = 0; kc < 8; ++kc) { const GAS f32x4* sp = (const GAS f32x4*)(slabs + ((size_t)kc * 8192 + row) * 256 + k0); p0[kc] = sp[0]; p1[kc] = sp[1]; }
            const GAS f32x4* bp = (const GAS f32x4*)(b1f + kv * 256 + k0); f32x4 s0 = bp[0], s1 = bp[1];
#pragma unroll
            for (int kc = 0; kc < 8; ++kc) { s0 += p0[kc]; s1 += p1[kc]; }
#pragma unroll
            for (int e = 0; e < 4; ++e) { s0[e] = pg8::gelu_tanh(s0[e]); s1[e] = pg8::gelu_tanh(s1[e]); }
            const pg8::u32x4 bw = pg8::pack8(s0, s1); const bf16x8_t bfrag = __builtin_bit_cast(bf16x8_t, bw);
            bf16x8_t afrag[4];
#pragma unroll
            for (int nt = 0; nt < 4; ++nt) afrag[nt] = *(const GAS bf16x8_t*)(w2t + ((size_t)kv * 64 + 16 * nt + fr) * 256 + k0);
#pragma unroll
            for (int nt = 0; nt < 4; ++nt) acc[nt] = __builtin_amdgcn_mfma_f32_16x16x32_bf16(afrag[nt], bfrag, acc[nt], 0, 0, 0);
        }
        LAS f32x4* rp = (LAS f32x4*)(red + (C.wave * 64 + C.lane) * 16);
#pragma unroll
        for (int nt = 0; nt < 4; ++nt) rp[nt] = acc[nt];
        __syncthreads();
        if (kq == 0) {
#pragma unroll
            for (int w = 1; w < 4; ++w) { const LAS f32x4* op = (const LAS f32x4*)(red + ((C.wave + w) * 64 + C.lane) * 16);
#pragma unroll
                for (int nt = 0; nt < 4; ++nt) acc[nt] += op[nt]; }
            const int m = row & 4095; const bool pad = (m & 127) == 127;
#pragma unroll
            for (int nt = 0; nt < 4; ++nt) { unsigned lo = pk2(acc[nt][0], acc[nt][1]), hi2 = pk2(acc[nt][2], acc[nt][3]); if (pad) { lo = 0u; hi2 = 0u; }
                *(unsigned long long*)(KC2 + (size_t)kv * KC2_STRIDE_E + (size_t)m * 64 + 16 * nt + 4 * fq) = (unsigned long long)lo | ((unsigned long long)hi2 << 32); }
        }
        __syncthreads();
    }
}

__device__ __forceinline__ void fox_flog_tasks(const Ctx& C, const bf16* U, const bf16* WfT, float* flog) {
    if (C.wave >= 4) return;
    const int fr = C.lane & 15, fq = C.lane >> 4;
    for (int task = C.vcu * 4 + C.wave; task < M / 16; task += C.G * 4) {
        const GAS bf16x8_t* ap = (const GAS bf16x8_t*)(U + (size_t)(task * 16 + fr) * D + 8 * fq); const GAS bf16x8_t* bp = (const GAS bf16x8_t*)(WfT + (size_t)fr * D + 8 * fq);
        f32x4 acc = (f32x4){0.f, 0.f, 0.f, 0.f};
#pragma unroll
        for (int kb = 0; kb < D / 32; kb += 16) {
            bf16x8_t a[16], b[16];
#pragma unroll
            for (int j = 0; j < 16; ++j) { a[j] = ap[4 * (kb + j)]; b[j] = bp[4 * (kb + j)]; }
#pragma unroll
            for (int j = 0; j < 16; ++j) acc = __builtin_amdgcn_mfma_f32_16x16x32_bf16(a[j], b[j], acc, 0, 0, 0);
        }
#pragma unroll
        for (int e = 0; e < 4; ++e) flog[(size_t)(task * 16 + 4 * fq + e) * 16 + fr] = acc[e];
    }
}

constexpr int FOX_CUM_OFF = 86016, FOX_WTOT_OFF = 94208, FOX_ROWQ_OFF = 95232;
static_assert(FOX_ROWQ_OFF + 2 * 2048 * 4 <= 139264, "FoX LDS map");
__device__ __forceinline__ void fox_fast_phase(const Ctx& C, char* ldsg, const bf16* Q, const bf16* K, const bf16* V, bf16* O, const float* flog, const float* bfp, bf16* Odummy) {
    LAS float* cumL = (LAS float*)(C.lds + FOX_CUM_OFF); LAS float* wtot = (LAS float*)(C.lds + FOX_WTOT_OFF);
    LAS float* rowq = (LAS float*)(C.lds + FOX_ROWQ_OFF); LAS float* rowd = rowq + SEQ;
    for (int cu = C.vcu; cu < 256; cu += C.G) {
        const int bh = cu >> 1, b = bh >> 4, h = bh & 15;
        int tid_ = C.tid; asm volatile("" : "+v"(tid_));
        const int lane_ = tid_ & 63, wave_ = __builtin_amdgcn_readfirstlane(tid_ >> 6);
#if defined(PROBE_FOXPRE)
#pragma unroll 1
        for (int prep_ = 0; prep_ < 1 + PROBE_FOXPRE; ++prep_) {
#endif
        {
            const int s0 = 4 * tid_; const float bias = bfp[h]; float a[4];
#pragma unroll
            for (int i = 0; i < 4; ++i) { const float x = flog[((size_t)b * SEQ + s0 + i) * 16 + h] + bias; a[i] = (fminf(x, 0.f) - log1pf(expf(-fabsf(x)))) * LOG2E; }
            a[1] += a[0]; a[2] += a[1]; a[3] += a[2];
            const float tot = a[3]; float v = tot;
#pragma unroll
            for (int o = 1; o < 64; o <<= 1) { const float n = __shfl_up(v, o); if (lane_ >= o) v += n; }
            if (lane_ == 63) wtot[wave_] = v;
            __syncthreads();
            float off = 0.f;
            for (int w = 0; w < wave_; ++w) off += wtot[w];
            const float ex = off + v - tot;
            *(LAS f32x4*)(cumL + s0) = (f32x4){ex + a[0], ex + a[1], ex + a[2], ex + a[3]};
            __syncthreads();
        }
        {
            float qm = 0.f, km = 0.f;
            const int sub = tid_ & 7, r8 = tid_ >> 3;
            const GAS v4u* Qg = (const GAS v4u*)(Q + ((size_t)b * SEQ) * 1024 + h * 64 + sub * 8); const GAS v4u* Kg = (const GAS v4u*)(K + ((size_t)b * SEQ) * 1024 + h * 64 + sub * 8);
            const int par = cu & 1;
#pragma unroll
            for (int hb = 0; hb < 2; ++hb) {
                v4u qa_[8], ka_[8];
#pragma unroll
                for (int j = 0; j < 8; ++j) { const int u = 2 * hb + (j >> 2), qbu = 2 * u + ((u >> 1) ^ par), row = 256 * qbu + 64 * (j & 3) + r8; qa_[j] = Qg[(size_t)row * 128]; ka_[j] = Kg[(size_t)row * 128]; }
#pragma unroll
                for (int j = 0; j < 8; ++j) { const int u = 2 * hb + (j >> 2), qbu = 2 * u + ((u >> 1) ^ par), row = 256 * qbu + 64 * (j & 3) + r8; const v4u a = qa_[j], c = ka_[j];
                    float sq = bf_lo(a.x) * bf_lo(a.x) + bf_hi(a.x) * bf_hi(a.x) + bf_lo(a.y) * bf_lo(a.y) + bf_hi(a.y) * bf_hi(a.y) + bf_lo(a.z) * bf_lo(a.z) + bf_hi(a.z) * bf_hi(a.z) + bf_lo(a.w) * bf_lo(a.w) + bf_hi(a.w) * bf_hi(a.w);
                    float sk = bf_lo(c.x) * bf_lo(c.x) + bf_hi(c.x) * bf_hi(c.x) + bf_lo(c.y) * bf_lo(c.y) + bf_hi(c.y) * bf_hi(c.y) + bf_lo(c.z) * bf_lo(c.z) + bf_hi(c.z) * bf_hi(c.z) + bf_lo(c.w) * bf_lo(c.w) + bf_hi(c.w) * bf_hi(c.w);
                    float dq = bf_lo(a.x) * bf_lo(c.x) + bf_hi(a.x) * bf_hi(c.x) + bf_lo(a.y) * bf_lo(c.y) + bf_hi(a.y) * bf_hi(c.y) + bf_lo(a.z) * bf_lo(c.z) + bf_hi(a.z) * bf_hi(c.z) + bf_lo(a.w) * bf_lo(c.w) + bf_hi(a.w) * bf_hi(c.w);
                    sq = sum8(sq); sk = sum8(sk); dq = sum8(dq);
                    qm = fmaxf(qm, sq); km = fmaxf(km, sk);
                    if (sub == 0) { rowq[row] = sq; rowd[row] = dq; } }
            }
            {
                v4u ka_[16];
#pragma unroll
                for (int j = 0; j < 16; ++j) { const int u = j >> 2, qbu = 2 * u + ((u >> 1) ^ par ^ 1), row = 256 * qbu + 64 * (j & 3) + r8; ka_[j] = Kg[(size_t)row * 128]; }
#pragma unroll
                for (int j = 0; j < 16; ++j) { const v4u c = ka_[j];
                    float sk = bf_lo(c.x) * bf_lo(c.x) + bf_hi(c.x) * bf_hi(c.x) + bf_lo(c.y) * bf_lo(c.y) + bf_hi(c.y) * bf_hi(c.y) + bf_lo(c.z) * bf_lo(c.z) + bf_hi(c.z) * bf_hi(c.z) + bf_lo(c.w) * bf_lo(c.w) + bf_hi(c.w) * bf_hi(c.w);
                    sk = sum8(sk); km = fmaxf(km, sk); }
            }
            qm = wave_max(qm); km = wave_max(km);
            if (lane_ == 0) { wtot[8 + wave_] = qm; wtot[16 + wave_] = km; }
            __syncthreads();
            float qa = 0.f, ka = 0.f;
#pragma unroll
            for (int w = 0; w < 8; ++w) { qa = fmaxf(qa, wtot[8 + w]); ka = fmaxf(ka, wtot[16 + w]); }
            const float Kmax = sqrtf(ka); if (tid_ == 0) wtot[48] = 0.02f * sqrtf(qa * ka) + 32.0f;
#pragma unroll
            for (int uu = 0; uu < 2; ++uu) { const int u = 2 * uu + (tid_ >> 8), qbu = 2 * u + ((u >> 1) ^ par), row = 256 * qbu + (tid_ & 255);
                const float t = wave_max(sqrtf(rowq[row]) * Kmax - rowd[row]); if (lane_ == 0) wtot[32 + 4 * u + (wave_ & 3)] = t; }
            __syncthreads();
        }
#if defined(PROBE_FOXPRE)
        }
#endif
#pragma unroll 1
        for (int i = 0; i < 4; ++i) {
            const int qb = (cu & 1) ? (i == 0 ? 6 : i == 1 ? 1 : i == 2 ? 4 : 3) : (i == 0 ? 7 : i == 1 ? 0 : i == 2 ? 5 : 2);
            const int uo = qb >> 1; const float Tskip = fmaxf(fmaxf(wtot[32 + 4 * uo], wtot[33 + 4 * uo]), fmaxf(wtot[34 + 4 * uo], wtot[35 + 4 * uo])) + wtot[48];
            int tskip = 0; { const float c0 = cumL[qb * 256]; for (int t = 0; t + 4 < 4 * qb + 4; ++t) { if (c0 - cumL[64 * t + 63] < -Tskip) tskip = t + 1; else break; } }
            tskip = __builtin_amdgcn_readfirstlane(tskip) & ~1;
#if defined(PROBE_FOXDIAG)
            attn_body::attn_unit<64>(b, h, qb, (const attn_body::bf16*)Q, (const attn_body::bf16*)K, (const attn_body::bf16*)V, (attn_body::bf16*)Odummy, ldsg + RING_OFF, cumL, (PROBE_FOXDIAG == 2 && qb >= 1) ? 4 * qb - 4 : 4 * qb);
#endif
#if defined(PROBE_FOX)
            attn_body::attn_unit<64, PROBE_FOX>(b, h, qb, (const attn_body::bf16*)Q, (const attn_body::bf16*)K, (const attn_body::bf16*)V, (attn_body::bf16*)Odummy, ldsg + RING_OFF, cumL, tskip);
#endif
            attn_body::attn_unit<64>(b, h, qb, (const attn_body::bf16*)Q, (const attn_body::bf16*)K, (const attn_body::bf16*)V, (attn_body::bf16*)O, ldsg + RING_OFF, cumL, tskip);
        }
        __syncthreads();
    }
}

__device__ __forceinline__ void nsa_fast_phase(const Ctx& C, char* ldsg, const bf16* Q, const bf16* KV, const bf16* KC2, const float* gates, const float* lutg, bf16* O) {
    static_assert(nsa::NSA_LDS_END <= LDSCTL_OFF, "NSA LDS map");
    for (int cu = C.vcu; cu < 256; cu += C.G) {
        const int bg = cu >> 3, s = cu & 7;
#pragma unroll 1
        for (int i = 0; i < 4; ++i) {
            const int qc = (i == 0) ? 31 - s : (i == 1) ? s : (i == 2) ? 16 + s : 15 - s;
            nsa::nsa_unit(bg >> 2, bg & 3, qc, (const attn_body::bf16*)Q, (const attn_body::bf16*)KV, (const attn_body::bf16*)KC2, KV_STRIDE_E, KC2_STRIDE_E, gates, lutg, (attn_body::bf16*)O, ldsg + RING_OFF);
        }
    }
}

struct Args { const float* in[15]; float* out; unsigned char* ws; int ph_lo, ph_hi; };
__device__ __forceinline__ Ctx make_ctx(unsigned char* lds) {
    Ctx C; int tid = threadIdx.x; asm volatile("" : "+v"(tid));
    C.lds = (LAS unsigned char*)lds; C.tid = tid; C.lane = tid & 63; C.wave = __builtin_amdgcn_readfirstlane(tid >> 6);
    int bx = blockIdx.x, G = gridDim.x; asm volatile("" : "+s"(bx), "+s"(G));
    C.G = G; C.bx = bx; C.vcu = (C.G % 8 == 0) ? (bx % 8) * (C.G / 8) + bx / 8 : bx;
    C.gw = C.vcu * NWAVES + C.wave; C.ngw = C.G * NWAVES;
    return C;
}
__device__ __forceinline__ unsigned char* opaque_ptr(unsigned char* p) { asm volatile("" : "+s"(p)); return p; }
__global__ void __launch_bounds__(NWAVES * 64, 2) fwd_kernel(Args args) {
    extern __shared__ __attribute__((aligned(16))) unsigned char lds[];
#ifndef CODE_SHIFT
#define CODE_SHIFT 0
#endif
#define CS_STR2(x) #x
#define CS_STR(x) CS_STR2(x)
#if CODE_SHIFT > 0
    asm volatile(".rept " CS_STR(CODE_SHIFT) "\n\ts_nop 0\n\t.endr");
#endif
    volatile LAS unsigned* MISC = (volatile LAS unsigned*)((LAS unsigned char*)lds + MISC_OFF);
    for (int u = threadIdx.x; u < LDS_BYTES / 4; u += NWAVES * 64) ((LAS unsigned*)((LAS unsigned char*)lds))[u] = 0u;
    __syncthreads();
    const int lo = args.ph_lo, hi = args.ph_hi;
    XcdBarrier bar; bar.bar = (unsigned*)(args.ws + WS_CTL) + CW_BAR; bar.x = 0; bar.st = nullptr;
    if (hi - lo > 1) bar = xcd_barrier_post((unsigned*)(args.ws + WS_CTL) + CW_BAR, MISC + 8);
    int ph = 0;
#ifndef PROBE_DUP
#define PROBE_DUP 0
#endif
#define PH_BEGIN_K(kind) if (ph >= lo && ph < hi) { for (int rep_ = (PROBE_DUP >> (kind)) & 1; rep_ >= 0; --rep_) { unsigned char* const ws = opaque_ptr(args.ws); const Ctx C = make_ctx(lds); (void)ws; (void)C;
#define PH_BEGIN PH_BEGIN_K(0)
#define PH_END   } if (ph + 1 < hi) { XcdBarrier b2 = bar; b2.bar = (unsigned*)opaque_ptr((unsigned char*)bar.bar); asm volatile("" : "+s"(b2.x)); xcd_barrier(b2); } } ++ph;
#define WSP(T, off) ((T*)(ws + (off)))

    PH_BEGIN_K(9) {
        In I; I.x = args.in[0]; I.norm_g = args.in[1]; I.w_gate = args.in[2]; I.w_up = args.in[3]; I.w_down = args.in[4]; I.rel_bias = args.in[5]; I.nsa_w_in = args.in[6]; I.nsa_pe = args.in[7];
        I.nsa_w1 = args.in[8]; I.nsa_b1 = args.in[9]; I.nsa_w2 = args.in[10]; I.nsa_w_out = args.in[11]; I.fox_w_in = args.in[12]; I.fox_b_f = args.in[13]; I.fox_w_out = args.in[14];
        prologue(C, I, ws, (bf16*)((unsigned char*)args.out + 32 * MiB)); } PH_END

#pragma unroll 1
    for (int s = 0; s < 8; ++s) {
        const int L = s >> 1, half = s & 1;
        PH_BEGIN_K(0) { pg8::Gemm g{WSP(bf16, WS_U), WSP(bf16, WS_WGU) + (size_t)s * NGU * D, D, D, D}; pg8::StaticOrder S; S.init(M, NGU, C.G, C.bx);
            pg8::EpiSwiglu E{WSP(bf16, WS_R1), FF}; pg8::gemm_phase<pg8::EpiSwiglu, pg8::StaticOrder, true, true>(C.lds + RING_OFF, g, S, E);
            if (C.G == 256 && C.bx >= 128 && rep_ == 0) {
                In I; I.x = args.in[0]; I.norm_g = args.in[1]; I.w_gate = args.in[2]; I.w_up = args.in[3]; I.w_down = args.in[4]; I.rel_bias = args.in[5]; I.nsa_w_in = args.in[6]; I.nsa_pe = args.in[7];
                I.nsa_w1 = args.in[8]; I.nsa_b1 = args.in[9]; I.nsa_w2 = args.in[10]; I.nsa_w_out = args.in[11]; I.fox_w_in = args.in[12]; I.fox_b_f = args.in[13]; I.fox_w_out = args.in[14];
                convert_for_next(I, ws, s, (C.bx - 128) * NWAVES + C.wave, 128 * NWAVES, (LAS float*)(C.lds + RING_OFF + C.wave * 16384), C.lane); } } PH_END
        PH_BEGIN_K(1) { pg8::Gemm g{WSP(bf16, WS_R1), WSP(bf16, WS_WD) + (size_t)s * D * FF, FF, FF, FF}; pg8::StaticOrder S; S.init(M, D, C.G, C.bx);
            pg8::EpiPlain E{WSP(bf16, WS_Y), D}; pg8::gemm_phase<pg8::EpiPlain, pg8::StaticOrder, true, true>(C.lds + RING_OFF, g, S, E); } PH_END
        PH_BEGIN_K(8) { const float* gL = args.in[1] + (size_t)L * 6 * D; const float* gpost = gL + (half ? 5 : 1) * D; const float* gpre = half ? (L < 3 ? gL + 6 * D : nullptr) : gL + 2 * D;
            bf16* hsd = (bf16*)((unsigned char*)args.out + 32 * MiB); const bool last = (s == 7);
            thin_pass(C, last ? WSP(bf16, WS_O) : hsd, rep_ ? WSP(bf16, WS_R1) : hsd, rep_ ? WSP(bf16, WS_R1 + 32 * MiB) : WSP(bf16, WS_U), rep_ ? WSP(float, WS_R1) : args.out, WSP(bf16, WS_Y), gpost, 0.5f, gpre, last); } PH_END
        if (half == 0) {
            const int j = L >> 1;
            if ((L & 1) == 0) {
                PH_BEGIN_K(2) { pg8::Gemm g{WSP(bf16, WS_U), WSP(bf16, WS_WNIN) + (size_t)j * NSA_IN_PAD * D, D, D, D}; pg8::StaticOrder S; S.init(M, NSA_IN_PAD, C.G, C.bx);
                    pg8::EpiNsaIn E{WSP(bf16, WS_R1), WSP(bf16, WS_R1 + R1_KV), WSP(float, WS_GATES), QSCALE, KV_STRIDE_E};
                    pg8::gemm_phase<pg8::EpiNsaIn, pg8::StaticOrder, true, true>(C.lds + RING_OFF, g, S, E); } PH_END
                PH_BEGIN_K(3) { const int xj = (C.bx >> 3) & 31, kc = xj & 7, Lu = (xj >> 4) * 16 + 2 * (C.bx & 7) + ((xj >> 3) & 1);
                    if (C.bx < 256) { int kch = 256; asm volatile("" : "+s"(kch));
                        pg8::Gemm g{WSP(bf16, WS_R1 + R1_KV) + kc * 256, WSP(bf16, WS_W1T) + (size_t)j * 512 * 2048 + kc * 256, 1024, 2048, kch}; pg8::OneUnit S{Lu, Lu >> 4};
                        pg8::EpiSlab E{WSP(float, WS_Y) + (size_t)kc * 8192 * 256}; pg8::gemm_phase<pg8::EpiSlab, pg8::OneUnit, true, true>(C.lds + RING_OFF, g, S, E); } } PH_END
                PH_BEGIN_K(5) cmp_tail_phase(C, WSP(float, WS_Y), WSP(float, WS_B1F) + j * 512, WSP(bf16, WS_W2T) + (size_t)j * 2 * 64 * 256, WSP(bf16, WS_R1 + R1_KC2)); PH_END
#if NSA_NAIVE
                PH_BEGIN_K(6) nsa_naive_phase(C, WSP(bf16, WS_R1), WSP(bf16, WS_R1 + R1_KV), WSP(bf16, WS_R1 + R1_KC2), WSP(float, WS_GATES), WSP(float, WS_LUT), WSP(bf16, WS_O)); PH_END
#else
                PH_BEGIN_K(6) nsa_fast_phase(C, (char*)lds, WSP(bf16, WS_R1), WSP(bf16, WS_R1 + R1_KV), WSP(bf16, WS_R1 + R1_KC2), WSP(float, WS_GATES), WSP(float, WS_LUT), WSP(bf16, WS_O)); PH_END
#endif
                PH_BEGIN_K(4) { pg8::Gemm g{WSP(bf16, WS_O), WSP(bf16, WS_WNOUT) + (size_t)j * D * D, D, D, D}; pg8::StaticOrder S; S.init(M, D, C.G, C.bx);
                    pg8::EpiPlain E{WSP(bf16, WS_Y), D}; pg8::gemm_phase<pg8::EpiPlain, pg8::StaticOrder, true, true>(C.lds + RING_OFF, g, S, E); } PH_END
            } else {
                PH_BEGIN_K(2) { fox_flog_tasks(C, WSP(bf16, WS_U), WSP(bf16, WS_WFIN) + ((size_t)j * FOX_IN_PAD + 3 * D) * D, WSP(float, WS_FLOG));
                    pg8::Gemm g{WSP(bf16, WS_U), WSP(bf16, WS_WFIN) + (size_t)j * FOX_IN_PAD * D, D, D, D}; pg8::StaticOrder S; S.init(M, 3 * D, C.G, C.bx);
                    pg8::EpiFoxIn E{WSP(bf16, WS_R1), WSP(float, WS_FLOG), QSCALE, (size_t)M * D}; pg8::gemm_phase<pg8::EpiFoxIn, pg8::StaticOrder, true, true>(C.lds + RING_OFF, g, S, E); } PH_END
#if FOX_NAIVE
                PH_BEGIN_K(7) fox_cum_phase(C, WSP(float, WS_FLOG), args.in[13] + j * 16, WSP(float, WS_CUM)); PH_END
                PH_BEGIN_K(7) fox_naive_phase(C, WSP(bf16, WS_R1), WSP(bf16, WS_R1) + (size_t)M * D, WSP(bf16, WS_R1) + (size_t)2 * M * D, WSP(float, WS_CUM), WSP(bf16, WS_O)); PH_END
#else
                PH_BEGIN_K(7) fox_fast_phase(C, (char*)lds, WSP(bf16, WS_R1), WSP(bf16, WS_R1) + (size_t)M * D, WSP(bf16, WS_R1) + (size_t)2 * M * D, WSP(bf16, WS_O), WSP(float, WS_FLOG), args.in[13] + j * 16, WSP(bf16, WS_Y)); PH_END
#endif
                PH_BEGIN_K(4) { pg8::Gemm g{WSP(bf16, WS_O), WSP(bf16, WS_WFOUT) + (size_t)j * D * D, D, D, D}; pg8::StaticOrder S; S.init(M, D, C.G, C.bx);
                    pg8::EpiPlain E{WSP(bf16, WS_Y), D}; pg8::gemm_phase<pg8::EpiPlain, pg8::StaticOrder, true, true>(C.lds + RING_OFF, g, S, E); } PH_END
            }
            PH_BEGIN_K(8) { const float* gL = args.in[1] + (size_t)L * 6 * D; bf16* hsd = (bf16*)((unsigned char*)args.out + 32 * MiB);
                thin_pass(C, hsd, rep_ ? WSP(bf16, WS_R1) : (L == 3 ? WSP(bf16, WS_O) : hsd), rep_ ? WSP(bf16, WS_R1 + 32 * MiB) : WSP(bf16, WS_U), args.out, WSP(bf16, WS_Y), gL + 3 * D, 1.0f, gL + 4 * D, false); } PH_END
        }
    }
#undef PH_BEGIN
#undef PH_END
#undef WSP
}

extern "C" void kernel_launch(void* const* d_in, const int* in_sizes, int n_in, void* d_out, int out_size, void* d_ws, size_t ws_size, hipStream_t stream) {
    static int grid = 0;
    if (grid == 0) {
        if (n_in != 15 || in_sizes[0] != M * D || out_size != M * D || ws_size < WS_END) { fprintf(stderr, "kernel_launch: unexpected shapes (n_in %d, in0 %d, out %d, ws %zu < %zu); nothing launched\n", n_in, n_in > 0 ? in_sizes[0] : -1, out_size, ws_size, (size_t)WS_END); grid = -1; return; }
        int dev = 0, cus = 0, per_cu = 0;
        if (hipGetDevice(&dev) != hipSuccess || hipDeviceGetAttribute(&cus, hipDeviceAttributeMultiprocessorCount, dev) != hipSuccess) { grid = -1; return; }
        if (hipFuncSetAttribute((const void*)fwd_kernel, hipFuncAttributeMaxDynamicSharedMemorySize, LDS_BYTES) != hipSuccess) { fprintf(stderr, "kernel_launch: hipFuncSetAttribute failed\n"); grid = -1; return; }
        if (hipOccupancyMaxActiveBlocksPerMultiprocessor(&per_cu, (const void*)fwd_kernel, NWAVES * 64, LDS_BYTES) != hipSuccess || per_cu < 1)
            fprintf(stderr, "kernel_launch: note: occupancy query reports %d workgroups per CU\n", per_cu);
        (void)hipGetLastError();
        grid = cus;
    }
    if (grid < 0) return;
    if (hipMemsetAsync((char*)d_ws + WS_CTL, 0, CTL_ZERO_BYTES, stream) != hipSuccess) { fprintf(stderr, "kernel_launch: hipMemsetAsync failed\n"); return; }
    Args a{};
    for (int i = 0; i < 15; ++i) a.in[i] = (const float*)d_in[i];
    a.out = (float*)d_out; a.ws = (unsigned char*)d_ws;
#if MK_PER_PHASE
    for (int p = 0; p < N_PHASES; ++p) { a.ph_lo = p; a.ph_hi = p + 1; hipLaunchKernelGGL(fwd_kernel, dim3(grid), dim3(NWAVES * 64), LDS_BYTES, stream, a); }
#else
    a.ph_lo = 0; a.ph_hi = N_PHASES;
    hipLaunchKernelGGL(fwd_kernel, dim3(grid), dim3(NWAVES * 64), LDS_BYTES, stream, a);
#endif
    const hipError_t le = hipPeekAtLastError();
    if (le != hipSuccess) fprintf(stderr, "kernel_launch: launch failed: %s\n", hipGetErrorName(le));
}
```
